# Optimizing an MI355X kernel written in HIP

```python
import math
import jax, jax.numpy as jnp
from jax import lax
import numpy as np

D_MODEL = 1024
BATCH = 4
SEQ = 8192
DEPTH = 1

D_MIX = D_MODEL
CONV_WIDTH = D_MIX // 2
CONV_GROUPS = 8
CONV_K = 3
DN_WIDTH = D_MIX - CONV_WIDTH
DN_HEADS = 4
DN_HEAD_DIM = DN_WIDTH // DN_HEADS
DN_CONV_K = 4
DN_CHUNK = 64
IN_COLS = 3 * CONV_WIDTH + 4 * DN_WIDTH + 2 * DN_HEADS
MEM_LEN = 256
X_HEADS = 4
X_HEAD_DIM = D_MODEL // X_HEADS
PEER_HEADS = 8
PEER_KEYS = 128
PEER_EXPERTS = PEER_KEYS * PEER_KEYS
PEER_TOPK = 16
PEER_QDIM = 128
PEER_HALF = PEER_QDIM // 2
PEER_BLOCK = 128
EPS = 1e-6

kernel_name = "hybrid_conv_deltanet_peer_layer"


def rms_norm(x, gain, eps=EPS):
    xf = x.astype(jnp.float32)
    y = xf * lax.rsqrt(jnp.mean(xf * xf, axis=-1, keepdims=True) + eps)
    return (y * gain.astype(jnp.float32)).astype(x.dtype)


def l2_normalize(t, eps=EPS):
    tf = t.astype(jnp.float32)
    return tf * lax.rsqrt(jnp.sum(tf * tf, axis=-1, keepdims=True) + eps)


def causal_depthwise_conv(x, w):
    k = w.shape[0]
    return lax.conv_general_dilated(
        x, w[:, None, :].astype(x.dtype), window_strides=(1,), padding=[(k - 1, 0)],
        dimension_numbers=("NWC", "WIO", "NWC"), feature_group_count=x.shape[-1])


def chunk_gated_delta_rule(q, k, v, g, beta):
    f32 = jnp.float32
    bsz, seq, nh, dk = q.shape
    dv = v.shape[-1]
    nc = seq // DN_CHUNK

    def to_chunks(t):
        t = t.astype(f32).reshape(bsz, nc, DN_CHUNK, nh, *t.shape[3:])
        return jnp.moveaxis(t, 3, 1)

    q = to_chunks(q) * (dk ** -0.5)
    k = to_chunks(k)
    v = to_chunks(v)
    beta = to_chunks(beta)
    g = jnp.cumsum(to_chunks(g), axis=-1)

    causal = jnp.tril(jnp.ones((DN_CHUNK, DN_CHUNK), dtype=bool))
    strict = jnp.tril(jnp.ones((DN_CHUNK, DN_CHUNK), dtype=bool), -1)
    diff = g[..., :, None] - g[..., None, :]
    decay = jnp.where(causal, jnp.exp(jnp.where(causal, diff, 0.0)), 0.0)

    k_beta = k * beta[..., None]
    v_beta = v * beta[..., None]
    a = jnp.where(strict, jnp.einsum("bhnid,bhnjd->bhnij", k_beta, k) * decay, 0.0)
    eye = jnp.eye(DN_CHUNK, dtype=f32)
    t_mat = lax.linalg.triangular_solve(a + eye, jnp.broadcast_to(eye, a.shape),
                                        left_side=True, lower=True, unit_diagonal=True)
    u = jnp.einsum("bhnij,bhnjd->bhnid", t_mat, v_beta)
    w = jnp.einsum("bhnij,bhnjd->bhnid", t_mat, k_beta * jnp.exp(g)[..., None])
    intra = jnp.einsum("bhnid,bhnjd->bhnij", q, k) * decay
    q_dec = q * jnp.exp(g)[..., None]
    k_dec = k * jnp.exp(g[..., -1:] - g)[..., None]
    g_last = jnp.exp(g[..., -1])

    xs = tuple(jnp.moveaxis(t, 2, 0) for t in (q_dec, k_dec, u, w, intra, g_last))

    def step(state, inp):
        q_c, k_c, u_c, w_c, a_c, gl = inp
        v_new = u_c - jnp.einsum("bhcd,bhde->bhce", w_c, state)
        o = jnp.einsum("bhcd,bhde->bhce", q_c, state) + jnp.einsum("bhij,bhje->bhie", a_c, v_new)
        state = state * gl[..., None, None] + jnp.einsum("bhcd,bhce->bhde", k_c, v_new)
        return state, o

    s0 = jnp.zeros((bsz, nh, dk, dv), f32)
    _, o = lax.scan(step, s0, xs)
    return o.transpose(1, 0, 3, 2, 4).reshape(bsz, seq, nh, dv)


def hybrid_mixer(xn, w_in, conv_w, dn_conv_w, dn_a_log, dn_dt_bias, dn_norm, w_out):
    bsz, seq, _ = xn.shape
    proj = xn @ w_in
    o1 = CONV_WIDTH
    o2 = 2 * CONV_WIDTH
    o3 = 3 * CONV_WIDTH
    o4 = o3 + 3 * DN_WIDTH
    o5 = o4 + DN_WIDTH
    o6 = o5 + DN_HEADS
    b_gate, c_gate, h_conv, qkv, z, beta_logit, a_logit = jnp.split(
        proj, [o1, o2, o3, o4, o5, o6], axis=-1)

    y_conv = b_gate * causal_depthwise_conv(c_gate * h_conv, conv_w)

    qkv = jax.nn.silu(causal_depthwise_conv(qkv, dn_conv_w))
    q, k, v = jnp.split(qkv, 3, axis=-1)
    hs = (bsz, seq, DN_HEADS, DN_HEAD_DIM)
    q = l2_normalize(q.reshape(hs))
    k = l2_normalize(k.reshape(hs))
    v = v.reshape(hs)
    beta = jax.nn.sigmoid(beta_logit.astype(jnp.float32))
    g = -jnp.exp(dn_a_log.astype(jnp.float32)) * jax.nn.softplus(
        a_logit.astype(jnp.float32) + dn_dt_bias.astype(jnp.float32))
    o = chunk_gated_delta_rule(q, k, v, g, beta)
    o = rms_norm(o, dn_norm) * jax.nn.silu(z.reshape(hs).astype(jnp.float32))
    y_dn = o.reshape(bsz, seq, DN_WIDTH).astype(xn.dtype)

    return jnp.concatenate([y_conv, y_dn], axis=-1) @ w_out


def memory_cross_attention(xn, mem_n, w_q, w_kv, w_o):
    bsz, seq, _ = xn.shape
    q = (xn @ w_q).reshape(bsz, seq, X_HEADS, X_HEAD_DIM)
    kv = (mem_n @ w_kv).reshape(bsz, mem_n.shape[1], 2, X_HEADS, X_HEAD_DIM)
    k, v = kv[:, :, 0], kv[:, :, 1]
    s = jnp.einsum("bshd,bmhd->bhsm", q, k).astype(jnp.float32) * (X_HEAD_DIM ** -0.5)
    p = jax.nn.softmax(s, axis=-1).astype(xn.dtype)
    o = jnp.einsum("bhsm,bmhd->bshd", p, v).reshape(bsz, seq, D_MODEL)
    return o @ w_o


def peer_ffn(xn, w_query, sub_keys, expert_u, expert_v):
    bsz, seq, d = xn.shape
    q = (xn @ w_query).reshape(bsz, seq, PEER_HEADS, 2, PEER_HALF)
    scores = jnp.einsum("bshpd,hpnd->bshpn", q, sub_keys).astype(jnp.float32)
    s_top, i_top = lax.top_k(scores, PEER_TOPK)
    cand = (s_top[..., 0, :, None] + s_top[..., 1, None, :]).reshape(
        bsz, seq, PEER_HEADS, PEER_TOPK * PEER_TOPK)
    cand_idx = (i_top[..., 0, :, None] * PEER_KEYS + i_top[..., 1, None, :]).reshape(
        bsz, seq, PEER_HEADS, PEER_TOPK * PEER_TOPK)
    best, pos = lax.top_k(cand, PEER_TOPK)
    idx = jnp.take_along_axis(cand_idx, pos, axis=-1)
    gates = jax.nn.softmax(best, axis=-1).astype(xn.dtype)

    n_blk = (bsz * seq) // PEER_BLOCK
    sel = PEER_HEADS * PEER_TOPK
    xb = xn.reshape(n_blk, PEER_BLOCK, d)
    ib = idx.reshape(n_blk, PEER_BLOCK, sel)
    gb = gates.reshape(n_blk, PEER_BLOCK, sel)

    def block(args):
        xt, it, gt = args
        u = expert_u[it]
        v = expert_v[it]
        act = jax.nn.gelu(jnp.einsum("td,ted->te", xt, u), approximate=False)
        return jnp.einsum("te,ted->td", gt * act, v)

    y = lax.map(block, (xb, ib, gb))
    return y.reshape(bsz, seq, d)


def setup_inputs(seed: int = 0) -> dict:
    key = jax.random.key(seed)
    ks = iter(jax.random.split(key, 32))
    f32 = jnp.float32
    L = DEPTH

    def nrm(shape, scale):
        return jax.random.normal(next(ks), shape, f32) * scale

    def gain(shape):
        return 1.0 + 0.02 * jax.random.normal(next(ks), shape, f32)

    x = nrm((BATCH, SEQ, D_MODEL), 1.0)
    mem = nrm((BATCH, MEM_LEN, D_MODEL), 1.0)
    norm_mix = gain((L, D_MODEL))
    w_in = nrm((L, D_MODEL, IN_COLS), D_MODEL ** -0.5)
    conv_w = nrm((L, CONV_K, CONV_WIDTH), CONV_K ** -0.5)
    dn_conv_w = nrm((L, DN_CONV_K, 3 * DN_WIDTH), DN_CONV_K ** -0.5)
    dn_a_log = jnp.log(jax.random.uniform(next(ks), (L, DN_HEADS), f32, 1.0, 16.0))
    dt = jnp.exp(jax.random.uniform(next(ks), (L, DN_HEADS), f32,
                                    math.log(1e-3), math.log(1e-1)))
    dn_dt_bias = dt + jnp.log(-jnp.expm1(-dt))
    dn_norm = gain((L, DN_HEAD_DIM))
    w_out = nrm((L, D_MIX, D_MODEL), D_MIX ** -0.5)
    norm_x = gain((L, D_MODEL))
    norm_mem = gain((L, D_MODEL))
    w_xq = nrm((L, D_MODEL, D_MODEL), D_MODEL ** -0.5)
    w_xkv = nrm((L, D_MODEL, 2 * D_MODEL), D_MODEL ** -0.5)
    w_xo = nrm((L, D_MODEL, D_MODEL), D_MODEL ** -0.5)
    norm_ffn = gain((L, D_MODEL))
    w_pq = nrm((L, D_MODEL, PEER_HEADS * PEER_QDIM), D_MODEL ** -0.5)
    peer_keys = nrm((L, PEER_HEADS, 2, PEER_KEYS, PEER_HALF), PEER_HALF ** -0.5)
    expert_u = nrm((L, PEER_EXPERTS, D_MODEL), D_MODEL ** -0.5)
    expert_v = nrm((L, PEER_EXPERTS, D_MODEL), PEER_TOPK ** -0.5)
    norm_final = gain((D_MODEL,))
    return {"x": x, "mem": mem, "norm_mix": norm_mix, "w_in": w_in, "conv_w": conv_w,
            "dn_conv_w": dn_conv_w, "dn_a_log": dn_a_log, "dn_dt_bias": dn_dt_bias,
            "dn_norm": dn_norm, "w_out": w_out, "norm_x": norm_x, "norm_mem": norm_mem,
            "w_xq": w_xq, "w_xkv": w_xkv, "w_xo": w_xo, "norm_ffn": norm_ffn,
            "w_pq": w_pq, "peer_keys": peer_keys, "expert_u": expert_u,
            "expert_v": expert_v, "norm_final": norm_final}


def reference(x, mem, norm_mix, w_in, conv_w, dn_conv_w, dn_a_log, dn_dt_bias, dn_norm,
              w_out, norm_x, norm_mem, w_xq, w_xkv, w_xo, norm_ffn, w_pq, peer_keys,
              expert_u, expert_v, norm_final):
    h = x
    for layer in range(DEPTH):
        h = h + hybrid_mixer(rms_norm(h, norm_mix[layer]), w_in[layer], conv_w[layer],
                             dn_conv_w[layer], dn_a_log[layer], dn_dt_bias[layer],
                             dn_norm[layer], w_out[layer])
        h = h + memory_cross_attention(rms_norm(h, norm_x[layer]),
                                       rms_norm(mem, norm_mem[layer]),
                                       w_xq[layer], w_xkv[layer], w_xo[layer])
        h = h + peer_ffn(rms_norm(h, norm_ffn[layer]), w_pq[layer], peer_keys[layer],
                         expert_u[layer], expert_v[layer])
    return rms_norm(h, norm_final)
```

```cpp
#include <hip/hip_runtime.h>
#include <hip/hip_cooperative_groups.h>
#include <stdint.h>
#include <stdio.h>
namespace cg = cooperative_groups;

typedef unsigned short u16;
using bf16x8 = __attribute__((ext_vector_type(8))) short;
using f32x4  = __attribute__((ext_vector_type(4))) float;
using f32x16 = __attribute__((ext_vector_type(16))) float;
using f32x2  = __attribute__((ext_vector_type(2))) float;
using bf16x2v = __attribute__((ext_vector_type(2))) __bf16;

#define DI __device__ __forceinline__
#define MFMA32(a, b, c) __builtin_amdgcn_mfma_f32_32x32x16_bf16((a), (b), (c), 0, 0, 0)
#define MFMA16(a, b, c) __builtin_amdgcn_mfma_f32_16x16x32_bf16((a), (b), (c), 0, 0, 0)

#ifndef ONE_LAUNCH
#define ONE_LAUNCH 1
#endif

constexpr int T_TOK = 32768;
constexpr int SEQ = 8192;
constexpr int DM = 1024;
constexpr int INC = 3592;
constexpr int NPH = 12;
constexpr float EPS = 1e-6f;
constexpr float EU_SCALE = 64.f, EV_SCALE = 8.f;

constexpr size_t MiB = 1024ull * 1024ull;
constexpr size_t OFF_WIN  = 0;
constexpr size_t OFF_WOUT = OFF_WIN + 3712ull * 1024 * 2;
constexpr size_t OFF_WXQ  = OFF_WOUT + 2 * MiB;
constexpr size_t OFF_WXKV = OFF_WXQ + 2 * MiB;
constexpr size_t OFF_WXO  = OFF_WXKV + 4 * MiB;
constexpr size_t OFF_WPQ  = OFF_WXO + 2 * MiB;
constexpr size_t OFF_KEYS = OFF_WPQ + 2 * MiB;
constexpr size_t OFF_EU   = OFF_KEYS + 262144;
constexpr size_t OFF_EV   = OFF_EU + 32 * MiB;
constexpr size_t OFF_XB   = OFF_EV + 32 * MiB;
constexpr size_t OFF_MEMB = OFF_XB + 64 * MiB;
constexpr size_t OFF_KX   = OFF_MEMB + 2 * MiB;
constexpr size_t OFF_VT   = OFF_KX + 2 * MiB;
constexpr size_t OFF_RSTD0 = OFF_VT + 2 * MiB;
constexpr size_t OFF_RSTDM = OFF_RSTD0 + 131072;
constexpr size_t OFF_SSQ1 = OFF_RSTDM + 4096;
constexpr size_t OFF_SSQ2 = OFF_SSQ1 + 1 * MiB;
constexpr size_t OFF_BA   = OFF_SSQ2 + 1 * MiB;
constexpr size_t OFF_GL   = OFF_BA + 1 * MiB;
constexpr size_t OFF_YMIX = OFF_GL + 8192;
constexpr size_t OFF_PROJ = OFF_YMIX + 64 * MiB;
constexpr size_t PROJ_BYTES = (size_t)T_TOK * INC * 2;
constexpr size_t OFF_BAR  = OFF_PROJ + PROJ_BYTES;
constexpr size_t BAR_BYTES = 16384;
constexpr size_t OFF_TS   = OFF_BAR + BAR_BYTES;
constexpr size_t WS_END   = OFF_TS + 4096;
constexpr size_t OFF_QX   = OFF_PROJ;
constexpr size_t OFF_OX   = OFF_PROJ + 64 * MiB;
constexpr size_t OFF_PQ   = OFF_PROJ + 128 * MiB;
constexpr size_t OFF_SELI = OFF_PROJ + 192 * MiB;
constexpr size_t OFF_SELG = OFF_PROJ + 208 * MiB;

constexpr int SMEM_BYTES = 75776;

struct Params {
  const float *x, *mem, *norm_mix, *w_in, *conv_w, *dn_conv_w, *dn_a_log, *dn_dt_bias, *dn_norm, *w_out,
      *norm_x, *norm_mem, *w_xq, *w_xkv, *w_xo, *norm_ffn, *w_pq, *peer_keys, *expert_u, *expert_v, *norm_final;
  float* out;
  char* ws;
};

DI int tidx() { int t = (int)__builtin_amdgcn_workitem_id_x(); asm volatile("" : "+v"(t)); return t; }
DI u16 f2bf(float x) { uint32_t u = __float_as_uint(x); u += 0x7fffu + ((u >> 16) & 1u); return (u16)(u >> 16); }
DI float bf2f(u16 v) { return __uint_as_float(((uint32_t)v) << 16); }
DI uint32_t pack2(float a, float b) { return (uint32_t)f2bf(a) | ((uint32_t)f2bf(b) << 16); }
DI float bflo(uint32_t u) { return __uint_as_float(u << 16); }
DI float bfhi(uint32_t u) { return __uint_as_float(u & 0xffff0000u); }
DI int crow32(int i, int h) { return (i & 3) + 8 * (i >> 2) + 4 * h; }
DI float silu_f(float v) { return v / (1.f + __expf(-v)); }
DI float wave_sum(float v) {
#pragma unroll
  for (int o = 32; o >= 1; o >>= 1) v += __shfl_xor(v, o);
  return v;
}
DI void unpack8(const uint4& r, float* f) {
  f[0] = bflo(r.x); f[1] = bfhi(r.x); f[2] = bflo(r.y); f[3] = bfhi(r.y);
  f[4] = bflo(r.z); f[5] = bfhi(r.z); f[6] = bflo(r.w); f[7] = bfhi(r.w);
}
DI uint4 pack8(const float* f) { return make_uint4(pack2(f[0], f[1]), pack2(f[2], f[3]), pack2(f[4], f[5]), pack2(f[6], f[7])); }

DI void rowconv(const float* __restrict__ src, u16* __restrict__ dst, const float* __restrict__ gain, float* __restrict__ rstd, int rows) {
  const int lane = tidx() & 63;
  const int gw = blockIdx.x * 4 + (tidx() >> 6), nw = gridDim.x * 4;
  for (int r = gw; r < rows; r += nw) {
    const float4* s = (const float4*)(src + (size_t)r * 1024);
    float4 a0 = s[lane * 2], a1 = s[lane * 2 + 1], b0 = s[128 + lane * 2], b1 = s[128 + lane * 2 + 1];
    float f[16] = {a0.x, a0.y, a0.z, a0.w, a1.x, a1.y, a1.z, a1.w, b0.x, b0.y, b0.z, b0.w, b1.x, b1.y, b1.z, b1.w};
    if (rstd) {
      float ss = 0.f;
#pragma unroll
      for (int i = 0; i < 16; ++i) ss += f[i] * f[i];
      ss = wave_sum(ss);
      if (lane == 0) rstd[r] = rsqrtf(ss * (1.f / 1024.f) + EPS);
    }
    if (gain) {
      const float4* gp = (const float4*)gain;
      float4 g0 = gp[lane * 2], g1 = gp[lane * 2 + 1], g2 = gp[128 + lane * 2], g3 = gp[128 + lane * 2 + 1];
      float gg[16] = {g0.x, g0.y, g0.z, g0.w, g1.x, g1.y, g1.z, g1.w, g2.x, g2.y, g2.z, g2.w, g3.x, g3.y, g3.z, g3.w};
#pragma unroll
      for (int i = 0; i < 16; ++i) f[i] *= gg[i];
    }
    *(uint4*)(dst + (size_t)r * 1024 + lane * 8) = pack8(f);
    *(uint4*)(dst + (size_t)r * 1024 + 512 + lane * 8) = pack8(f + 8);
  }
}


DI void rowconv8(const float* __restrict__ src, unsigned char* __restrict__ dst, const float* __restrict__ gain, float scale, int rows, int bid, int nb) {
  const int lane = tidx() & 63;
  const int gw = bid * 4 + (tidx() >> 6), nw = nb * 4;
  float gg[16];
#pragma unroll
  for (int i = 0; i < 16; ++i) gg[i] = scale;
  if (gain) {
    const float4* gp = (const float4*)(gain + lane * 16);
#pragma unroll
    for (int q = 0; q < 4; ++q) { const float4 g4 = gp[q]; gg[4 * q] *= g4.x; gg[4 * q + 1] *= g4.y; gg[4 * q + 2] *= g4.z; gg[4 * q + 3] *= g4.w; }
  }
  for (int r = gw; r < rows; r += nw) {
    const float4* s = (const float4*)(src + (size_t)r * 1024 + lane * 16);
    uint32_t o[4];
#pragma unroll
    for (int q = 0; q < 4; ++q) {
      const float4 v = s[q];
      int pk = __builtin_amdgcn_cvt_pk_fp8_f32(v.x * gg[4 * q], v.y * gg[4 * q + 1], 0, false);
      pk = __builtin_amdgcn_cvt_pk_fp8_f32(v.z * gg[4 * q + 2], v.w * gg[4 * q + 3], pk, true);
      o[q] = (uint32_t)pk;
    }
    *(uint4*)(dst + (size_t)r * 1024 + lane * 16) = make_uint4(o[0], o[1], o[2], o[3]);
  }
}

DI void transpose_tile(const float* __restrict__ W, int N, const float* __restrict__ gain, u16* __restrict__ Wt, int nt, int kt, float* tile) {
  const int t = tidx();
  const int k0 = kt * 64, n0 = nt * 64;
#pragma unroll
  for (int i = 0; i < 16; ++i) {
    int kk = i * 4 + (t >> 6), nn = t & 63;
    float v = 0.f;
    if (n0 + nn < N) v = W[(size_t)(k0 + kk) * N + n0 + nn] * (gain ? gain[k0 + kk] : 1.f);
    tile[kk * 65 + nn] = v;
  }
  __syncthreads();
#pragma unroll
  for (int i = 0; i < 16; ++i) {
    int nn = i * 4 + (t >> 6), kk = t & 63;
    if (n0 + nn < N) Wt[(size_t)(n0 + nn) * 1024 + k0 + kk] = f2bf(tile[kk * 65 + nn]);
  }
  __syncthreads();
}

DI void weight_transposes(const Params& p, char* smem, unsigned mask, int bid, int nb) {
  char* ws = p.ws;
  const int cnt_all[6] = {57 * 16, 256, 256, 512, 256, 256};
  int cnt[6], total = 0;
  for (int i = 0; i < 6; ++i) { cnt[i] = ((mask >> i) & 1u) ? cnt_all[i] : 0; total += cnt[i]; }
  for (int job = bid; job < total; job += nb) {
    int j = job, w = 0;
    while (j >= cnt[w]) { j -= cnt[w]; ++w; }
    const float* W; const float* gain; u16* dst; int N;
    switch (w) {
      case 0: W = p.w_in; gain = p.norm_mix; dst = (u16*)(ws + OFF_WIN); N = INC; break;
      case 1: W = p.w_out; gain = nullptr; dst = (u16*)(ws + OFF_WOUT); N = 1024; break;
      case 2: W = p.w_xq; gain = p.norm_x; dst = (u16*)(ws + OFF_WXQ); N = 1024; break;
      case 3: W = p.w_xkv; gain = p.norm_mem; dst = (u16*)(ws + OFF_WXKV); N = 2048; break;
      case 4: W = p.w_xo; gain = nullptr; dst = (u16*)(ws + OFF_WXO); N = 1024; break;
      default: W = p.w_pq; gain = p.norm_ffn; dst = (u16*)(ws + OFF_WPQ); N = 1024; break;
    }
    transpose_tile(W, N, gain, dst, j >> 4, j & 15, (float*)smem);
  }
}
DI void keys_convert(const Params& p, int bid, int nb) {
  u16* kd = (u16*)(p.ws + OFF_KEYS);
  for (int i = bid * 256 + tidx(); i < 131072; i += nb * 256) kd[i] = f2bf(p.peer_keys[i]);
}

DI void phase_prep(const Params& p, char* smem) {
  char* ws = p.ws;
  const bool defer = gridDim.x == 512;
  weight_transposes(p, smem, defer ? 0x09u : 0x3Fu, blockIdx.x, gridDim.x);
  rowconv(p.x, (u16*)(ws + OFF_XB), nullptr, (float*)(ws + OFF_RSTD0), T_TOK);
  rowconv(p.mem, (u16*)(ws + OFF_MEMB), nullptr, (float*)(ws + OFF_RSTDM), 1024);
  if (!defer) {
    rowconv8(p.expert_u, (unsigned char*)(ws + OFF_EU), p.norm_ffn, EU_SCALE, 16384, blockIdx.x, gridDim.x);
    rowconv8(p.expert_v, (unsigned char*)(ws + OFF_EV), nullptr, EV_SCALE, 16384, blockIdx.x, gridDim.x);
    keys_convert(p, blockIdx.x, gridDim.x);
  }
}

typedef unsigned u32x4 __attribute__((ext_vector_type(4)));
DI void gload16(u32x4& dst, const void* p) { asm volatile("global_load_dwordx4 %0, %1, off" : "=&v"(dst) : "v"(p) : "memory"); }
DI void gwait8_all(u32x4& a0, u32x4& a1, u32x4& a2, u32x4& a3, u32x4& b0, u32x4& b1, u32x4& b2, u32x4& b3) {
  asm volatile("s_waitcnt vmcnt(0)" : "+v"(a0), "+v"(a1), "+v"(a2), "+v"(a3), "+v"(b0), "+v"(b1), "+v"(b2), "+v"(b3) : : "memory");
}
DI void gwait8_keep8(u32x4& a0, u32x4& a1, u32x4& a2, u32x4& a3, u32x4& b0, u32x4& b1, u32x4& b2, u32x4& b3) {
  asm volatile("s_waitcnt vmcnt(8)" : "+v"(a0), "+v"(a1), "+v"(a2), "+v"(a3), "+v"(b0), "+v"(b1), "+v"(b2), "+v"(b3) : : "memory");
}

DI void gemm_main(const u16* __restrict__ A, const u16* __restrict__ Bt, int m0, int n0, char* smem, f32x16 (&acc)[2][2]) {
  const int tid = tidx(), lane = tid & 63, wave = tid >> 6;
  const int wm = wave >> 1, wn = wave & 1;
  u16* As = (u16*)smem;
  u16* Bs = (u16*)(smem + 36864);
  const int srow = tid >> 3, scol = (tid & 7) * 8;
  const u16* Ap = A + (size_t)(m0 + srow) * 1024 + scol;
  const u16* Bp = Bt + (size_t)(n0 + srow) * 1024 + scol;
  u32x4 r0a[4], r0b[4], r1a[4], r1b[4];
#pragma unroll
  for (int mi = 0; mi < 2; ++mi)
#pragma unroll
    for (int ni = 0; ni < 2; ++ni)
#pragma unroll
      for (int i = 0; i < 16; ++i) acc[mi][ni][i] = 0.f;
#define ISSUE(ra_, rb_, k_) { _Pragma("unroll") for (int i = 0; i < 4; ++i) { gload16(ra_[i], Ap + (size_t)i * 32 * 1024 + (k_) * 64); gload16(rb_[i], Bp + (size_t)i * 32 * 1024 + (k_) * 64); } }
#define STORE(ra_, rb_, buf_) { u16* as2 = As + (buf_) * 128 * 72; u16* bs2 = Bs + (buf_) * 128 * 72; \
    _Pragma("unroll") for (int i = 0; i < 4; ++i) { *(u32x4*)(as2 + (srow + 32 * i) * 72 + scol) = ra_[i]; *(u32x4*)(bs2 + (srow + 32 * i) * 72 + scol) = rb_[i]; } }
  auto compute = [&](int cur) {
    const u16* as = As + cur * 128 * 72;
    const u16* bs = Bs + cur * 128 * 72;
#pragma unroll
    for (int ks = 0; ks < 4; ++ks) {
      bf16x8 a[2], b[2];
#pragma unroll
      for (int mi = 0; mi < 2; ++mi) a[mi] = *(const bf16x8*)(as + (64 * wm + 32 * mi + (lane & 31)) * 72 + 16 * ks + 8 * (lane >> 5));
#pragma unroll
      for (int ni = 0; ni < 2; ++ni) b[ni] = *(const bf16x8*)(bs + (64 * wn + 32 * ni + (lane & 31)) * 72 + 16 * ks + 8 * (lane >> 5));
#pragma unroll
      for (int mi = 0; mi < 2; ++mi)
#pragma unroll
        for (int ni = 0; ni < 2; ++ni) acc[mi][ni] = MFMA32(b[ni], a[mi], acc[mi][ni]);
    }
  };
  ISSUE(r0a, r0b, 0)
  ISSUE(r1a, r1b, 1)
  gwait8_keep8(r0a[0], r0a[1], r0a[2], r0a[3], r0b[0], r0b[1], r0b[2], r0b[3]);
  STORE(r0a, r0b, 0)
  __syncthreads();
#pragma unroll 1
  for (int kk = 0; kk < 16; kk += 2) {
    const int k2 = (kk + 2 < 16) ? kk + 2 : 15, k3 = (kk + 3 < 16) ? kk + 3 : 15;
    ISSUE(r0a, r0b, k2)
    compute(0);
    gwait8_keep8(r1a[0], r1a[1], r1a[2], r1a[3], r1b[0], r1b[1], r1b[2], r1b[3]);
    STORE(r1a, r1b, 1)
    __syncthreads();
    ISSUE(r1a, r1b, k3)
    compute(1);
    gwait8_keep8(r0a[0], r0a[1], r0a[2], r0a[3], r0b[0], r0b[1], r0b[2], r0b[3]);
    STORE(r0a, r0b, 0)
    __syncthreads();
  }
  gwait8_all(r1a[0], r1a[1], r1a[2], r1a[3], r1b[0], r1b[1], r1b[2], r1b[3]);
#undef ISSUE
#undef STORE
}

DI bool tile_map(int it, int MT, int NT, int& mt, int& nt) {
  const int nb = gridDim.x >> 3;
  if ((gridDim.x & 7) != 0) {
    const int tile = blockIdx.x + it * gridDim.x;
    if (tile >= MT * NT) return false;
    mt = tile / NT; nt = tile % NT;
    return true;
  }
  const int vx = blockIdx.x & 7, lb = blockIdx.x >> 3;
  const int per = (MT >> 3) * NT;
  const int q = it * nb + lb;
  if (q >= per) return false;
  const int grp = q / (8 * NT), r = q % (8 * NT);
  mt = vx * (MT >> 3) + grp * 8 + (r & 7);
  nt = r >> 3;
  return true;
}

DI float* rs_ptr(char* smem) { return (float*)(smem + 73728); }
DI float* sq_ptr(char* smem) { return (float*)(smem + 73728 + 512); }

DI void kv_gemm(const Params& p, char* smem, int bid, int nb);
DI void phase_proj(const Params& p, char* smem) {
  char* ws = p.ws;
  const int tid = tidx(), lane = tid & 63, wave = tid >> 6, wm = wave >> 1, wn = wave & 1, hh = lane >> 5;
  float* rs = rs_ptr(smem);
  u16* proj = (u16*)(ws + OFF_PROJ);
  float* ba = (float*)(ws + OFF_BA);
  for (int it = 0;; ++it) {
    int mt, nt;
    if (!tile_map(it, 256, 29, mt, nt)) break;
    const int m0 = mt * 128, n0 = nt * 128;
    f32x16 acc[2][2];
    gemm_main((const u16*)(ws + OFF_XB), (const u16*)(ws + OFF_WIN), m0, n0, smem, acc);
    if (tid < 128) rs[tid] = ((const float*)(ws + OFF_RSTD0))[m0 + tid];
    __syncthreads();
#pragma unroll
    for (int mi = 0; mi < 2; ++mi) {
      const int rl = 64 * wm + 32 * mi + (lane & 31);
      const float sc = rs[rl];
      const size_t row = (size_t)(m0 + rl);
#pragma unroll
      for (int ni = 0; ni < 2; ++ni)
#pragma unroll
        for (int q = 0; q < 4; ++q) {
          const int col = n0 + 64 * wn + 32 * ni + 8 * q + 4 * hh;
          const float v0 = acc[mi][ni][4 * q] * sc, v1 = acc[mi][ni][4 * q + 1] * sc, v2 = acc[mi][ni][4 * q + 2] * sc, v3 = acc[mi][ni][4 * q + 3] * sc;
          if (col < 3584) *(uint2*)(proj + row * INC + col) = make_uint2(pack2(v0, v1), pack2(v2, v3));
          else if (col < INC) *(float4*)(ba + row * 8 + (col - 3584)) = make_float4(v0, v1, v2, v3);
        }
    }
    __syncthreads();
  }
  if (gridDim.x != 512) kv_gemm(p, smem, blockIdx.x, gridDim.x);
}

DI void kv_gemm(const Params& p, char* smem, int bid, int nb) {
  char* ws = p.ws;
  const int tid = tidx(), lane = tid & 63, wave = tid >> 6, wm = wave >> 1, wn = wave & 1, hh = lane >> 5;
  float* rs = rs_ptr(smem);
  u16* kx = (u16*)(ws + OFF_KX);
  u16* vt = (u16*)(ws + OFF_VT);
  for (int t2 = bid; t2 < 128; t2 += nb) {
    const int mt = t2 >> 4, nt = t2 & 15, m0 = mt * 128, n0 = nt * 128;
    f32x16 acc[2][2];
    gemm_main((const u16*)(ws + OFF_MEMB), (const u16*)(ws + OFF_WXKV), m0, n0, smem, acc);
    if (tid < 128) rs[tid] = ((const float*)(ws + OFF_RSTDM))[m0 + tid];
    __syncthreads();
#pragma unroll
    for (int mi = 0; mi < 2; ++mi) {
      const int rl = 64 * wm + 32 * mi + (lane & 31);
      const float sc = rs[rl];
      const int row = m0 + rl, b = row >> 8, mm = row & 255;
#pragma unroll
      for (int ni = 0; ni < 2; ++ni)
#pragma unroll
        for (int q = 0; q < 4; ++q) {
          const int col = n0 + 64 * wn + 32 * ni + 8 * q + 4 * hh;
          const float v0 = acc[mi][ni][4 * q] * sc, v1 = acc[mi][ni][4 * q + 1] * sc, v2 = acc[mi][ni][4 * q + 2] * sc, v3 = acc[mi][ni][4 * q + 3] * sc;
          if (col < 1024) {
            const int head = col >> 8, d = col & 255;
            *(uint2*)(kx + ((size_t)((b * 4 + head) * 256 + mm)) * 256 + d) = make_uint2(pack2(v0, v1), pack2(v2, v3));
          } else {
            const int c2 = col - 1024, head = c2 >> 8, d = c2 & 255;
            u16* vp = vt + ((size_t)((b * 4 + head) * 256 + d)) * 256 + mm;
            vp[0] = f2bf(v0); vp[256] = f2bf(v1); vp[512] = f2bf(v2); vp[768] = f2bf(v3);
          }
        }
    }
    __syncthreads();
  }
}

DI void phase_resid(const u16* A, const u16* Bt, const float* resid, float* hout, u16* hb, float* ssq, char* smem) {
  const int tid = tidx(), lane = tid & 63, wave = tid >> 6, wm = wave >> 1, wn = wave & 1, hh = lane >> 5;
  float* sq = sq_ptr(smem);
  for (int it = 0;; ++it) {
    int mt, nt;
    if (!tile_map(it, 256, 8, mt, nt)) break;
    const int m0 = mt * 128, n0 = nt * 128;
    f32x16 acc[2][2];
    gemm_main(A, Bt, m0, n0, smem, acc);
    if (tid < 128) sq[tid] = 0.f;
    __syncthreads();
#pragma unroll
    for (int mi = 0; mi < 2; ++mi) {
      const int rl = 64 * wm + 32 * mi + (lane & 31);
      const size_t row = (size_t)(m0 + rl);
      float s2 = 0.f;
#pragma unroll
      for (int ni = 0; ni < 2; ++ni)
#pragma unroll
        for (int q = 0; q < 4; ++q) {
          const int col = n0 + 64 * wn + 32 * ni + 8 * q + 4 * hh;
          const float4 r = *(const float4*)(resid + row * 1024 + col);
          const float h0 = r.x + acc[mi][ni][4 * q], h1 = r.y + acc[mi][ni][4 * q + 1], h2 = r.z + acc[mi][ni][4 * q + 2], h3 = r.w + acc[mi][ni][4 * q + 3];
          *(float4*)(hout + row * 1024 + col) = make_float4(h0, h1, h2, h3);
          *(uint2*)(hb + row * 1024 + col) = make_uint2(pack2(h0, h1), pack2(h2, h3));
          s2 += h0 * h0 + h1 * h1 + h2 * h2 + h3 * h3;
        }
      atomicAdd(&sq[rl], s2);
    }
    __syncthreads();
    if (tid < 128) ssq[(size_t)(m0 + tid) * 8 + nt] = sq[tid];
    __syncthreads();
  }
}

DI void phase_scaled(const u16* A, const u16* Bt, const float* ssq, u16* out, char* smem) {
  const int tid = tidx(), lane = tid & 63, wave = tid >> 6, wm = wave >> 1, wn = wave & 1, hh = lane >> 5;
  float* rs = rs_ptr(smem);
  for (int it = 0;; ++it) {
    int mt, nt;
    if (!tile_map(it, 256, 8, mt, nt)) break;
    const int m0 = mt * 128, n0 = nt * 128;
    f32x16 acc[2][2];
    gemm_main(A, Bt, m0, n0, smem, acc);
    if (tid < 128) {
      const float4* sp = (const float4*)(ssq + (size_t)(m0 + tid) * 8);
      float4 s0 = sp[0], s1 = sp[1];
      rs[tid] = rsqrtf((s0.x + s0.y + s0.z + s0.w + s1.x + s1.y + s1.z + s1.w) * (1.f / 1024.f) + EPS);
    }
    __syncthreads();
#pragma unroll
    for (int mi = 0; mi < 2; ++mi) {
      const int rl = 64 * wm + 32 * mi + (lane & 31);
      const float sc = rs[rl];
#pragma unroll
      for (int ni = 0; ni < 2; ++ni)
#pragma unroll
        for (int q = 0; q < 4; ++q) {
          const int col = n0 + 64 * wn + 32 * ni + 8 * q + 4 * hh;
          *(uint2*)(out + (size_t)(m0 + rl) * 1024 + col) =
              make_uint2(pack2(acc[mi][ni][4 * q] * sc, acc[mi][ni][4 * q + 1] * sc), pack2(acc[mi][ni][4 * q + 2] * sc, acc[mi][ni][4 * q + 3] * sc));
        }
    }
    __syncthreads();
  }
}

DI void chunk_job(const Params& p, int cj, char* smem) {
  char* ws = p.ws;
  const int tid = tidx(), lane = tid & 63, wave = tid >> 6;
  const int bh = cj >> 7, n = cj & 127, b = bh >> 2, h = bh & 3;
  const int t0 = b * SEQ + n * 64;
  u16* Kb  = (u16*)smem;
  u16* Qb  = (u16*)(smem + 17408);
  u16* Vt  = (u16*)(smem + 34816);
  u16* KGt = (u16*)(smem + 53248);
  float* gc = (float*)(smem + 71680);
  float* bt = gc + 64;
  float* As = (float*)(smem + 17408);
  u16* Tb = (u16*)smem;
  const u16* proj = (const u16*)(ws + OFF_PROJ);
  u16* QD = (u16*)p.out;
  u16* KD = (u16*)((char*)p.out + 32 * MiB);
  u16* UU = (u16*)((char*)p.out + 64 * MiB);
  u16* WW = (u16*)((char*)p.out + 96 * MiB);
  u16* IN = (u16*)(ws + OFF_XB);
  float* GL = (float*)(ws + OFF_GL);

  if (wave == 0) {
    const float* ba = (const float*)(ws + OFF_BA) + (size_t)(t0 + lane) * 8;
    const float bl = ba[h], al = ba[4 + h] + p.dn_dt_bias[h];
    const float sp = fmaxf(al, 0.f) + log1pf(expf(-fabsf(al)));
    float g = -expf(p.dn_a_log[h]) * sp;
#pragma unroll
    for (int o = 1; o < 64; o <<= 1) { float v = __shfl_up(g, o); if (lane >= o) g += v; }
    gc[lane] = g;
    bt[lane] = 1.f / (1.f + expf(-bl));
    if (lane == 63) GL[cj] = expf(g);
  }
  __syncthreads();

  {
    const int cgp = tid & 15, ts = tid >> 4;
    const float glast = gc[63];
    float eg[4], ed[4], be[4];
#pragma unroll
    for (int tt = 0; tt < 4; ++tt) { const float gv = gc[4 * ts + tt]; eg[tt] = expf(gv); ed[tt] = expf(glast - gv); be[tt] = bt[4 * ts + tt]; }
#pragma unroll 1
    for (int part = 0; part < 3; ++part) {
      const int cc = part * 512 + h * 128 + cgp * 8;
      const int cb = 1536 + cc;
      float xin[7][8];
#pragma unroll
      for (int r = 0; r < 7; ++r) {
        const int sp = n * 64 + 4 * ts - 3 + r;
        if (sp >= 0) { uint4 raw = *(const uint4*)(proj + (size_t)(t0 + 4 * ts - 3 + r) * INC + cb); unpack8(raw, xin[r]); }
        else {
#pragma unroll
          for (int c = 0; c < 8; ++c) xin[r][c] = 0.f;
        }
      }
      float o[4][8];
#pragma unroll
      for (int tt = 0; tt < 4; ++tt)
#pragma unroll
        for (int c = 0; c < 8; ++c) o[tt][c] = 0.f;
#pragma unroll
      for (int j = 0; j < 4; ++j) {
        const float4 w0 = *(const float4*)(p.dn_conv_w + j * 1536 + cc), w1 = *(const float4*)(p.dn_conv_w + j * 1536 + cc + 4);
        const float wj[8] = {w0.x, w0.y, w0.z, w0.w, w1.x, w1.y, w1.z, w1.w};
#pragma unroll
        for (int tt = 0; tt < 4; ++tt)
#pragma unroll
          for (int c = 0; c < 8; ++c) o[tt][c] += wj[c] * xin[tt + j][c];
      }
#pragma unroll
      for (int tt = 0; tt < 4; ++tt)
#pragma unroll
        for (int c = 0; c < 8; ++c) o[tt][c] = silu_f(o[tt][c]);
      if (part < 2) {
#pragma unroll
        for (int tt = 0; tt < 4; ++tt) {
          float ss = 0.f;
#pragma unroll
          for (int c = 0; c < 8; ++c) ss += o[tt][c] * o[tt][c];
          ss += __shfl_xor(ss, 1); ss += __shfl_xor(ss, 2); ss += __shfl_xor(ss, 4); ss += __shfl_xor(ss, 8);
          const float rn = rsqrtf(ss + EPS) * (part == 0 ? 0.08838834764831845f : 1.f);
#pragma unroll
          for (int c = 0; c < 8; ++c) o[tt][c] *= rn;
        }
      }
      if (part == 0) {
#pragma unroll
        for (int tt = 0; tt < 4; ++tt) {
          const int tok = 4 * ts + tt;
          *(uint4*)(Qb + tok * 136 + cgp * 8) = pack8(o[tt]);
          float qd[8];
#pragma unroll
          for (int c = 0; c < 8; ++c) qd[c] = o[tt][c] * eg[tt];
          *(uint4*)(QD + ((size_t)cj * 64 + tok) * 128 + cgp * 8) = pack8(qd);
        }
      } else if (part == 1) {
#pragma unroll
        for (int tt = 0; tt < 4; ++tt) *(uint4*)(Kb + (4 * ts + tt) * 136 + cgp * 8) = pack8(o[tt]);
#pragma unroll
        for (int c = 0; c < 8; ++c) {
          const int d = cgp * 8 + c;
          *(uint2*)(KGt + d * 72 + 4 * ts) = make_uint2(pack2(o[0][c] * be[0] * eg[0], o[1][c] * be[1] * eg[1]), pack2(o[2][c] * be[2] * eg[2], o[3][c] * be[3] * eg[3]));
          *(uint2*)(KD + ((size_t)cj * 128 + d) * 64 + 4 * ts) = make_uint2(pack2(o[0][c] * ed[0], o[1][c] * ed[1]), pack2(o[2][c] * ed[2], o[3][c] * ed[3]));
        }
      } else {
#pragma unroll
        for (int c = 0; c < 8; ++c) {
          const int d = cgp * 8 + c;
          *(uint2*)(Vt + d * 72 + 4 * ts) = make_uint2(pack2(o[0][c] * be[0], o[1][c] * be[1]), pack2(o[2][c] * be[2], o[3][c] * be[3]));
        }
      }
    }
  }
  __syncthreads();

  {
    const int wi = wave >> 1, wj = wave & 1, hh = lane >> 5;
    f32x16 aK, aQ;
#pragma unroll
    for (int i = 0; i < 16; ++i) { aK[i] = 0.f; aQ[i] = 0.f; }
    if (wi >= wj) {
#pragma unroll
      for (int ks = 0; ks < 8; ++ks) {
        const bf16x8 fk = *(const bf16x8*)(Kb + (32 * wi + (lane & 31)) * 136 + 16 * ks + 8 * hh);
        const bf16x8 fq = *(const bf16x8*)(Qb + (32 * wi + (lane & 31)) * 136 + 16 * ks + 8 * hh);
        const bf16x8 fb = *(const bf16x8*)(Kb + (32 * wj + (lane & 31)) * 136 + 16 * ks + 8 * hh);
        aK = MFMA32(fk, fb, aK);
        aQ = MFMA32(fq, fb, aQ);
      }
    }
    __syncthreads();
    const int j = 32 * wj + (lane & 31);
    const float gj = gc[j];
#pragma unroll
    for (int ii = 0; ii < 16; ++ii) {
      const int i = 32 * wi + crow32(ii, hh);
      const float dec = (i >= j) ? expf(gc[i] - gj) : 0.f;
      As[i * 68 + j] = (i > j) ? aK[ii] * bt[i] * dec : 0.f;
      IN[((size_t)cj * 64 + i) * 64 + j] = f2bf((i >= j) ? aQ[ii] * dec : 0.f);
    }
  }
  __syncthreads();

  if (wave == 0) {
    float xcol[64];
#pragma unroll
    for (int i = 0; i < 64; ++i) {
      int lv = lane;
      asm volatile("" : "+v"(lv));
      float s = (i == lv) ? 1.f : 0.f;
#pragma unroll
      for (int j4 = 0; j4 < (i + 3) / 4; ++j4) {
        const float4 a4 = *(const float4*)(As + i * 68 + 4 * j4);
        if (4 * j4 + 0 < i) s -= a4.x * xcol[4 * j4 + 0];
        if (4 * j4 + 1 < i) s -= a4.y * xcol[4 * j4 + 1];
        if (4 * j4 + 2 < i) s -= a4.z * xcol[4 * j4 + 2];
        if (4 * j4 + 3 < i) s -= a4.w * xcol[4 * j4 + 3];
      }
      xcol[i] = s;
      asm volatile("" ::: "memory");
    }
#pragma unroll
    for (int i = 0; i < 64; ++i) Tb[i * 72 + lane] = f2bf(xcol[i]);
  }
  __syncthreads();

  {
    const int hh = lane >> 5;
    f32x16 aU[2], aW[2];
#pragma unroll
    for (int mi = 0; mi < 2; ++mi)
#pragma unroll
      for (int i = 0; i < 16; ++i) { aU[mi][i] = 0.f; aW[mi][i] = 0.f; }
#pragma unroll
    for (int ks = 0; ks < 4; ++ks) {
      const bf16x8 bv = *(const bf16x8*)(Vt + (32 * wave + (lane & 31)) * 72 + 16 * ks + 8 * hh);
      const bf16x8 bk = *(const bf16x8*)(KGt + (32 * wave + (lane & 31)) * 72 + 16 * ks + 8 * hh);
#pragma unroll
      for (int mi = 0; mi < 2; ++mi) {
        const bf16x8 a = *(const bf16x8*)(Tb + (32 * mi + (lane & 31)) * 72 + 16 * ks + 8 * hh);
        aU[mi] = MFMA32(a, bv, aU[mi]);
        aW[mi] = MFMA32(a, bk, aW[mi]);
      }
    }
    const int d = 32 * wave + (lane & 31);
#pragma unroll
    for (int mi = 0; mi < 2; ++mi)
#pragma unroll
      for (int ii = 0; ii < 16; ++ii) {
        const int i = 32 * mi + crow32(ii, hh);
        UU[((size_t)cj * 64 + i) * 128 + d] = f2bf(aU[mi][ii]);
        WW[((size_t)cj * 64 + i) * 128 + d] = f2bf(aW[mi][ii]);
      }
  }
  __syncthreads();
}

DI void conv_items(const Params& p, int bid, int nb) {
  char* ws = p.ws;
  const u16* proj = (const u16*)(ws + OFF_PROJ);
  u16* ymix = (u16*)(ws + OFF_YMIX);
  for (int item = bid * 256 + tidx(); item < T_TOK * 64; item += nb * 256) {
    const int t = item >> 6, c0 = (item & 63) * 8;
    const int s = t & (SEQ - 1);
    float accv[8];
#pragma unroll
    for (int c = 0; c < 8; ++c) accv[c] = 0.f;
#pragma unroll
    for (int k = 0; k < 3; ++k) {
      if (s - 2 + k >= 0) {
        const size_t row = (size_t)(t - 2 + k) * INC;
        float cg8[8], hc8[8];
        unpack8(*(const uint4*)(proj + row + 512 + c0), cg8);
        unpack8(*(const uint4*)(proj + row + 1024 + c0), hc8);
        const float4 w0 = *(const float4*)(p.conv_w + k * 512 + c0), w1 = *(const float4*)(p.conv_w + k * 512 + c0 + 4);
        const float wk[8] = {w0.x, w0.y, w0.z, w0.w, w1.x, w1.y, w1.z, w1.w};
#pragma unroll
        for (int c = 0; c < 8; ++c) accv[c] += wk[c] * cg8[c] * hc8[c];
      }
    }
    float bg[8];
    unpack8(*(const uint4*)(proj + (size_t)t * INC + c0), bg);
#pragma unroll
    for (int c = 0; c < 8; ++c) accv[c] *= bg[c];
    *(uint4*)(ymix + (size_t)t * 1024 + c0) = pack8(accv);
  }
}

DI void phase_chunks(const Params& p, char* smem) {
  char* ws = p.ws;
  for (int cj = blockIdx.x; cj < 2048; cj += gridDim.x) chunk_job(p, cj, smem);
  if (gridDim.x != 512) conv_items(p, blockIdx.x, gridDim.x);
}

struct ScanFrag {
  bf16x8 wf[4], qf[4], inf[2], kf[2][2];
  float uf[4];
  float gl;
};

DI void phase_scan(const Params& p, char* smem) {
  char* ws = p.ws;
  if (blockIdx.x >= 128) {
    if (gridDim.x == 512) {
      if (blockIdx.x >= 256 && blockIdx.x < 384) return;
      const int bid = (blockIdx.x < 256) ? blockIdx.x - 128 : blockIdx.x - 256, nb = 256;
      conv_items(p, bid, nb);
      kv_gemm(p, smem, bid, nb);
      weight_transposes(p, smem, 0x36u, bid, nb);
      keys_convert(p, bid, nb);
      rowconv8(p.expert_u, (unsigned char*)(ws + OFF_EU), p.norm_ffn, EU_SCALE, 16384, bid, nb);
      rowconv8(p.expert_v, (unsigned char*)(ws + OFF_EV), nullptr, EV_SCALE, 16384, bid, nb);
    }
    return;
  }
  const int tid = tidx(), lane = tid & 63, w = tid >> 6, m = lane & 15, g = lane >> 4;
  const int bid = blockIdx.x;
  const int bh = (bid & 7) + 8 * ((bid >> 3) & 1), sl = bid >> 4;
  const int b = bh >> 2, h = bh & 3, e0 = sl * 16;
  u16* ST = (u16*)smem;
  u16* VT = (u16*)(smem + 4352);
  const u16* QD = (const u16*)p.out;
  const u16* KD = (const u16*)((const char*)p.out + 32 * MiB);
  const u16* UU = (const u16*)((const char*)p.out + 64 * MiB);
  const u16* WW = (const u16*)((const char*)p.out + 96 * MiB);
  const u16* IN = (const u16*)(ws + OFF_XB);
  const float* GL = (const float*)(ws + OFF_GL);
  u16* ymix = (u16*)(ws + OFF_YMIX);

  for (int i = tid; i < 16 * 136 / 2; i += 256) ((uint32_t*)ST)[i] = 0u;
  f32x4 Sacc[2];
#pragma unroll
  for (int mt = 0; mt < 2; ++mt)
#pragma unroll
    for (int j = 0; j < 4; ++j) Sacc[mt][j] = 0.f;

  auto load = [&](int c, ScanFrag& f) {
    const u16* wp = WW + ((size_t)c * 64 + 16 * w + m) * 128 + 8 * g;
    const u16* qp = QD + ((size_t)c * 64 + 16 * w + m) * 128 + 8 * g;
#pragma unroll
    for (int ks = 0; ks < 4; ++ks) { f.wf[ks] = *(const bf16x8*)(wp + 32 * ks); f.qf[ks] = *(const bf16x8*)(qp + 32 * ks); }
    const u16* ip = IN + ((size_t)c * 64 + 16 * w + m) * 64 + 8 * g;
#pragma unroll
    for (int ks = 0; ks < 2; ++ks) f.inf[ks] = *(const bf16x8*)(ip + 32 * ks);
#pragma unroll
    for (int mt = 0; mt < 2; ++mt)
#pragma unroll
      for (int ks = 0; ks < 2; ++ks) f.kf[mt][ks] = *(const bf16x8*)(KD + ((size_t)c * 128 + 32 * w + 16 * mt + m) * 64 + 32 * ks + 8 * g);
#pragma unroll
    for (int j = 0; j < 4; ++j) f.uf[j] = bf2f(UU[((size_t)c * 64 + 16 * w + 4 * g + j) * 128 + e0 + m]);
    f.gl = GL[c];
  };

  const int c0 = bh * 128;
  const int t0 = b * SEQ;
  ScanFrag cur, nxt;
  load(c0, cur);
  nxt = cur;
  __syncthreads();
  for (int n = 0; n < 128; ++n) {
    if (n + 1 < 128) load(c0 + n + 1, nxt);
    f32x4 av = {0.f, 0.f, 0.f, 0.f}, aq = {0.f, 0.f, 0.f, 0.f};
#pragma unroll
    for (int ks = 0; ks < 4; ++ks) {
      const bf16x8 sf = *(const bf16x8*)(ST + m * 136 + 32 * ks + 8 * g);
      av = MFMA16(cur.wf[ks], sf, av);
      aq = MFMA16(cur.qf[ks], sf, aq);
    }
    float vn[4];
#pragma unroll
    for (int j = 0; j < 4; ++j) vn[j] = cur.uf[j] - av[j];
    *(uint2*)(VT + m * 72 + 16 * w + 4 * g) = make_uint2(pack2(vn[0], vn[1]), pack2(vn[2], vn[3]));
    __syncthreads();
    bf16x8 vf[2];
#pragma unroll
    for (int ks = 0; ks < 2; ++ks) vf[ks] = *(const bf16x8*)(VT + m * 72 + 32 * ks + 8 * g);
#pragma unroll
    for (int ks = 0; ks < 2; ++ks) aq = MFMA16(cur.inf[ks], vf[ks], aq);
#pragma unroll
    for (int j = 0; j < 4; ++j)
      ymix[(size_t)(t0 + n * 64 + 16 * w + 4 * g + j) * 1024 + 512 + h * 128 + e0 + m] = f2bf(aq[j]);
#pragma unroll
    for (int mt = 0; mt < 2; ++mt) {
#pragma unroll
      for (int j = 0; j < 4; ++j) Sacc[mt][j] *= cur.gl;
#pragma unroll
      for (int ks = 0; ks < 2; ++ks) Sacc[mt] = MFMA16(cur.kf[mt][ks], vf[ks], Sacc[mt]);
      *(uint2*)(ST + m * 136 + 32 * w + 16 * mt + 4 * g) = make_uint2(pack2(Sacc[mt][0], Sacc[mt][1]), pack2(Sacc[mt][2], Sacc[mt][3]));
    }
    __syncthreads();
    cur = nxt;
  }
}

DI void phase_gate(const Params& p) {
  char* ws = p.ws;
  const u16* proj = (const u16*)(ws + OFF_PROJ);
  u16* ymix = (u16*)(ws + OFF_YMIX);
  for (int item = blockIdx.x * 256 + tidx(); item < T_TOK * 64; item += gridDim.x * 256) {
    const int t = item >> 6, hh = (item >> 4) & 3, part = item & 15;
    u16* op = ymix + (size_t)t * 1024 + 512 + hh * 128 + part * 8;
    float o[8], z[8];
    unpack8(*(const uint4*)op, o);
    unpack8(*(const uint4*)(proj + (size_t)t * INC + 3072 + hh * 128 + part * 8), z);
    float ss = 0.f;
#pragma unroll
    for (int c = 0; c < 8; ++c) ss += o[c] * o[c];
    ss += __shfl_xor(ss, 1); ss += __shfl_xor(ss, 2); ss += __shfl_xor(ss, 4); ss += __shfl_xor(ss, 8);
    const float rn = rsqrtf(ss * (1.f / 128.f) + EPS);
    const float4 g0 = *(const float4*)(p.dn_norm + part * 8), g1 = *(const float4*)(p.dn_norm + part * 8 + 4);
    const float gg[8] = {g0.x, g0.y, g0.z, g0.w, g1.x, g1.y, g1.z, g1.w};
#pragma unroll
    for (int c = 0; c < 8; ++c) o[c] = o[c] * rn * gg[c] * silu_f(z[c]);
    *(uint4*)op = pack8(o);
  }
}

DI void phase_attn(const Params& p, char* smem) {
  char* ws = p.ws;
  const int tid = tidx(), lane = tid & 63, wave = tid >> 6, m = lane & 15, g = lane >> 4;
  const u16* QX = (const u16*)(ws + OFF_QX);
  const u16* KX = (const u16*)(ws + OFF_KX);
  const u16* VTp = (const u16*)(ws + OFF_VT);
  u16* OX = (u16*)(ws + OFF_OX);
  u16* Kc = (u16*)smem;
  u16* Vc = (u16*)(smem + 34816);
  for (int job = blockIdx.x; job < 2048; job += gridDim.x) {
    const int head = job & 3, qt = (job >> 2) & 127, b = job >> 9;
    const size_t qrow = (size_t)b * SEQ + qt * 64 + wave * 16;
    bf16x8 qf[8];
#pragma unroll
    for (int ks = 0; ks < 8; ++ks) qf[ks] = *(const bf16x8*)(QX + (qrow + m) * 1024 + head * 256 + 32 * ks + 8 * g);
    const u16* kb = KX + (size_t)(b * 4 + head) * 65536;
    const u16* vb = VTp + (size_t)(b * 4 + head) * 65536;
    f32x4 s[16];
#pragma unroll
    for (int mt = 0; mt < 16; ++mt) s[mt] = {0.f, 0.f, 0.f, 0.f};
#pragma unroll
    for (int kc = 0; kc < 4; ++kc) {
      {
        const u16* gsrc = kb + (size_t)(kc * 64 + (tid >> 5)) * 256 + (tid & 31) * 8;
        u16* ldst = Kc + (tid >> 5) * 264 + (tid & 31) * 8;
        asm volatile("" : "+v"(ldst));
#pragma unroll
        for (int i = 0; i < 8; ++i) *(uint4*)(ldst + i * 8 * 264) = *(const uint4*)(gsrc + i * 8 * 256);
      }
      __syncthreads();
      const u16* kbase = Kc + m * 264 + 8 * g;
      asm volatile("" : "+v"(kbase));
#pragma unroll
      for (int mt2 = 0; mt2 < 4; ++mt2)
#pragma unroll
        for (int ks = 0; ks < 8; ++ks) {
          const bf16x8 a = *(const bf16x8*)(kbase + 16 * mt2 * 264 + 32 * ks);
          s[kc * 4 + mt2] = MFMA16(a, qf[ks], s[kc * 4 + mt2]);
          if (ks == 7) asm volatile("" ::: "memory");
        }
      __syncthreads();
    }
    float mx = -1e30f;
#pragma unroll
    for (int mt = 0; mt < 16; ++mt)
#pragma unroll
      for (int j = 0; j < 4; ++j) { s[mt][j] *= 0.0625f; mx = fmaxf(mx, s[mt][j]); }
    mx = fmaxf(mx, __shfl_xor(mx, 16)); mx = fmaxf(mx, __shfl_xor(mx, 32));
    float sum = 0.f;
#pragma unroll
    for (int mt = 0; mt < 16; ++mt)
#pragma unroll
      for (int j = 0; j < 4; ++j) { s[mt][j] = __expf(s[mt][j] - mx); sum += s[mt][j]; }
    sum += __shfl_xor(sum, 16); sum += __shfl_xor(sum, 32);
    const float inv = 1.f / sum;
    bf16x8 pf[8];
#pragma unroll
    for (int k2 = 0; k2 < 8; ++k2) {
      uint4 u = make_uint4(pack2(s[2 * k2][0], s[2 * k2][1]), pack2(s[2 * k2][2], s[2 * k2][3]),
                           pack2(s[2 * k2 + 1][0], s[2 * k2 + 1][1]), pack2(s[2 * k2 + 1][2], s[2 * k2 + 1][3]));
      pf[k2] = __builtin_bit_cast(bf16x8, u);
    }
    float invr[4];
#pragma unroll
    for (int j = 0; j < 4; ++j) invr[j] = __shfl(inv, 4 * g + j);
    f32x4 o[16];
#pragma unroll
    for (int nt = 0; nt < 16; ++nt) o[nt] = {0.f, 0.f, 0.f, 0.f};
#pragma unroll
    for (int vc = 0; vc < 4; ++vc) {
      {
        const u16* gsrc = vb + (size_t)(tid >> 3) * 256 + vc * 64 + (tid & 7) * 8;
        u16* ldst = Vc + (tid >> 3) * 72 + (tid & 7) * 8;
        asm volatile("" : "+v"(ldst));
#pragma unroll
        for (int i = 0; i < 8; ++i) *(uint4*)(ldst + i * 32 * 72) = *(const uint4*)(gsrc + i * 32 * 256);
      }
      __syncthreads();
      const u16* vbase = Vc + m * 72 + 4 * g;
      asm volatile("" : "+v"(vbase));
#pragma unroll
      for (int nt = 0; nt < 16; ++nt) {
#pragma unroll
        for (int k2l = 0; k2l < 2; ++k2l) {
          const uint2 lo = *(const uint2*)(vbase + 16 * nt * 72 + 32 * k2l);
          const uint2 hi = *(const uint2*)(vbase + 16 * nt * 72 + 32 * k2l + 16);
          const uint4 u = make_uint4(lo.x, lo.y, hi.x, hi.y);
          o[nt] = MFMA16(pf[2 * vc + k2l], __builtin_bit_cast(bf16x8, u), o[nt]);
        }
        if ((nt & 3) == 3) asm volatile("" ::: "memory");
      }
      __syncthreads();
    }
#pragma unroll
    for (int j = 0; j < 4; ++j) {
      u16* ob = OX + (qrow + 4 * g + j) * 1024 + head * 256 + m;
      asm volatile("" : "+v"(ob));
#pragma unroll
      for (int nt = 0; nt < 16; ++nt) ob[16 * nt] = f2bf(o[nt][j] * invr[j]);
    }
  }
}

DI uint32_t ordf(float f) { uint32_t u = __float_as_uint(f); return u ^ ((uint32_t)((int32_t)u >> 31) | 0x80000000u); }
DI float unordf(uint32_t k) { return __uint_as_float(k ^ ((~(uint32_t)((int32_t)k >> 31)) | 0x80000000u)); }
DI void ins32(uint32_t (&top)[16], uint32_t x) {
#pragma unroll
  for (int i = 0; i < 16; ++i) { const uint32_t hi = max(top[i], x); x = min(top[i], x); top[i] = hi; }
}
DI void ins64(uint32_t (&tk)[16], uint32_t (&tv)[16], uint32_t xk, uint32_t xv) {
#pragma unroll
  for (int i = 0; i < 16; ++i) {
    const bool gt = xk > tk[i];
    const uint32_t nk = gt ? xk : tk[i], nv = gt ? xv : tv[i];
    xk = gt ? tk[i] : xk; xv = gt ? tv[i] : xv;
    tk[i] = nk; tv[i] = nv;
  }
}

__device__ constexpr int PAIR_I[50] = {0,0,0,0,0,0,0,0,0,0,0,0,0,0,0,0,1,1,1,1,1,1,1,1,2,2,2,2,2,3,3,3,3,4,4,4,5,5,6,6,7,7,8,9,10,11,12,13,14,15};
__device__ constexpr int PAIR_J[50] = {0,1,2,3,4,5,6,7,8,9,10,11,12,13,14,15,0,1,2,3,4,5,6,7,0,1,2,3,4,0,1,2,3,0,1,2,0,1,0,1,0,1,0,0,0,0,0,0,0,0};

DI void phase_topk(const Params& p) {
  char* ws = p.ws;
  const int lane = tidx() & 63, l31 = lane & 31, hh = lane >> 5;
  const uint32_t hh4 = (uint32_t)hh << 2;
  const u16* PQ = (const u16*)(ws + OFF_PQ);
  const u16* KEYS = (const u16*)(ws + OFF_KEYS);
  int* SELI = (int*)(ws + OFF_SELI);
  float* SELG = (float*)(ws + OFF_SELG);
  const int gw = blockIdx.x * 4 + (tidx() >> 6), nw = gridDim.x * 4;
  for (int job = gw; job < 1024 * 8; job += nw) {
    const int hd = job & 7, tt = job >> 3;
    const size_t tok = (size_t)tt * 32 + l31;
    uint32_t top[2][16];
#pragma unroll
    for (int pp = 0; pp < 2; ++pp) {
      bf16x8 qf[4];
#pragma unroll
      for (int ks = 0; ks < 4; ++ks) qf[ks] = *(const bf16x8*)(PQ + tok * 1024 + hd * 128 + pp * 64 + 16 * ks + 8 * hh);
      f32x16 acc[4];
#pragma unroll
      for (int mt = 0; mt < 4; ++mt) {
#pragma unroll
        for (int i = 0; i < 16; ++i) acc[mt][i] = 0.f;
#pragma unroll
        for (int ks = 0; ks < 4; ++ks) {
          const bf16x8 a = *(const bf16x8*)(KEYS + (size_t)((hd * 2 + pp) * 128 + 32 * mt + l31) * 64 + 16 * ks + 8 * hh);
          acc[mt] = MFMA32(a, qf[ks], acc[mt]);
        }
      }
#pragma unroll
      for (int i = 0; i < 16; ++i) top[pp][i] = 0u;
#pragma unroll
      for (int mt = 0; mt < 4; ++mt)
#pragma unroll
        for (int i = 0; i < 16; ++i) {
          const uint32_t kc = (uint32_t)(127 - (32 * mt + (i & 3) + 8 * (i >> 2)));
          ins32(top[pp], ((ordf(acc[mt][i]) & 0xFFFFFF80u) | kc) ^ hh4);
        }
      uint32_t c[16];
#pragma unroll
      for (int i = 0; i < 16; ++i) c[i] = max(top[pp][i], (uint32_t)__shfl_xor((int)top[pp][15 - i], 32));
#pragma unroll
      for (int st = 8; st >= 1; st >>= 1)
#pragma unroll
        for (int i = 0; i < 16; ++i)
          if ((i & st) == 0) { const uint32_t hi = max(c[i], c[i + st]), lo = min(c[i], c[i + st]); c[i] = hi; c[i + st] = lo; }
#pragma unroll
      for (int i = 0; i < 16; ++i) top[pp][i] = c[i];
    }
    uint32_t tk[16], tv[16];
#pragma unroll
    for (int i = 0; i < 16; ++i) { tk[i] = 0u; tv[i] = 0u; }
#pragma unroll
    for (int q = 0; q < 25; ++q) {
      const int ia = PAIR_I[2 * q], ja = PAIR_J[2 * q], ib = PAIR_I[2 * q + 1], jb = PAIR_J[2 * q + 1];
      const uint32_t k1 = hh ? top[0][ib] : top[0][ia];
      const uint32_t k2 = hh ? top[1][jb] : top[1][ja];
      const float xs = unordf(k1 & 0xFFFFFF80u) + unordf(k2 & 0xFFFFFF80u);
      const uint32_t xv = (127u - (k1 & 127u)) * 128u + (127u - (k2 & 127u));
      ins64(tk, tv, ordf(xs), xv);
    }
    {
      uint32_t ck[16], cv[16];
#pragma unroll
      for (int i = 0; i < 16; ++i) {
        const uint32_t ok = (uint32_t)__shfl_xor((int)tk[15 - i], 32), ov = (uint32_t)__shfl_xor((int)tv[15 - i], 32);
        const bool gt = ok > tk[i];
        ck[i] = gt ? ok : tk[i]; cv[i] = gt ? ov : tv[i];
      }
#pragma unroll
      for (int i = 0; i < 16; ++i) { tk[i] = ck[i]; tv[i] = cv[i]; }
    }
    float e[16], sum = 0.f;
    uint32_t mk = tk[0];
#pragma unroll
    for (int i = 1; i < 16; ++i) mk = max(mk, tk[i]);
    const float mx = unordf(mk);
#pragma unroll
    for (int i = 0; i < 16; ++i) { e[i] = __expf(unordf(tk[i]) - mx); sum += e[i]; }
    const float inv = 1.f / sum;
    int* ip = SELI + (tok * 8 + hd) * 16;
    float* gp = SELG + (tok * 8 + hd) * 16;
    if (hh == 0) {
      *(uint4*)ip = make_uint4(tv[0], tv[1], tv[2], tv[3]);
      *(uint4*)(ip + 4) = make_uint4(tv[4], tv[5], tv[6], tv[7]);
      *(uint4*)(ip + 8) = make_uint4(tv[8], tv[9], tv[10], tv[11]);
      *(uint4*)(ip + 12) = make_uint4(tv[12], tv[13], tv[14], tv[15]);
      *(float4*)gp = make_float4(e[0] * inv, e[1] * inv, e[2] * inv, e[3] * inv);
      *(float4*)(gp + 4) = make_float4(e[4] * inv, e[5] * inv, e[6] * inv, e[7] * inv);
      *(float4*)(gp + 8) = make_float4(e[8] * inv, e[9] * inv, e[10] * inv, e[11] * inv);
      *(float4*)(gp + 12) = make_float4(e[12] * inv, e[13] * inv, e[14] * inv, e[15] * inv);
    }
  }
}

DI bf16x8 fp8x8_to_bf16(uint32_t d0, uint32_t d1) {
  const bf16x2v c0 = __builtin_amdgcn_cvt_scalef32_pk_bf16_fp8((int)d0, 1.0f, false);
  const bf16x2v c1 = __builtin_amdgcn_cvt_scalef32_pk_bf16_fp8((int)d0, 1.0f, true);
  const bf16x2v c2 = __builtin_amdgcn_cvt_scalef32_pk_bf16_fp8((int)d1, 1.0f, false);
  const bf16x2v c3 = __builtin_amdgcn_cvt_scalef32_pk_bf16_fp8((int)d1, 1.0f, true);
  const uint4 u = make_uint4(__builtin_bit_cast(uint32_t, c0), __builtin_bit_cast(uint32_t, c1), __builtin_bit_cast(uint32_t, c2), __builtin_bit_cast(uint32_t, c3));
  return __builtin_bit_cast(bf16x8, u);
}

DI void phase_peer(const Params& p, char* smem, float* dst) {
  char* ws = p.ws;
  const int tid = tidx(), lane = tid & 63, wave = tid >> 6, m = lane & 15, g = lane >> 4;
  const u16* HB = (const u16*)(ws + OFF_XB);
  const unsigned char* EU = (const unsigned char*)(ws + OFF_EU);
  const unsigned char* EV = (const unsigned char*)(ws + OFF_EV);
  const int* SELI = (const int*)(ws + OFF_SELI);
  const float* SELG = (const float*)(ws + OFF_SELG);
  const float* SSQ = (const float*)(ws + OFF_SSQ2);
  float* coef = (float*)(smem + wave * 1024);
  int* idxs = (int*)(smem + wave * 1024 + 512);
  for (int tile = blockIdx.x; tile < T_TOK / 4; tile += gridDim.x) {
    const size_t t = (size_t)tile * 4 + wave;
    const float4 q0 = *(const float4*)(SSQ + t * 8), q1 = *(const float4*)(SSQ + t * 8 + 4);
    const float rstd = rsqrtf((q0.x + q0.y + q0.z + q0.w + q1.x + q1.y + q1.z + q1.w) * (1.f / 1024.f) + EPS) * (1.f / EU_SCALE);
    int myidx[8];
#pragma unroll
    for (int grp = 0; grp < 8; ++grp) myidx[grp] = SELI[t * 128 + grp * 16 + m];
    f32x4 acc[8];
#pragma unroll
    for (int grp = 0; grp < 8; ++grp) acc[grp] = {0.f, 0.f, 0.f, 0.f};
    for (int kb2 = 0; kb2 < 8; ++kb2) {
      bf16x8 xf[4];
#pragma unroll
      for (int j = 0; j < 4; ++j) xf[j] = *(const bf16x8*)(HB + t * 1024 + kb2 * 128 + g * 32 + 8 * j);
      uint4 raw0[8], raw1[8];
#pragma unroll
      for (int grp = 0; grp < 8; ++grp) {
        const unsigned char* up = EU + (size_t)myidx[grp] * 1024 + kb2 * 128 + g * 32;
        raw0[grp] = *(const uint4*)up;
        raw1[grp] = *(const uint4*)(up + 16);
      }
#pragma unroll
      for (int grp = 0; grp < 8; ++grp) {
        acc[grp] = MFMA16(fp8x8_to_bf16(raw0[grp].x, raw0[grp].y), xf[0], acc[grp]);
        acc[grp] = MFMA16(fp8x8_to_bf16(raw0[grp].z, raw0[grp].w), xf[1], acc[grp]);
        acc[grp] = MFMA16(fp8x8_to_bf16(raw1[grp].x, raw1[grp].y), xf[2], acc[grp]);
        acc[grp] = MFMA16(fp8x8_to_bf16(raw1[grp].z, raw1[grp].w), xf[3], acc[grp]);
      }
    }
    if (g == 0) {
#pragma unroll
      for (int grp = 0; grp < 8; ++grp) idxs[grp * 16 + m] = myidx[grp];
    }
    if (m == 0) {
#pragma unroll
      for (int grp = 0; grp < 8; ++grp)
#pragma unroll
        for (int j = 0; j < 4; ++j) {
          const int e = grp * 16 + 4 * g + j;
          const float a = acc[grp][j] * rstd;
          const float ge = 0.5f * a * (1.f + erff(a * 0.7071067811865475f));
          coef[e] = SELG[t * 128 + e] * ge * (1.f / EV_SCALE);
        }
    }
    __syncthreads();
    f32x2 y[8];
#pragma unroll
    for (int i = 0; i < 8; ++i) y[i] = {0.f, 0.f};
#pragma unroll 8
    for (int e = 0; e < 128; ++e) {
      const float c = coef[e];
      const f32x2 c2 = {c, c};
      const uint4 r = *(const uint4*)(EV + (size_t)idxs[e] * 1024 + lane * 16);
      y[0] += c2 * __builtin_amdgcn_cvt_pk_f32_fp8((int)r.x, false);
      y[1] += c2 * __builtin_amdgcn_cvt_pk_f32_fp8((int)r.x, true);
      y[2] += c2 * __builtin_amdgcn_cvt_pk_f32_fp8((int)r.y, false);
      y[3] += c2 * __builtin_amdgcn_cvt_pk_f32_fp8((int)r.y, true);
      y[4] += c2 * __builtin_amdgcn_cvt_pk_f32_fp8((int)r.z, false);
      y[5] += c2 * __builtin_amdgcn_cvt_pk_f32_fp8((int)r.z, true);
      y[6] += c2 * __builtin_amdgcn_cvt_pk_f32_fp8((int)r.w, false);
      y[7] += c2 * __builtin_amdgcn_cvt_pk_f32_fp8((int)r.w, true);
    }
    const float* hp = p.out + t * 1024 + lane * 16;
    float* dp = dst + t * 1024 + lane * 16;
    float hv[16];
#pragma unroll
    for (int q = 0; q < 4; ++q) { const float4 h4 = *(const float4*)(hp + 4 * q); hv[4 * q] = h4.x; hv[4 * q + 1] = h4.y; hv[4 * q + 2] = h4.z; hv[4 * q + 3] = h4.w; }
    float ss = 0.f;
#pragma unroll
    for (int i = 0; i < 8; ++i) { hv[2 * i] += y[i][0]; hv[2 * i + 1] += y[i][1]; }
#pragma unroll
    for (int i = 0; i < 16; ++i) ss += hv[i] * hv[i];
    ss = wave_sum(ss);
    const float rn = rsqrtf(ss * (1.f / 1024.f) + EPS);
#pragma unroll
    for (int q = 0; q < 4; ++q) {
      const float4 n4 = *(const float4*)(p.norm_final + lane * 16 + 4 * q);
      *(float4*)(dp + 4 * q) = make_float4(hv[4 * q] * rn * n4.x, hv[4 * q + 1] * rn * n4.y, hv[4 * q + 2] * rn * n4.z, hv[4 * q + 3] * rn * n4.w);
    }
    __syncthreads();
  }
}

#define XB_TMO      128
#define XB_XCNT(j)  (256  + 64 * (j))
#define XB_XSUB(j)  (1280 + 64 * (j))
#define XB_XGEN(j)  (2304 + 64 * (j))
#define XB_TOP      3328
#define XB_TOPGEN   3392
#define XCD_BAR_WORDS 3456
#define XB_SPIN_CAP (1u << 22)
#define LAS __attribute__((address_space(3)))
DI unsigned xb_ld(unsigned* p)              { return __hip_atomic_load(p, __ATOMIC_RELAXED, __HIP_MEMORY_SCOPE_AGENT); }
DI unsigned xb_add(unsigned* p, unsigned v) { return __hip_atomic_fetch_add(p, v, __ATOMIC_RELAXED, __HIP_MEMORY_SCOPE_AGENT); }
DI unsigned xb_xcc_id() { return (unsigned)__builtin_amdgcn_s_getreg((3 << 11) | 20) & 0xFu; }
#define XB_SPIN(cond, bar) do { unsigned _sp = 0; while (cond) { __builtin_amdgcn_s_sleep(1); \
    if ((++_sp & 255u) == 0u) { if (xb_ld(&(bar)[XB_TMO])) break; if (_sp > XB_SPIN_CAP) { atomicAdd(&(bar)[XB_TMO], 1u); break; } } } } while (0)
struct XcdBarrier { unsigned* bar; unsigned x; volatile LAS unsigned* st; };
DI XcdBarrier xcd_barrier_post(unsigned* bar, volatile LAS unsigned* st) {
  XcdBarrier b; b.bar = bar; b.x = xb_xcc_id(); b.st = st;
  if (__builtin_amdgcn_workitem_id_x() == 0) (void)xb_add(&bar[XB_XCNT(b.x)], 1u);
  return b;
}
DI void xcd_barrier_complete(unsigned* bar, unsigned x, unsigned& nloc, unsigned& nx) {
  const unsigned G = gridDim.x * gridDim.y * gridDim.z;
  unsigned sum, cnt, mine, sp = 0u;
  for (;;) {
    sum = 0u; cnt = 0u; mine = 0u;
#pragma unroll
    for (unsigned j = 0; j < 16; ++j) { const unsigned c = xb_ld(&bar[XB_XCNT(j)]); sum += c; cnt += (c > 0u) ? 1u : 0u; mine = (j == x) ? c : mine; }
    if (sum == G) break;
    __builtin_amdgcn_s_sleep(1);
    if ((++sp & 255u) == 0u) { if (xb_ld(&bar[XB_TMO])) break; if (sp > XB_SPIN_CAP) { atomicAdd(&bar[XB_TMO], 1u); break; } }
  }
  nloc = mine > 0u ? mine : 1u; nx = cnt > 0u ? cnt : 1u;
}
DI void xcd_barrier(const XcdBarrier& b) {
  asm volatile("s_waitcnt vmcnt(0)" ::: "memory");
  __syncthreads();
  if (__builtin_amdgcn_workitem_id_x() == 0) {
    unsigned* bar = b.bar;
    __builtin_amdgcn_s_waitcnt(0);
    unsigned nloc = b.st[0], nx = b.st[1];
    if (nloc == 0u) { xcd_barrier_complete(bar, b.x, nloc, nx); b.st[0] = nloc; b.st[1] = nx; }
    const unsigned old = xb_add(&bar[XB_XSUB(b.x)], 1u);
    const unsigned gen = old / nloc;
    if (old + 1u == (gen + 1u) * nloc) {
      __builtin_amdgcn_fence(__ATOMIC_RELEASE, "agent");
      asm volatile("s_waitcnt vmcnt(0)" ::: "memory");
      const unsigned og = xb_add(&bar[XB_TOP], 1u);
      const unsigned tg = og / nx;
      if (og + 1u == (tg + 1u) * nx) xb_add(&bar[XB_TOPGEN], 1u);
      else XB_SPIN(xb_ld(&bar[XB_TOPGEN]) == tg, bar);
      __builtin_amdgcn_fence(__ATOMIC_ACQUIRE, "agent");
      xb_add(&bar[XB_XGEN(b.x)], 1u);
      asm volatile("s_waitcnt vmcnt(0)" ::: "memory");
    } else {
      XB_SPIN(xb_ld(&bar[XB_XGEN(b.x)]) == gen, bar);
      __builtin_amdgcn_fence(__ATOMIC_ACQUIRE, "agent");
      asm volatile("s_waitcnt vmcnt(0)" ::: "memory");
    }
  }
  __syncthreads();
}

__global__ void __launch_bounds__(256, 2) fwd_kernel(Params p, int ph_lo, int ph_hi) {
  extern __shared__ __attribute__((aligned(16))) char smem[];
  char* ws = p.ws;
#ifndef DOUBLE_MASK
#define DOUBLE_MASK 0
#endif
  const bool multi = (ph_hi - ph_lo) > 1;
  XcdBarrier xb;
  if (multi) {
    volatile LAS unsigned* st = (volatile LAS unsigned*)(smem + SMEM_BYTES - 16);
    if (__builtin_amdgcn_workitem_id_x() == 0) { st[0] = 0u; st[1] = 0u; }
    __syncthreads();
    xb = xcd_barrier_post((unsigned*)(ws + OFF_BAR), st);
  }
  if (ph_lo < -1000) cg::this_grid().sync();
#define RUN_PHASE(k, call) if (ph_lo <= (k) && (k) < ph_hi) { \
    _Pragma("unroll 1") for (int rep = ((DOUBLE_MASK >> (k)) & 1); rep >= 0; --rep) { call; if (rep > 0 || (k) + 1 < ph_hi) xcd_barrier(xb); } }
  RUN_PHASE(0, phase_prep(p, smem))
  RUN_PHASE(1, phase_proj(p, smem))
  RUN_PHASE(2, phase_chunks(p, smem))
  RUN_PHASE(3, phase_scan(p, smem))
  RUN_PHASE(4, phase_gate(p))
  RUN_PHASE(5, phase_resid((const u16*)(ws + OFF_YMIX), (const u16*)(ws + OFF_WOUT), p.x, p.out, (u16*)(ws + OFF_XB), (float*)(ws + OFF_SSQ1), smem))
  RUN_PHASE(6, phase_scaled((const u16*)(ws + OFF_XB), (const u16*)(ws + OFF_WXQ), (const float*)(ws + OFF_SSQ1), (u16*)(ws + OFF_QX), smem))
  RUN_PHASE(7, phase_attn(p, smem))
  RUN_PHASE(8, phase_resid((const u16*)(ws + OFF_OX), (const u16*)(ws + OFF_WXO), p.out, p.out, (u16*)(ws + OFF_XB), (float*)(ws + OFF_SSQ2), smem))
  RUN_PHASE(9, phase_scaled((const u16*)(ws + OFF_XB), (const u16*)(ws + OFF_WPQ), (const float*)(ws + OFF_SSQ2), (u16*)(ws + OFF_PQ), smem))
  RUN_PHASE(10, phase_topk(p))
#if (DOUBLE_MASK >> 11) & 1
  if (ph_lo <= 11 && 11 < ph_hi) { phase_peer(p, smem, (float*)(ws + OFF_PROJ)); xcd_barrier(xb); }
#endif
  if (ph_lo <= 11 && 11 < ph_hi) phase_peer(p, smem, p.out);
}

extern "C" void kernel_launch(void* const* d_in, const int* in_sizes, int n_in, void* d_out, int out_size, void* d_ws, size_t ws_size,
                              hipStream_t stream) {
  static int grid = 0;
  if (grid == 0) {
    if (n_in != 21 || out_size != T_TOK * DM || ws_size < WS_END) {
      fprintf(stderr, "kernel_launch: unexpected shapes (n_in %d out %d ws %zu need %zu)\n", n_in, out_size, ws_size, (size_t)WS_END);
      grid = -1;
      return;
    }
    int dev = 0, cus = 0, per_cu = 0;
    hipGetDevice(&dev);
    hipDeviceGetAttribute(&cus, hipDeviceAttributeMultiprocessorCount, dev);
    hipFuncSetAttribute((const void*)fwd_kernel, hipFuncAttributeMaxDynamicSharedMemorySize, SMEM_BYTES);
    hipOccupancyMaxActiveBlocksPerMultiprocessor(&per_cu, (const void*)fwd_kernel, 256, SMEM_BYTES);
    if (per_cu < 1) per_cu = 1;
    if (per_cu > 2) per_cu = 2;
    grid = cus * per_cu;
    if (grid < 128) { fprintf(stderr, "kernel_launch: grid %d too small\n", grid); grid = -1; return; }
  }
  if (grid < 0) return;
  Params p{};
  const float** pp = (const float**)&p;
  for (int i = 0; i < 21; ++i) pp[i] = (const float*)d_in[i];
  p.out = (float*)d_out;
  p.ws = (char*)d_ws;
#if ONE_LAUNCH
  hipMemsetAsync((char*)d_ws + OFF_BAR, 0, BAR_BYTES, stream);
  int lo = 0, hi = NPH;
  void* args[] = {&p, &lo, &hi};
  hipError_t e = hipLaunchCooperativeKernel((const void*)fwd_kernel, dim3(grid), dim3(256), args, SMEM_BYTES, stream);
  if (e != hipSuccess) fprintf(stderr, "cooperative launch failed: %s (grid %d)\n", hipGetErrorString(e), grid);
#else
  for (int ph = 0; ph < NPH; ++ph) hipLaunchKernelGGL(fwd_kernel, dim3(grid), dim3(256), SMEM_BYTES, stream, p, ph, ph + 1);
#endif
}
```

```cpp
#include <hip/hip_runtime.h>
#include <hip/hip_cooperative_groups.h>
#include <stdint.h>
#include <stdio.h>
namespace cg = cooperative_groups;

typedef unsigned short u16;
using bf16x8 = __attribute__((ext_vector_type(8))) short;
using f32x4  = __attribute__((ext_vector_type(4))) float;
using f32x16 = __attribute__((ext_vector_type(16))) float;
using f32x2  = __attribute__((ext_vector_type(2))) float;
using bf16x2v = __attribute__((ext_vector_type(2))) __bf16;

#define DI __device__ __forceinline__
#define MFMA32(a, b, c) __builtin_amdgcn_mfma_f32_32x32x16_bf16((a), (b), (c), 0, 0, 0)
#define MFMA16(a, b, c) __builtin_amdgcn_mfma_f32_16x16x32_bf16((a), (b), (c), 0, 0, 0)

#ifndef ONE_LAUNCH
#define ONE_LAUNCH 1
#endif

constexpr int T_TOK = 32768;
constexpr int SEQ = 8192;
constexpr int DM = 1024;
constexpr int INC = 3592;
constexpr int NPH = 12;
constexpr float EPS = 1e-6f;
constexpr float EU_SCALE = 64.f, EV_SCALE = 8.f;

constexpr size_t MiB = 1024ull * 1024ull;
constexpr size_t OFF_WIN  = 0;
constexpr size_t OFF_WOUT = OFF_WIN + 3712ull * 1024 * 2;
constexpr size_t OFF_WXQ  = OFF_WOUT + 2 * MiB;
constexpr size_t OFF_WXKV = OFF_WXQ + 2 * MiB;
constexpr size_t OFF_WXO  = OFF_WXKV + 4 * MiB;
constexpr size_t OFF_WPQ  = OFF_WXO + 2 * MiB;
constexpr size_t OFF_KEYS = OFF_WPQ + 2 * MiB;
constexpr size_t OFF_EU   = OFF_KEYS + 262144;
constexpr size_t OFF_EV   = OFF_EU + 32 * MiB;
constexpr size_t OFF_XB   = OFF_EV + 32 * MiB;
constexpr size_t OFF_MEMB = OFF_XB + 64 * MiB;
constexpr size_t OFF_KX   = OFF_MEMB + 2 * MiB;
constexpr size_t OFF_VT   = OFF_KX + 2 * MiB;
constexpr size_t OFF_RSTD0 = OFF_VT + 2 * MiB;
constexpr size_t OFF_RSTDM = OFF_RSTD0 + 131072;
constexpr size_t OFF_SSQ1 = OFF_RSTDM + 4096;
constexpr size_t OFF_SSQ2 = OFF_SSQ1 + 1 * MiB;
constexpr size_t OFF_BA   = OFF_SSQ2 + 1 * MiB;
constexpr size_t OFF_GL   = OFF_BA + 1 * MiB;
constexpr size_t OFF_YMIX = OFF_GL + 8192;
constexpr size_t OFF_PROJ = OFF_YMIX + 64 * MiB;
constexpr size_t PROJ_BYTES = (size_t)T_TOK * INC * 2;
constexpr size_t OFF_BAR  = OFF_PROJ + PROJ_BYTES;
constexpr size_t BAR_BYTES = 16384;
constexpr size_t OFF_TS   = OFF_BAR + BAR_BYTES;
constexpr size_t WS_END   = OFF_TS + 4096;
constexpr size_t OFF_QX   = OFF_PROJ;
constexpr size_t OFF_OX   = OFF_PROJ + 64 * MiB;
constexpr size_t OFF_PQ   = OFF_PROJ + 128 * MiB;
constexpr size_t OFF_SELI = OFF_PROJ + 192 * MiB;
constexpr size_t OFF_SELG = OFF_PROJ + 208 * MiB;

constexpr int SMEM_BYTES = 75776;

struct Params {
  const float *x, *mem, *norm_mix, *w_in, *conv_w, *dn_conv_w, *dn_a_log, *dn_dt_bias, *dn_norm, *w_out,
      *norm_x, *norm_mem, *w_xq, *w_xkv, *w_xo, *norm_ffn, *w_pq, *peer_keys, *expert_u, *expert_v, *norm_final;
  float* out;
  char* ws;
};

DI int tidx() { int t = (int)__builtin_amdgcn_workitem_id_x(); asm volatile("" : "+v"(t)); return t; }
DI u16 f2bf(float x) { uint32_t u = __float_as_uint(x); u += 0x7fffu + ((u >> 16) & 1u); return (u16)(u >> 16); }
DI float bf2f(u16 v) { return __uint_as_float(((uint32_t)v) << 16); }
DI uint32_t pack2(float a, float b) { return (uint32_t)f2bf(a) | ((uint32_t)f2bf(b) << 16); }
DI float bflo(uint32_t u) { return __uint_as_float(u << 16); }
DI float bfhi(uint32_t u) { return __uint_as_float(u & 0xffff0000u); }
DI int crow32(int i, int h) { return (i & 3) + 8 * (i >> 2) + 4 * h; }
DI float silu_f(float v) { return v / (1.f + __expf(-v)); }
DI float wave_sum(float v) {
#pragma unroll
  for (int o = 32; o >= 1; o >>= 1) v += __shfl_xor(v, o);
  return v;
}
DI void unpack8(const uint4& r, float* f) {
  f[0] = bflo(r.x); f[1] = bfhi(r.x); f[2] = bflo(r.y); f[3] = bfhi(r.y);
  f[4] = bflo(r.z); f[5] = bfhi(r.z); f[6] = bflo(r.w); f[7] = bfhi(r.w);
}
DI uint4 pack8(const float* f) { return make_uint4(pack2(f[0], f[1]), pack2(f[2], f[3]), pack2(f[4], f[5]), pack2(f[6], f[7])); }

DI void rowconv(const float* __restrict__ src, u16* __restrict__ dst, const float* __restrict__ gain, float* __restrict__ rstd, int rows) {
  const int lane = tidx() & 63;
  const int gw = blockIdx.x * 4 + (tidx() >> 6), nw = gridDim.x * 4;
  for (int r = gw; r < rows; r += nw) {
    const float4* s = (const float4*)(src + (size_t)r * 1024);
    float4 a0 = s[lane * 2], a1 = s[lane * 2 + 1], b0 = s[128 + lane * 2], b1 = s[128 + lane * 2 + 1];
    float f[16] = {a0.x, a0.y, a0.z, a0.w, a1.x, a1.y, a1.z, a1.w, b0.x, b0.y, b0.z, b0.w, b1.x, b1.y, b1.z, b1.w};
    if (rstd) {
      float ss = 0.f;
#pragma unroll
      for (int i = 0; i < 16; ++i) ss += f[i] * f[i];
      ss = wave_sum(ss);
      if (lane == 0) rstd[r] = rsqrtf(ss * (1.f / 1024.f) + EPS);
    }
    if (gain) {
      const float4* gp = (const float4*)gain;
      float4 g0 = gp[lane * 2], g1 = gp[lane * 2 + 1], g2 = gp[128 + lane * 2], g3 = gp[128 + lane * 2 + 1];
      float gg[16] = {g0.x, g0.y, g0.z, g0.w, g1.x, g1.y, g1.z, g1.w, g2.x, g2.y, g2.z, g2.w, g3.x, g3.y, g3.z, g3.w};
#pragma unroll
      for (int i = 0; i < 16; ++i) f[i] *= gg[i];
    }
    *(uint4*)(dst + (size_t)r * 1024 + lane * 8) = pack8(f);
    *(uint4*)(dst + (size_t)r * 1024 + 512 + lane * 8) = pack8(f + 8);
  }
}


DI void rowconv8(const float* __restrict__ src, unsigned char* __restrict__ dst, const float* __restrict__ gain, float scale, int rows, int bid, int nb) {
  const int lane = tidx() & 63;
  const int gw = bid * 4 + (tidx() >> 6), nw = nb * 4;
  float gg[16];
#pragma unroll
  for (int i = 0; i < 16; ++i) gg[i] = scale;
  if (gain) {
    const float4* gp = (const float4*)(gain + lane * 16);
#pragma unroll
    for (int q = 0; q < 4; ++q) { const float4 g4 = gp[q]; gg[4 * q] *= g4.x; gg[4 * q + 1] *= g4.y; gg[4 * q + 2] *= g4.z; gg[4 * q + 3] *= g4.w; }
  }
  for (int r = gw; r < rows; r += nw) {
    const float4* s = (const float4*)(src + (size_t)r * 1024 + lane * 16);
    uint32_t o[4];
#pragma unroll
    for (int q = 0; q < 4; ++q) {
      const float4 v = s[q];
      int pk = __builtin_amdgcn_cvt_pk_fp8_f32(v.x * gg[4 * q], v.y * gg[4 * q + 1], 0, false);
      pk = __builtin_amdgcn_cvt_pk_fp8_f32(v.z * gg[4 * q + 2], v.w * gg[4 * q + 3], pk, true);
      o[q] = (uint32_t)pk;
    }
    *(uint4*)(dst + (size_t)r * 1024 + lane * 16) = make_uint4(o[0], o[1], o[2], o[3]);
  }
}

DI void transpose_tile(const float* __restrict__ W, int N, const float* __restrict__ gain, u16* __restrict__ Wt, int nt, int kt, float* tile) {
  const int t = tidx();
  const int k0 = kt * 64, n0 = nt * 64;
#pragma unroll
  for (int i = 0; i < 16; ++i) {
    int kk = i * 4 + (t >> 6), nn = t & 63;
    float v = 0.f;
    if (n0 + nn < N) v = W[(size_t)(k0 + kk) * N + n0 + nn] * (gain ? gain[k0 + kk] : 1.f);
    tile[kk * 65 + nn] = v;
  }
  __syncthreads();
#pragma unroll
  for (int i = 0; i < 16; ++i) {
    int nn = i * 4 + (t >> 6), kk = t & 63;
    if (n0 + nn < N) Wt[(size_t)(n0 + nn) * 1024 + k0 + kk] = f2bf(tile[kk * 65 + nn]);
  }
  __syncthreads();
}

DI void weight_transposes(const Params& p, char* smem, unsigned mask, int bid, int nb) {
  char* ws = p.ws;
  const int cnt_all[6] = {57 * 16, 256, 256, 512, 256, 256};
  int cnt[6], total = 0;
  for (int i = 0; i < 6; ++i) { cnt[i] = ((mask >> i) & 1u) ? cnt_all[i] : 0; total += cnt[i]; }
  for (int job = bid; job < total; job += nb) {
    int j = job, w = 0;
    while (j >= cnt[w]) { j -= cnt[w]; ++w; }
    const float* W; const float* gain; u16* dst; int N;
    switch (w) {
      case 0: W = p.w_in; gain = p.norm_mix; dst = (u16*)(ws + OFF_WIN); N = INC; break;
      case 1: W = p.w_out; gain = nullptr; dst = (u16*)(ws + OFF_WOUT); N = 1024; break;
      case 2: W = p.w_xq; gain = p.norm_x; dst = (u16*)(ws + OFF_WXQ); N = 1024; break;
      case 3: W = p.w_xkv; gain = p.norm_mem; dst = (u16*)(ws + OFF_WXKV); N = 2048; break;
      case 4: W = p.w_xo; gain = nullptr; dst = (u16*)(ws + OFF_WXO); N = 1024; break;
      default: W = p.w_pq; gain = p.norm_ffn; dst = (u16*)(ws + OFF_WPQ); N = 1024; break;
    }
    transpose_tile(W, N, gain, dst, j >> 4, j & 15, (float*)smem);
  }
}
DI void keys_convert(const Params& p, int bid, int nb) {
  u16* kd = (u16*)(p.ws + OFF_KEYS);
  for (int i = bid * 256 + tidx(); i < 131072; i += nb * 256) kd[i] = f2bf(p.peer_keys[i]);
}

DI void phase_prep(const Params& p, char* smem) {
  char* ws = p.ws;
  const bool defer = gridDim.x >= 256;
  weight_transposes(p, smem, defer ? 0x09u : 0x3Fu, blockIdx.x, gridDim.x);
  rowconv(p.x, (u16*)(ws + OFF_XB), nullptr, (float*)(ws + OFF_RSTD0), T_TOK);
  rowconv(p.mem, (u16*)(ws + OFF_MEMB), nullptr, (float*)(ws + OFF_RSTDM), 1024);
  if (!defer) {
    rowconv8(p.expert_u, (unsigned char*)(ws + OFF_EU), p.norm_ffn, EU_SCALE, 16384, blockIdx.x, gridDim.x);
    rowconv8(p.expert_v, (unsigned char*)(ws + OFF_EV), nullptr, EV_SCALE, 16384, blockIdx.x, gridDim.x);
    keys_convert(p, blockIdx.x, gridDim.x);
  }
}

typedef unsigned u32x4 __attribute__((ext_vector_type(4)));
DI void gload16(u32x4& dst, const void* p) { asm volatile("global_load_dwordx4 %0, %1, off" : "=&v"(dst) : "v"(p) : "memory"); }
DI void gwait8_all(u32x4& a0, u32x4& a1, u32x4& a2, u32x4& a3, u32x4& b0, u32x4& b1, u32x4& b2, u32x4& b3) {
  asm volatile("s_waitcnt vmcnt(0)" : "+v"(a0), "+v"(a1), "+v"(a2), "+v"(a3), "+v"(b0), "+v"(b1), "+v"(b2), "+v"(b3) : : "memory");
}
DI void gwait8_keep8(u32x4& a0, u32x4& a1, u32x4& a2, u32x4& a3, u32x4& b0, u32x4& b1, u32x4& b2, u32x4& b3) {
  asm volatile("s_waitcnt vmcnt(8)" : "+v"(a0), "+v"(a1), "+v"(a2), "+v"(a3), "+v"(b0), "+v"(b1), "+v"(b2), "+v"(b3) : : "memory");
}

DI void gemm_main(const u16* __restrict__ A, const u16* __restrict__ Bt, int m0, int n0, char* smem, f32x16 (&acc)[2][2]) {
  const int tid = tidx(), lane = tid & 63, wave = tid >> 6;
  const int wm = wave >> 1, wn = wave & 1;
  u16* As = (u16*)smem;
  u16* Bs = (u16*)(smem + 36864);
  const int srow = tid >> 3, scol = (tid & 7) * 8;
  const u16* Ap = A + (size_t)(m0 + srow) * 1024 + scol;
  const u16* Bp = Bt + (size_t)(n0 + srow) * 1024 + scol;
  u32x4 r0a[4], r0b[4], r1a[4], r1b[4];
#pragma unroll
  for (int mi = 0; mi < 2; ++mi)
#pragma unroll
    for (int ni = 0; ni < 2; ++ni)
#pragma unroll
      for (int i = 0; i < 16; ++i) acc[mi][ni][i] = 0.f;
#define ISSUE(ra_, rb_, k_) { _Pragma("unroll") for (int i = 0; i < 4; ++i) { gload16(ra_[i], Ap + (size_t)i * 32 * 1024 + (k_) * 64); gload16(rb_[i], Bp + (size_t)i * 32 * 1024 + (k_) * 64); } }
#define STORE(ra_, rb_, buf_) { u16* as2 = As + (buf_) * 128 * 72; u16* bs2 = Bs + (buf_) * 128 * 72; \
    _Pragma("unroll") for (int i = 0; i < 4; ++i) { *(u32x4*)(as2 + (srow + 32 * i) * 72 + scol) = ra_[i]; *(u32x4*)(bs2 + (srow + 32 * i) * 72 + scol) = rb_[i]; } }
  auto compute = [&](int cur) {
    const u16* as = As + cur * 128 * 72;
    const u16* bs = Bs + cur * 128 * 72;
#pragma unroll
    for (int ks = 0; ks < 4; ++ks) {
      bf16x8 a[2], b[2];
#pragma unroll
      for (int mi = 0; mi < 2; ++mi) a[mi] = *(const bf16x8*)(as + (64 * wm + 32 * mi + (lane & 31)) * 72 + 16 * ks + 8 * (lane >> 5));
#pragma unroll
      for (int ni = 0; ni < 2; ++ni) b[ni] = *(const bf16x8*)(bs + (64 * wn + 32 * ni + (lane & 31)) * 72 + 16 * ks + 8 * (lane >> 5));
#pragma unroll
      for (int mi = 0; mi < 2; ++mi)
#pragma unroll
        for (int ni = 0; ni < 2; ++ni) acc[mi][ni] = MFMA32(b[ni], a[mi], acc[mi][ni]);
    }
  };
  ISSUE(r0a, r0b, 0)
  ISSUE(r1a, r1b, 1)
  gwait8_keep8(r0a[0], r0a[1], r0a[2], r0a[3], r0b[0], r0b[1], r0b[2], r0b[3]);
  STORE(r0a, r0b, 0)
  __syncthreads();
#pragma unroll 1
  for (int kk = 0; kk < 16; kk += 2) {
    const int k2 = (kk + 2 < 16) ? kk + 2 : 15, k3 = (kk + 3 < 16) ? kk + 3 : 15;
    ISSUE(r0a, r0b, k2)
    compute(0);
    gwait8_keep8(r1a[0], r1a[1], r1a[2], r1a[3], r1b[0], r1b[1], r1b[2], r1b[3]);
    STORE(r1a, r1b, 1)
    __syncthreads();
    ISSUE(r1a, r1b, k3)
    compute(1);
    gwait8_keep8(r0a[0], r0a[1], r0a[2], r0a[3], r0b[0], r0b[1], r0b[2], r0b[3]);
    STORE(r0a, r0b, 0)
    __syncthreads();
  }
  gwait8_all(r1a[0], r1a[1], r1a[2], r1a[3], r1b[0], r1b[1], r1b[2], r1b[3]);
#undef ISSUE
#undef STORE
}

DI bool tile_map(int it, int MT, int NT, int& mt, int& nt) {
  const int nb = gridDim.x >> 3;
  if ((gridDim.x & 7) != 0) {
    const int tile = blockIdx.x + it * gridDim.x;
    if (tile >= MT * NT) return false;
    mt = tile / NT; nt = tile % NT;
    return true;
  }
  const int vx = blockIdx.x & 7, lb = blockIdx.x >> 3;
  const int per = (MT >> 3) * NT;
  const int q = it * nb + lb;
  if (q >= per) return false;
  const int grp = q / (8 * NT), r = q % (8 * NT);
  mt = vx * (MT >> 3) + grp * 8 + (r & 7);
  nt = r >> 3;
  return true;
}

DI float* rs_ptr(char* smem) { return (float*)(smem + 73728); }
DI float* sq_ptr(char* smem) { return (float*)(smem + 73728 + 512); }

DI void kv_gemm(const Params& p, char* smem, int bid, int nb);
DI void phase_proj(const Params& p, char* smem) {
  char* ws = p.ws;
  const int tid = tidx(), lane = tid & 63, wave = tid >> 6, wm = wave >> 1, wn = wave & 1, hh = lane >> 5;
  float* rs = rs_ptr(smem);
  u16* proj = (u16*)(ws + OFF_PROJ);
  float* ba = (float*)(ws + OFF_BA);
  for (int it = 0;; ++it) {
    int mt, nt;
    if (!tile_map(it, 256, 29, mt, nt)) break;
    const int m0 = mt * 128, n0 = nt * 128;
    f32x16 acc[2][2];
    gemm_main((const u16*)(ws + OFF_XB), (const u16*)(ws + OFF_WIN), m0, n0, smem, acc);
    if (tid < 128) rs[tid] = ((const float*)(ws + OFF_RSTD0))[m0 + tid];
    __syncthreads();
#pragma unroll
    for (int mi = 0; mi < 2; ++mi) {
      const int rl = 64 * wm + 32 * mi + (lane & 31);
      const float sc = rs[rl];
      const size_t row = (size_t)(m0 + rl);
#pragma unroll
      for (int ni = 0; ni < 2; ++ni)
#pragma unroll
        for (int q = 0; q < 4; ++q) {
          const int col = n0 + 64 * wn + 32 * ni + 8 * q + 4 * hh;
          const float v0 = acc[mi][ni][4 * q] * sc, v1 = acc[mi][ni][4 * q + 1] * sc, v2 = acc[mi][ni][4 * q + 2] * sc, v3 = acc[mi][ni][4 * q + 3] * sc;
          if (col < 3584) *(uint2*)(proj + row * INC + col) = make_uint2(pack2(v0, v1), pack2(v2, v3));
          else if (col < INC) *(float4*)(ba + row * 8 + (col - 3584)) = make_float4(v0, v1, v2, v3);
        }
    }
    __syncthreads();
  }
  if (gridDim.x < 256) kv_gemm(p, smem, blockIdx.x, gridDim.x);
}

DI void kv_gemm(const Params& p, char* smem, int bid, int nb) {
  char* ws = p.ws;
  const int tid = tidx(), lane = tid & 63, wave = tid >> 6, wm = wave >> 1, wn = wave & 1, hh = lane >> 5;
  float* rs = rs_ptr(smem);
  u16* kx = (u16*)(ws + OFF_KX);
  u16* vt = (u16*)(ws + OFF_VT);
  for (int t2 = bid; t2 < 128; t2 += nb) {
    const int mt = t2 >> 4, nt = t2 & 15, m0 = mt * 128, n0 = nt * 128;
    f32x16 acc[2][2];
    gemm_main((const u16*)(ws + OFF_MEMB), (const u16*)(ws + OFF_WXKV), m0, n0, smem, acc);
    if (tid < 128) rs[tid] = ((const float*)(ws + OFF_RSTDM))[m0 + tid];
    __syncthreads();
#pragma unroll
    for (int mi = 0; mi < 2; ++mi) {
      const int rl = 64 * wm + 32 * mi + (lane & 31);
      const float sc = rs[rl];
      const int row = m0 + rl, b = row >> 8, mm = row & 255;
#pragma unroll
      for (int ni = 0; ni < 2; ++ni)
#pragma unroll
        for (int q = 0; q < 4; ++q) {
          const int col = n0 + 64 * wn + 32 * ni + 8 * q + 4 * hh;
          const float v0 = acc[mi][ni][4 * q] * sc, v1 = acc[mi][ni][4 * q + 1] * sc, v2 = acc[mi][ni][4 * q + 2] * sc, v3 = acc[mi][ni][4 * q + 3] * sc;
          if (col < 1024) {
            const int head = col >> 8, d = col & 255;
            *(uint2*)(kx + ((size_t)((b * 4 + head) * 256 + mm)) * 256 + d) = make_uint2(pack2(v0, v1), pack2(v2, v3));
          } else {
            const int c2 = col - 1024, head = c2 >> 8, d = c2 & 255;
            u16* vp = vt + ((size_t)((b * 4 + head) * 256 + d)) * 256 + mm;
            vp[0] = f2bf(v0); vp[256] = f2bf(v1); vp[512] = f2bf(v2); vp[768] = f2bf(v3);
          }
        }
    }
    __syncthreads();
  }
}

DI void phase_resid(const u16* A, const u16* Bt, const float* resid, float* hout, u16* hb, float* ssq, char* smem) {
  const int tid = tidx(), lane = tid & 63, wave = tid >> 6, wm = wave >> 1, wn = wave & 1, hh = lane >> 5;
  float* sq = sq_ptr(smem);
  for (int it = 0;; ++it) {
    int mt, nt;
    if (!tile_map(it, 256, 8, mt, nt)) break;
    const int m0 = mt * 128, n0 = nt * 128;
    f32x16 acc[2][2];
    gemm_main(A, Bt, m0, n0, smem, acc);
    if (tid < 128) sq[tid] = 0.f;
    __syncthreads();
#pragma unroll
    for (int mi = 0; mi < 2; ++mi) {
      const int rl = 64 * wm + 32 * mi + (lane & 31);
      const size_t row = (size_t)(m0 + rl);
      float s2 = 0.f;
#pragma unroll
      for (int ni = 0; ni < 2; ++ni)
#pragma unroll
        for (int q = 0; q < 4; ++q) {
          const int col = n0 + 64 * wn + 32 * ni + 8 * q + 4 * hh;
          const float4 r = *(const float4*)(resid + row * 1024 + col);
          const float h0 = r.x + acc[mi][ni][4 * q], h1 = r.y + acc[mi][ni][4 * q + 1], h2 = r.z + acc[mi][ni][4 * q + 2], h3 = r.w + acc[mi][ni][4 * q + 3];
          *(float4*)(hout + row * 1024 + col) = make_float4(h0, h1, h2, h3);
          *(uint2*)(hb + row * 1024 + col) = make_uint2(pack2(h0, h1), pack2(h2, h3));
          s2 += h0 * h0 + h1 * h1 + h2 * h2 + h3 * h3;
        }
      atomicAdd(&sq[rl], s2);
    }
    __syncthreads();
    if (tid < 128) ssq[(size_t)(m0 + tid) * 8 + nt] = sq[tid];
    __syncthreads();
  }
}

DI void phase_scaled(const u16* A, const u16* Bt, const float* ssq, u16* out, char* smem) {
  const int tid = tidx(), lane = tid & 63, wave = tid >> 6, wm = wave >> 1, wn = wave & 1, hh = lane >> 5;
  float* rs = rs_ptr(smem);
  for (int it = 0;; ++it) {
    int mt, nt;
    if (!tile_map(it, 256, 8, mt, nt)) break;
    const int m0 = mt * 128, n0 = nt * 128;
    f32x16 acc[2][2];
    gemm_main(A, Bt, m0, n0, smem, acc);
    if (tid < 128) {
      const float4* sp = (const float4*)(ssq + (size_t)(m0 + tid) * 8);
      float4 s0 = sp[0], s1 = sp[1];
      rs[tid] = rsqrtf((s0.x + s0.y + s0.z + s0.w + s1.x + s1.y + s1.z + s1.w) * (1.f / 1024.f) + EPS);
    }
    __syncthreads();
#pragma unroll
    for (int mi = 0; mi < 2; ++mi) {
      const int rl = 64 * wm + 32 * mi + (lane & 31);
      const float sc = rs[rl];
#pragma unroll
      for (int ni = 0; ni < 2; ++ni)
#pragma unroll
        for (int q = 0; q < 4; ++q) {
          const int col = n0 + 64 * wn + 32 * ni + 8 * q + 4 * hh;
          *(uint2*)(out + (size_t)(m0 + rl) * 1024 + col) =
              make_uint2(pack2(acc[mi][ni][4 * q] * sc, acc[mi][ni][4 * q + 1] * sc), pack2(acc[mi][ni][4 * q + 2] * sc, acc[mi][ni][4 * q + 3] * sc));
        }
    }
    __syncthreads();
  }
}

DI void chunk_job(const Params& p, int cj, char* smem) {
  char* ws = p.ws;
  const int tid = tidx(), lane = tid & 63, wave = tid >> 6;
  const int bh = cj >> 7, n = cj & 127, b = bh >> 2, h = bh & 3;
  const int t0 = b * SEQ + n * 64;
  u16* Kb  = (u16*)smem;
  u16* Qb  = (u16*)(smem + 17408);
  u16* Vt  = (u16*)(smem + 34816);
  u16* KGt = (u16*)(smem + 53248);
  float* gc = (float*)(smem + 71680);
  float* bt = gc + 64;
  float* As = (float*)(smem + 17408);
  u16* Tb = (u16*)smem;
  const u16* proj = (const u16*)(ws + OFF_PROJ);
  u16* QD = (u16*)p.out;
  u16* KD = (u16*)((char*)p.out + 32 * MiB);
  u16* UU = (u16*)((char*)p.out + 64 * MiB);
  u16* WW = (u16*)((char*)p.out + 96 * MiB);
  u16* IN = (u16*)(ws + OFF_XB);
  float* GL = (float*)(ws + OFF_GL);

  if (wave == 0) {
    const float* ba = (const float*)(ws + OFF_BA) + (size_t)(t0 + lane) * 8;
    const float bl = ba[h], al = ba[4 + h] + p.dn_dt_bias[h];
    const float sp = fmaxf(al, 0.f) + log1pf(expf(-fabsf(al)));
    float g = -expf(p.dn_a_log[h]) * sp;
#pragma unroll
    for (int o = 1; o < 64; o <<= 1) { float v = __shfl_up(g, o); if (lane >= o) g += v; }
    gc[lane] = g;
    bt[lane] = 1.f / (1.f + expf(-bl));
    if (lane == 63) GL[cj] = expf(g);
  }
  __syncthreads();

  {
    const int cgp = tid & 15, ts = tid >> 4;
    const float glast = gc[63];
    float eg[4], ed[4], be[4];
#pragma unroll
    for (int tt = 0; tt < 4; ++tt) { const float gv = gc[4 * ts + tt]; eg[tt] = expf(gv); ed[tt] = expf(glast - gv); be[tt] = bt[4 * ts + tt]; }
#pragma unroll 1
    for (int part = 0; part < 3; ++part) {
      const int cc = part * 512 + h * 128 + cgp * 8;
      const int cb = 1536 + cc;
      float xin[7][8];
#pragma unroll
      for (int r = 0; r < 7; ++r) {
        const int sp = n * 64 + 4 * ts - 3 + r;
        if (sp >= 0) { uint4 raw = *(const uint4*)(proj + (size_t)(t0 + 4 * ts - 3 + r) * INC + cb); unpack8(raw, xin[r]); }
        else {
#pragma unroll
          for (int c = 0; c < 8; ++c) xin[r][c] = 0.f;
        }
      }
      float o[4][8];
#pragma unroll
      for (int tt = 0; tt < 4; ++tt)
#pragma unroll
        for (int c = 0; c < 8; ++c) o[tt][c] = 0.f;
#pragma unroll
      for (int j = 0; j < 4; ++j) {
        const float4 w0 = *(const float4*)(p.dn_conv_w + j * 1536 + cc), w1 = *(const float4*)(p.dn_conv_w + j * 1536 + cc + 4);
        const float wj[8] = {w0.x, w0.y, w0.z, w0.w, w1.x, w1.y, w1.z, w1.w};
#pragma unroll
        for (int tt = 0; tt < 4; ++tt)
#pragma unroll
          for (int c = 0; c < 8; ++c) o[tt][c] += wj[c] * xin[tt + j][c];
      }
#pragma unroll
      for (int tt = 0; tt < 4; ++tt)
#pragma unroll
        for (int c = 0; c < 8; ++c) o[tt][c] = silu_f(o[tt][c]);
      if (part < 2) {
#pragma unroll
        for (int tt = 0; tt < 4; ++tt) {
          float ss = 0.f;
#pragma unroll
          for (int c = 0; c < 8; ++c) ss += o[tt][c] * o[tt][c];
          ss += __shfl_xor(ss, 1); ss += __shfl_xor(ss, 2); ss += __shfl_xor(ss, 4); ss += __shfl_xor(ss, 8);
          const float rn = rsqrtf(ss + EPS) * (part == 0 ? 0.08838834764831845f : 1.f);
#pragma unroll
          for (int c = 0; c < 8; ++c) o[tt][c] *= rn;
        }
      }
      if (part == 0) {
#pragma unroll
        for (int tt = 0; tt < 4; ++tt) {
          const int tok = 4 * ts + tt;
          *(uint4*)(Qb + tok * 136 + cgp * 8) = pack8(o[tt]);
          float qd[8];
#pragma unroll
          for (int c = 0; c < 8; ++c) qd[c] = o[tt][c] * eg[tt];
          *(uint4*)(QD + ((size_t)cj * 64 + tok) * 128 + cgp * 8) = pack8(qd);
        }
      } else if (part == 1) {
#pragma unroll
        for (int tt = 0; tt < 4; ++tt) *(uint4*)(Kb + (4 * ts + tt) * 136 + cgp * 8) = pack8(o[tt]);
#pragma unroll
        for (int c = 0; c < 8; ++c) {
          const int d = cgp * 8 + c;
          *(uint2*)(KGt + d * 72 + 4 * ts) = make_uint2(pack2(o[0][c] * be[0] * eg[0], o[1][c] * be[1] * eg[1]), pack2(o[2][c] * be[2] * eg[2], o[3][c] * be[3] * eg[3]));
          *(uint2*)(KD + ((size_t)cj * 128 + d) * 64 + 4 * ts) = make_uint2(pack2(o[0][c] * ed[0], o[1][c] * ed[1]), pack2(o[2][c] * ed[2], o[3][c] * ed[3]));
        }
      } else {
#pragma unroll
        for (int c = 0; c < 8; ++c) {
          const int d = cgp * 8 + c;
          *(uint2*)(Vt + d * 72 + 4 * ts) = make_uint2(pack2(o[0][c] * be[0], o[1][c] * be[1]), pack2(o[2][c] * be[2], o[3][c] * be[3]));
        }
      }
    }
  }
  __syncthreads();

  {
    const int wi = wave >> 1, wj = wave & 1, hh = lane >> 5;
    f32x16 aK, aQ;
#pragma unroll
    for (int i = 0; i < 16; ++i) { aK[i] = 0.f; aQ[i] = 0.f; }
    if (wi >= wj) {
#pragma unroll
      for (int ks = 0; ks < 8; ++ks) {
        const bf16x8 fk = *(const bf16x8*)(Kb + (32 * wi + (lane & 31)) * 136 + 16 * ks + 8 * hh);
        const bf16x8 fq = *(const bf16x8*)(Qb + (32 * wi + (lane & 31)) * 136 + 16 * ks + 8 * hh);
        const bf16x8 fb = *(const bf16x8*)(Kb + (32 * wj + (lane & 31)) * 136 + 16 * ks + 8 * hh);
        aK = MFMA32(fk, fb, aK);
        aQ = MFMA32(fq, fb, aQ);
      }
    }
    __syncthreads();
    const int j = 32 * wj + (lane & 31);
    const float gj = gc[j];
#pragma unroll
    for (int ii = 0; ii < 16; ++ii) {
      const int i = 32 * wi + crow32(ii, hh);
      const float dec = (i >= j) ? expf(gc[i] - gj) : 0.f;
      As[i * 68 + j] = (i > j) ? aK[ii] * bt[i] * dec : 0.f;
      IN[((size_t)cj * 64 + i) * 64 + j] = f2bf((i >= j) ? aQ[ii] * dec : 0.f);
    }
  }
  __syncthreads();

  if (wave == 0) {
    float xcol[64];
#pragma unroll
    for (int i = 0; i < 64; ++i) {
      int lv = lane;
      asm volatile("" : "+v"(lv));
      float s = (i == lv) ? 1.f : 0.f;
#pragma unroll
      for (int j4 = 0; j4 < (i + 3) / 4; ++j4) {
        const float4 a4 = *(const float4*)(As + i * 68 + 4 * j4);
        if (4 * j4 + 0 < i) s -= a4.x * xcol[4 * j4 + 0];
        if (4 * j4 + 1 < i) s -= a4.y * xcol[4 * j4 + 1];
        if (4 * j4 + 2 < i) s -= a4.z * xcol[4 * j4 + 2];
        if (4 * j4 + 3 < i) s -= a4.w * xcol[4 * j4 + 3];
      }
      xcol[i] = s;
      asm volatile("" ::: "memory");
    }
#pragma unroll
    for (int i = 0; i < 64; ++i) Tb[i * 72 + lane] = f2bf(xcol[i]);
  }
  __syncthreads();

  {
    const int hh = lane >> 5;
    f32x16 aU[2], aW[2];
#pragma unroll
    for (int mi = 0; mi < 2; ++mi)
#pragma unroll
      for (int i = 0; i < 16; ++i) { aU[mi][i] = 0.f; aW[mi][i] = 0.f; }
#pragma unroll
    for (int ks = 0; ks < 4; ++ks) {
      const bf16x8 bv = *(const bf16x8*)(Vt + (32 * wave + (lane & 31)) * 72 + 16 * ks + 8 * hh);
      const bf16x8 bk = *(const bf16x8*)(KGt + (32 * wave + (lane & 31)) * 72 + 16 * ks + 8 * hh);
#pragma unroll
      for (int mi = 0; mi < 2; ++mi) {
        const bf16x8 a = *(const bf16x8*)(Tb + (32 * mi + (lane & 31)) * 72 + 16 * ks + 8 * hh);
        aU[mi] = MFMA32(a, bv, aU[mi]);
        aW[mi] = MFMA32(a, bk, aW[mi]);
      }
    }
    const int d = 32 * wave + (lane & 31);
#pragma unroll
    for (int mi = 0; mi < 2; ++mi)
#pragma unroll
      for (int ii = 0; ii < 16; ++ii) {
        const int i = 32 * mi + crow32(ii, hh);
        UU[((size_t)cj * 64 + i) * 128 + d] = f2bf(aU[mi][ii]);
        WW[((size_t)cj * 64 + i) * 128 + d] = f2bf(aW[mi][ii]);
      }
  }
  __syncthreads();
}

DI void conv_items(const Params& p, int bid, int nb) {
  char* ws = p.ws;
  const u16* proj = (const u16*)(ws + OFF_PROJ);
  u16* ymix = (u16*)(ws + OFF_YMIX);
  for (int item = bid * 256 + tidx(); item < T_TOK * 64; item += nb * 256) {
    const int t = item >> 6, c0 = (item & 63) * 8;
    const int s = t & (SEQ - 1);
    float accv[8];
#pragma unroll
    for (int c = 0; c < 8; ++c) accv[c] = 0.f;
#pragma unroll
    for (int k = 0; k < 3; ++k) {
      if (s - 2 + k >= 0) {
        const size_t row = (size_t)(t - 2 + k) * INC;
        float cg8[8], hc8[8];
        unpack8(*(const uint4*)(proj + row + 512 + c0), cg8);
        unpack8(*(const uint4*)(proj + row + 1024 + c0), hc8);
        const float4 w0 = *(const float4*)(p.conv_w + k * 512 + c0), w1 = *(const float4*)(p.conv_w + k * 512 + c0 + 4);
        const float wk[8] = {w0.x, w0.y, w0.z, w0.w, w1.x, w1.y, w1.z, w1.w};
#pragma unroll
        for (int c = 0; c < 8; ++c) accv[c] += wk[c] * cg8[c] * hc8[c];
      }
    }
    float bg[8];
    unpack8(*(const uint4*)(proj + (size_t)t * INC + c0), bg);
#pragma unroll
    for (int c = 0; c < 8; ++c) accv[c] *= bg[c];
    *(uint4*)(ymix + (size_t)t * 1024 + c0) = pack8(accv);
  }
}

DI void phase_chunks(const Params& p, char* smem) {
  char* ws = p.ws;
  for (int cj = blockIdx.x; cj < 2048; cj += gridDim.x) chunk_job(p, cj, smem);
  if (gridDim.x < 256) conv_items(p, blockIdx.x, gridDim.x);
}

struct ScanFrag {
  bf16x8 wf[4], qf[4], inf[2], kf[2][2];
  float uf[4];
  float gl;
};

DI void phase_scan(const Params& p, char* smem) {
  char* ws = p.ws;
  if (blockIdx.x >= 128) {
    if (gridDim.x >= 256) {
      const int bid = blockIdx.x - 128, nb = gridDim.x - 128;
      conv_items(p, bid, nb);
      kv_gemm(p, smem, bid, nb);
      weight_transposes(p, smem, 0x36u, bid, nb);
      keys_convert(p, bid, nb);
      rowconv8(p.expert_u, (unsigned char*)(ws + OFF_EU), p.norm_ffn, EU_SCALE, 16384, bid, nb);
      rowconv8(p.expert_v, (unsigned char*)(ws + OFF_EV), nullptr, EV_SCALE, 16384, bid, nb);
    }
    return;
  }
  const int tid = tidx(), lane = tid & 63, w = tid >> 6, m = lane & 15, g = lane >> 4;
  const int bid = blockIdx.x;
  const int bh = (bid & 7) + 8 * ((bid >> 3) & 1), sl = bid >> 4;
  const int b = bh >> 2, h = bh & 3, e0 = sl * 16;
  u16* ST = (u16*)smem;
  u16* VT = (u16*)(smem + 4352);
  const u16* QD = (const u16*)p.out;
  const u16* KD = (const u16*)((const char*)p.out + 32 * MiB);
  const u16* UU = (const u16*)((const char*)p.out + 64 * MiB);
  const u16* WW = (const u16*)((const char*)p.out + 96 * MiB);
  const u16* IN = (const u16*)(ws + OFF_XB);
  const float* GL = (const float*)(ws + OFF_GL);
  u16* ymix = (u16*)(ws + OFF_YMIX);

  for (int i = tid; i < 16 * 136 / 2; i += 256) ((uint32_t*)ST)[i] = 0u;
  f32x4 Sacc[2];
#pragma unroll
  for (int mt = 0; mt < 2; ++mt)
#pragma unroll
    for (int j = 0; j < 4; ++j) Sacc[mt][j] = 0.f;

  auto load = [&](int c, ScanFrag& f) {
    const u16* wp = WW + ((size_t)c * 64 + 16 * w + m) * 128 + 8 * g;
    const u16* qp = QD + ((size_t)c * 64 + 16 * w + m) * 128 + 8 * g;
#pragma unroll
    for (int ks = 0; ks < 4; ++ks) { f.wf[ks] = *(const bf16x8*)(wp + 32 * ks); f.qf[ks] = *(const bf16x8*)(qp + 32 * ks); }
    const u16* ip = IN + ((size_t)c * 64 + 16 * w + m) * 64 + 8 * g;
#pragma unroll
    for (int ks = 0; ks < 2; ++ks) f.inf[ks] = *(const bf16x8*)(ip + 32 * ks);
#pragma unroll
    for (int mt = 0; mt < 2; ++mt)
#pragma unroll
      for (int ks = 0; ks < 2; ++ks) f.kf[mt][ks] = *(const bf16x8*)(KD + ((size_t)c * 128 + 32 * w + 16 * mt + m) * 64 + 32 * ks + 8 * g);
#pragma unroll
    for (int j = 0; j < 4; ++j) f.uf[j] = bf2f(UU[((size_t)c * 64 + 16 * w + 4 * g + j) * 128 + e0 + m]);
    f.gl = GL[c];
  };

  const int c0 = bh * 128;
  const int t0 = b * SEQ;
  ScanFrag cur, nxt;
  load(c0, cur);
  nxt = cur;
  __syncthreads();
  for (int n = 0; n < 128; ++n) {
    if (n + 1 < 128) load(c0 + n + 1, nxt);
    f32x4 av = {0.f, 0.f, 0.f, 0.f}, aq = {0.f, 0.f, 0.f, 0.f};
#pragma unroll
    for (int ks = 0; ks < 4; ++ks) {
      const bf16x8 sf = *(const bf16x8*)(ST + m * 136 + 32 * ks + 8 * g);
      av = MFMA16(cur.wf[ks], sf, av);
      aq = MFMA16(cur.qf[ks], sf, aq);
    }
    float vn[4];
#pragma unroll
    for (int j = 0; j < 4; ++j) vn[j] = cur.uf[j] - av[j];
    *(uint2*)(VT + m * 72 + 16 * w + 4 * g) = make_uint2(pack2(vn[0], vn[1]), pack2(vn[2], vn[3]));
    __syncthreads();
    bf16x8 vf[2];
#pragma unroll
    for (int ks = 0; ks < 2; ++ks) vf[ks] = *(const bf16x8*)(VT + m * 72 + 32 * ks + 8 * g);
#pragma unroll
    for (int ks = 0; ks < 2; ++ks) aq = MFMA16(cur.inf[ks], vf[ks], aq);
#pragma unroll
    for (int j = 0; j < 4; ++j)
      ymix[(size_t)(t0 + n * 64 + 16 * w + 4 * g + j) * 1024 + 512 + h * 128 + e0 + m] = f2bf(aq[j]);
#pragma unroll
    for (int mt = 0; mt < 2; ++mt) {
#pragma unroll
      for (int j = 0; j < 4; ++j) Sacc[mt][j] *= cur.gl;
#pragma unroll
      for (int ks = 0; ks < 2; ++ks) Sacc[mt] = MFMA16(cur.kf[mt][ks], vf[ks], Sacc[mt]);
      *(uint2*)(ST + m * 136 + 32 * w + 16 * mt + 4 * g) = make_uint2(pack2(Sacc[mt][0], Sacc[mt][1]), pack2(Sacc[mt][2], Sacc[mt][3]));
    }
    __syncthreads();
    cur = nxt;
  }
}

DI void phase_gate(const Params& p) {
  char* ws = p.ws;
  const u16* proj = (const u16*)(ws + OFF_PROJ);
  u16* ymix = (u16*)(ws + OFF_YMIX);
  for (int item = blockIdx.x * 256 + tidx(); item < T_TOK * 64; item += gridDim.x * 256) {
    const int t = item >> 6, hh = (item >> 4) & 3, part = item & 15;
    u16* op = ymix + (size_t)t * 1024 + 512 + hh * 128 + part * 8;
    float o[8], z[8];
    unpack8(*(const uint4*)op, o);
    unpack8(*(const uint4*)(proj + (size_t)t * INC + 3072 + hh * 128 + part * 8), z);
    float ss = 0.f;
#pragma unroll
    for (int c = 0; c < 8; ++c) ss += o[c] * o[c];
    ss += __shfl_xor(ss, 1); ss += __shfl_xor(ss, 2); ss += __shfl_xor(ss, 4); ss += __shfl_xor(ss, 8);
    const float rn = rsqrtf(ss * (1.f / 128.f) + EPS);
    const float4 g0 = *(const float4*)(p.dn_norm + part * 8), g1 = *(const float4*)(p.dn_norm + part * 8 + 4);
    const float gg[8] = {g0.x, g0.y, g0.z, g0.w, g1.x, g1.y, g1.z, g1.w};
#pragma unroll
    for (int c = 0; c < 8; ++c) o[c] = o[c] * rn * gg[c] * silu_f(z[c]);
    *(uint4*)op = pack8(o);
  }
}

DI void phase_attn(const Params& p, char* smem) {
  char* ws = p.ws;
  const int tid = tidx(), lane = tid & 63, wave = tid >> 6, m = lane & 15, g = lane >> 4;
  const u16* QX = (const u16*)(ws + OFF_QX);
  const u16* KX = (const u16*)(ws + OFF_KX);
  const u16* VTp = (const u16*)(ws + OFF_VT);
  u16* OX = (u16*)(ws + OFF_OX);
  u16* Kc = (u16*)smem;
  u16* Vc = (u16*)(smem + 34816);
  for (int job = blockIdx.x; job < 2048; job += gridDim.x) {
    const int head = job & 3, qt = (job >> 2) & 127, b = job >> 9;
    const size_t qrow = (size_t)b * SEQ + qt * 64 + wave * 16;
    bf16x8 qf[8];
#pragma unroll
    for (int ks = 0; ks < 8; ++ks) qf[ks] = *(const bf16x8*)(QX + (qrow + m) * 1024 + head * 256 + 32 * ks + 8 * g);
    const u16* kb = KX + (size_t)(b * 4 + head) * 65536;
    const u16* vb = VTp + (size_t)(b * 4 + head) * 65536;
    const u16* ksrc = kb + (size_t)(tid >> 5) * 256 + (tid & 31) * 8;
    const u16* vsrc = vb + (size_t)(tid >> 3) * 256 + (tid & 7) * 8;
    u16* kdst = Kc + (tid >> 5) * 264 + (tid & 31) * 8;
    u16* vdst = Vc + (tid >> 3) * 72 + (tid & 7) * 8;

    u32x4 st[8];
#define ATT_ISSUE_K(c_) { _Pragma("unroll") for (int i = 0; i < 8; ++i) gload16(st[i], ksrc + (size_t)((c_) * 64 + i * 8) * 256); }
#define ATT_ISSUE_V(c_) { _Pragma("unroll") for (int i = 0; i < 8; ++i) gload16(st[i], vsrc + (size_t)(i * 32) * 256 + (c_) * 64); }
#define ATT_LAND_K() { gwait8_all(st[0], st[1], st[2], st[3], st[4], st[5], st[6], st[7]); \
                       _Pragma("unroll") for (int i = 0; i < 8; ++i) *(u32x4*)(kdst + i * 8 * 264) = st[i]; }
#define ATT_LAND_V() { gwait8_all(st[0], st[1], st[2], st[3], st[4], st[5], st[6], st[7]); \
                       _Pragma("unroll") for (int i = 0; i < 8; ++i) *(u32x4*)(vdst + i * 32 * 72) = st[i]; }
    f32x4 s[16];
#pragma unroll
    for (int mt = 0; mt < 16; ++mt) s[mt] = {0.f, 0.f, 0.f, 0.f};
    ATT_ISSUE_K(0)
#pragma unroll
    for (int kc = 0; kc < 4; ++kc) {
      ATT_LAND_K()
      if (kc < 3) ATT_ISSUE_K(kc + 1) else ATT_ISSUE_V(0)
      __syncthreads();
      const u16* kbase = Kc + m * 264 + 8 * g;
      asm volatile("" : "+v"(kbase));
#pragma unroll
      for (int mt2 = 0; mt2 < 4; ++mt2)
#pragma unroll
        for (int ks = 0; ks < 8; ++ks) {
          const bf16x8 a = *(const bf16x8*)(kbase + 16 * mt2 * 264 + 32 * ks);
          s[kc * 4 + mt2] = MFMA16(a, qf[ks], s[kc * 4 + mt2]);
          if (ks == 7) asm volatile("" ::: "memory");
        }
      __syncthreads();
    }
    float mx = -1e30f;
#pragma unroll
    for (int mt = 0; mt < 16; ++mt)
#pragma unroll
      for (int j = 0; j < 4; ++j) { s[mt][j] *= 0.0625f; mx = fmaxf(mx, s[mt][j]); }
    mx = fmaxf(mx, __shfl_xor(mx, 16)); mx = fmaxf(mx, __shfl_xor(mx, 32));
    float sum = 0.f;
#pragma unroll
    for (int mt = 0; mt < 16; ++mt)
#pragma unroll
      for (int j = 0; j < 4; ++j) { s[mt][j] = __expf(s[mt][j] - mx); sum += s[mt][j]; }
    sum += __shfl_xor(sum, 16); sum += __shfl_xor(sum, 32);
    const float inv = 1.f / sum;
    bf16x8 pf[8];
#pragma unroll
    for (int k2 = 0; k2 < 8; ++k2) {
      uint4 u = make_uint4(pack2(s[2 * k2][0], s[2 * k2][1]), pack2(s[2 * k2][2], s[2 * k2][3]),
                           pack2(s[2 * k2 + 1][0], s[2 * k2 + 1][1]), pack2(s[2 * k2 + 1][2], s[2 * k2 + 1][3]));
      pf[k2] = __builtin_bit_cast(bf16x8, u);
    }
    float invr[4];
#pragma unroll
    for (int j = 0; j < 4; ++j) invr[j] = __shfl(inv, 4 * g + j);
    f32x4 o[16];
#pragma unroll
    for (int nt = 0; nt < 16; ++nt) o[nt] = {0.f, 0.f, 0.f, 0.f};
#pragma unroll
    for (int vc = 0; vc < 4; ++vc) {
      ATT_LAND_V()
      if (vc < 3) ATT_ISSUE_V(vc + 1)
      __syncthreads();
      const u16* vbase = Vc + m * 72 + 4 * g;
      asm volatile("" : "+v"(vbase));
#pragma unroll
      for (int nt = 0; nt < 16; ++nt) {
#pragma unroll
        for (int k2l = 0; k2l < 2; ++k2l) {
          const uint2 lo = *(const uint2*)(vbase + 16 * nt * 72 + 32 * k2l);
          const uint2 hi = *(const uint2*)(vbase + 16 * nt * 72 + 32 * k2l + 16);
          const uint4 u = make_uint4(lo.x, lo.y, hi.x, hi.y);
          o[nt] = MFMA16(pf[2 * vc + k2l], __builtin_bit_cast(bf16x8, u), o[nt]);
        }
        if ((nt & 3) == 3) asm volatile("" ::: "memory");
      }
      __syncthreads();
    }
#undef ATT_ISSUE_K
#undef ATT_ISSUE_V
#undef ATT_LAND_K
#undef ATT_LAND_V
#pragma unroll
    for (int j = 0; j < 4; ++j) {
      u16* ob = OX + (qrow + 4 * g + j) * 1024 + head * 256 + m;
      asm volatile("" : "+v"(ob));
#pragma unroll
      for (int nt = 0; nt < 16; ++nt) ob[16 * nt] = f2bf(o[nt][j] * invr[j]);
    }
  }
}

DI uint32_t ordf(float f) { uint32_t u = __float_as_uint(f); return u ^ ((uint32_t)((int32_t)u >> 31) | 0x80000000u); }
DI float unordf(uint32_t k) { return __uint_as_float(k ^ ((~(uint32_t)((int32_t)k >> 31)) | 0x80000000u)); }
DI void ins32(uint32_t (&top)[16], uint32_t x) {
#pragma unroll
  for (int i = 0; i < 16; ++i) { const uint32_t hi = max(top[i], x); x = min(top[i], x); top[i] = hi; }
}
DI void ins64(uint32_t (&tk)[16], uint32_t (&tv)[16], uint32_t xk, uint32_t xv) {
#pragma unroll
  for (int i = 0; i < 16; ++i) {
    const bool gt = xk > tk[i];
    const uint32_t nk = gt ? xk : tk[i], nv = gt ? xv : tv[i];
    xk = gt ? tk[i] : xk; xv = gt ? tv[i] : xv;
    tk[i] = nk; tv[i] = nv;
  }
}

__device__ constexpr int PAIR_I[50] = {0,0,0,0,0,0,0,0,0,0,0,0,0,0,0,0,1,1,1,1,1,1,1,1,2,2,2,2,2,3,3,3,3,4,4,4,5,5,6,6,7,7,8,9,10,11,12,13,14,15};
__device__ constexpr int PAIR_J[50] = {0,1,2,3,4,5,6,7,8,9,10,11,12,13,14,15,0,1,2,3,4,5,6,7,0,1,2,3,4,0,1,2,3,0,1,2,0,1,0,1,0,1,0,0,0,0,0,0,0,0};

DI void phase_topk(const Params& p) {
  char* ws = p.ws;
  const int lane = tidx() & 63, l31 = lane & 31, hh = lane >> 5;
  const uint32_t hh4 = (uint32_t)hh << 2;
  const u16* PQ = (const u16*)(ws + OFF_PQ);
  const u16* KEYS = (const u16*)(ws + OFF_KEYS);
  int* SELI = (int*)(ws + OFF_SELI);
  float* SELG = (float*)(ws + OFF_SELG);
  const int gw = blockIdx.x * 4 + (tidx() >> 6), nw = gridDim.x * 4;
  for (int job = gw; job < 1024 * 8; job += nw) {
    const int hd = job & 7, tt = job >> 3;
    const size_t tok = (size_t)tt * 32 + l31;
    uint32_t top[2][16];
#pragma unroll
    for (int pp = 0; pp < 2; ++pp) {
      bf16x8 qf[4];
#pragma unroll
      for (int ks = 0; ks < 4; ++ks) qf[ks] = *(const bf16x8*)(PQ + tok * 1024 + hd * 128 + pp * 64 + 16 * ks + 8 * hh);
      f32x16 acc[4];
#pragma unroll
      for (int mt = 0; mt < 4; ++mt) {
#pragma unroll
        for (int i = 0; i < 16; ++i) acc[mt][i] = 0.f;
#pragma unroll
        for (int ks = 0; ks < 4; ++ks) {
          const bf16x8 a = *(const bf16x8*)(KEYS + (size_t)((hd * 2 + pp) * 128 + 32 * mt + l31) * 64 + 16 * ks + 8 * hh);
          acc[mt] = MFMA32(a, qf[ks], acc[mt]);
        }
      }
#pragma unroll
      for (int i = 0; i < 16; ++i) top[pp][i] = 0u;
#pragma unroll
      for (int mt = 0; mt < 4; ++mt)
#pragma unroll
        for (int i = 0; i < 16; ++i) {
          const uint32_t kc = (uint32_t)(127 - (32 * mt + (i & 3) + 8 * (i >> 2)));
          ins32(top[pp], ((ordf(acc[mt][i]) & 0xFFFFFF80u) | kc) ^ hh4);
        }
      uint32_t c[16];
#pragma unroll
      for (int i = 0; i < 16; ++i) c[i] = max(top[pp][i], (uint32_t)__shfl_xor((int)top[pp][15 - i], 32));
#pragma unroll
      for (int st = 8; st >= 1; st >>= 1)
#pragma unroll
        for (int i = 0; i < 16; ++i)
          if ((i & st) == 0) { const uint32_t hi = max(c[i], c[i + st]), lo = min(c[i], c[i + st]); c[i] = hi; c[i + st] = lo; }
#pragma unroll
      for (int i = 0; i < 16; ++i) top[pp][i] = c[i];
    }
    uint32_t tk[16], tv[16];
#pragma unroll
    for (int i = 0; i < 16; ++i) { tk[i] = 0u; tv[i] = 0u; }
#pragma unroll
    for (int q = 0; q < 25; ++q) {
      const int ia = PAIR_I[2 * q], ja = PAIR_J[2 * q], ib = PAIR_I[2 * q + 1], jb = PAIR_J[2 * q + 1];
      const uint32_t k1 = hh ? top[0][ib] : top[0][ia];
      const uint32_t k2 = hh ? top[1][jb] : top[1][ja];
      const float xs = unordf(k1 & 0xFFFFFF80u) + unordf(k2 & 0xFFFFFF80u);
      const uint32_t xv = (127u - (k1 & 127u)) * 128u + (127u - (k2 & 127u));
      ins64(tk, tv, ordf(xs), xv);
    }
    {
      uint32_t ck[16], cv[16];
#pragma unroll
      for (int i = 0; i < 16; ++i) {
        const uint32_t ok = (uint32_t)__shfl_xor((int)tk[15 - i], 32), ov = (uint32_t)__shfl_xor((int)tv[15 - i], 32);
        const bool gt = ok > tk[i];
        ck[i] = gt ? ok : tk[i]; cv[i] = gt ? ov : tv[i];
      }
#pragma unroll
      for (int i = 0; i < 16; ++i) { tk[i] = ck[i]; tv[i] = cv[i]; }
    }
    float e[16], sum = 0.f;
    uint32_t mk = tk[0];
#pragma unroll
    for (int i = 1; i < 16; ++i) mk = max(mk, tk[i]);
    const float mx = unordf(mk);
#pragma unroll
    for (int i = 0; i < 16; ++i) { e[i] = __expf(unordf(tk[i]) - mx); sum += e[i]; }
    const float inv = 1.f / sum;
    int* ip = SELI + (tok * 8 + hd) * 16;
    float* gp = SELG + (tok * 8 + hd) * 16;
    if (hh == 0) {
      *(uint4*)ip = make_uint4(tv[0], tv[1], tv[2], tv[3]);
      *(uint4*)(ip + 4) = make_uint4(tv[4], tv[5], tv[6], tv[7]);
      *(uint4*)(ip + 8) = make_uint4(tv[8], tv[9], tv[10], tv[11]);
      *(uint4*)(ip + 12) = make_uint4(tv[12], tv[13], tv[14], tv[15]);
      *(float4*)gp = make_float4(e[0] * inv, e[1] * inv, e[2] * inv, e[3] * inv);
      *(float4*)(gp + 4) = make_float4(e[4] * inv, e[5] * inv, e[6] * inv, e[7] * inv);
      *(float4*)(gp + 8) = make_float4(e[8] * inv, e[9] * inv, e[10] * inv, e[11] * inv);
      *(float4*)(gp + 12) = make_float4(e[12] * inv, e[13] * inv, e[14] * inv, e[15] * inv);
    }
  }
}

DI bf16x8 fp8x8_to_bf16(uint32_t d0, uint32_t d1) {
  const bf16x2v c0 = __builtin_amdgcn_cvt_scalef32_pk_bf16_fp8((int)d0, 1.0f, false);
  const bf16x2v c1 = __builtin_amdgcn_cvt_scalef32_pk_bf16_fp8((int)d0, 1.0f, true);
  const bf16x2v c2 = __builtin_amdgcn_cvt_scalef32_pk_bf16_fp8((int)d1, 1.0f, false);
  const bf16x2v c3 = __builtin_amdgcn_cvt_scalef32_pk_bf16_fp8((int)d1, 1.0f, true);
  const uint4 u = make_uint4(__builtin_bit_cast(uint32_t, c0), __builtin_bit_cast(uint32_t, c1), __builtin_bit_cast(uint32_t, c2), __builtin_bit_cast(uint32_t, c3));
  return __builtin_bit_cast(bf16x8, u);
}

DI void phase_peer(const Params& p, char* smem, float* dst) {
  char* ws = p.ws;
  const int tid = tidx(), lane = tid & 63, wave = tid >> 6, m = lane & 15, g = lane >> 4;
  const u16* HB = (const u16*)(ws + OFF_XB);
  const unsigned char* EU = (const unsigned char*)(ws + OFF_EU);
  const unsigned char* EV = (const unsigned char*)(ws + OFF_EV);
  const int* SELI = (const int*)(ws + OFF_SELI);
  const float* SELG = (const float*)(ws + OFF_SELG);
  const float* SSQ = (const float*)(ws + OFF_SSQ2);
  float* coef = (float*)(smem + wave * 1024);
  int* idxs = (int*)(smem + wave * 1024 + 512);
  for (int tile = blockIdx.x; tile < T_TOK / 4; tile += gridDim.x) {
    const size_t t = (size_t)tile * 4 + wave;
    const float4 q0 = *(const float4*)(SSQ + t * 8), q1 = *(const float4*)(SSQ + t * 8 + 4);
    const float rstd = rsqrtf((q0.x + q0.y + q0.z + q0.w + q1.x + q1.y + q1.z + q1.w) * (1.f / 1024.f) + EPS) * (1.f / EU_SCALE);
    int myidx[8];
#pragma unroll
    for (int grp = 0; grp < 8; ++grp) myidx[grp] = SELI[t * 128 + grp * 16 + m];
    f32x4 acc[8];
#pragma unroll
    for (int grp = 0; grp < 8; ++grp) acc[grp] = {0.f, 0.f, 0.f, 0.f};
    for (int kb2 = 0; kb2 < 8; ++kb2) {
      bf16x8 xf[4];
#pragma unroll
      for (int j = 0; j < 4; ++j) xf[j] = *(const bf16x8*)(HB + t * 1024 + kb2 * 128 + g * 32 + 8 * j);
      uint4 raw0[8], raw1[8];
#pragma unroll
      for (int grp = 0; grp < 8; ++grp) {
        const unsigned char* up = EU + (size_t)myidx[grp] * 1024 + kb2 * 128 + g * 32;
        raw0[grp] = *(const uint4*)up;
        raw1[grp] = *(const uint4*)(up + 16);
      }
#pragma unroll
      for (int grp = 0; grp < 8; ++grp) {
        acc[grp] = MFMA16(fp8x8_to_bf16(raw0[grp].x, raw0[grp].y), xf[0], acc[grp]);
        acc[grp] = MFMA16(fp8x8_to_bf16(raw0[grp].z, raw0[grp].w), xf[1], acc[grp]);
        acc[grp] = MFMA16(fp8x8_to_bf16(raw1[grp].x, raw1[grp].y), xf[2], acc[grp]);
        acc[grp] = MFMA16(fp8x8_to_bf16(raw1[grp].z, raw1[grp].w), xf[3], acc[grp]);
      }
    }
    if (g == 0) {
#pragma unroll
      for (int grp = 0; grp < 8; ++grp) idxs[grp * 16 + m] = myidx[grp];
    }
    if (m == 0) {
#pragma unroll
      for (int grp = 0; grp < 8; ++grp)
#pragma unroll
        for (int j = 0; j < 4; ++j) {
          const int e = grp * 16 + 4 * g + j;
          const float a = acc[grp][j] * rstd;
          const float ge = 0.5f * a * (1.f + erff(a * 0.7071067811865475f));
          coef[e] = SELG[t * 128 + e] * ge * (1.f / EV_SCALE);
        }
    }
    __syncthreads();
    f32x2 y[8];
#pragma unroll
    for (int i = 0; i < 8; ++i) y[i] = {0.f, 0.f};
#pragma unroll 8
    for (int e = 0; e < 128; ++e) {
      const float c = coef[e];
      const f32x2 c2 = {c, c};
      const uint4 r = *(const uint4*)(EV + (size_t)idxs[e] * 1024 + lane * 16);
      y[0] += c2 * __builtin_amdgcn_cvt_pk_f32_fp8((int)r.x, false);
      y[1] += c2 * __builtin_amdgcn_cvt_pk_f32_fp8((int)r.x, true);
      y[2] += c2 * __builtin_amdgcn_cvt_pk_f32_fp8((int)r.y, false);
      y[3] += c2 * __builtin_amdgcn_cvt_pk_f32_fp8((int)r.y, true);
      y[4] += c2 * __builtin_amdgcn_cvt_pk_f32_fp8((int)r.z, false);
      y[5] += c2 * __builtin_amdgcn_cvt_pk_f32_fp8((int)r.z, true);
      y[6] += c2 * __builtin_amdgcn_cvt_pk_f32_fp8((int)r.w, false);
      y[7] += c2 * __builtin_amdgcn_cvt_pk_f32_fp8((int)r.w, true);
    }
    const float* hp = p.out + t * 1024 + lane * 16;
    float* dp = dst + t * 1024 + lane * 16;
    float hv[16];
#pragma unroll
    for (int q = 0; q < 4; ++q) { const float4 h4 = *(const float4*)(hp + 4 * q); hv[4 * q] = h4.x; hv[4 * q + 1] = h4.y; hv[4 * q + 2] = h4.z; hv[4 * q + 3] = h4.w; }
    float ss = 0.f;
#pragma unroll
    for (int i = 0; i < 8; ++i) { hv[2 * i] += y[i][0]; hv[2 * i + 1] += y[i][1]; }
#pragma unroll
    for (int i = 0; i < 16; ++i) ss += hv[i] * hv[i];
    ss = wave_sum(ss);
    const float rn = rsqrtf(ss * (1.f / 1024.f) + EPS);
#pragma unroll
    for (int q = 0; q < 4; ++q) {
      const float4 n4 = *(const float4*)(p.norm_final + lane * 16 + 4 * q);
      *(float4*)(dp + 4 * q) = make_float4(hv[4 * q] * rn * n4.x, hv[4 * q + 1] * rn * n4.y, hv[4 * q + 2] * rn * n4.z, hv[4 * q + 3] * rn * n4.w);
    }
    __syncthreads();
  }
}

#define XB_TMO      128
#define XB_XCNT(j)  (256  + 64 * (j))
#define XB_XSUB(j)  (1280 + 64 * (j))
#define XB_XGEN(j)  (2304 + 64 * (j))
#define XB_TOP      3328
#define XB_TOPGEN   3392
#define XCD_BAR_WORDS 3456
#define XB_SPIN_CAP (1u << 22)
#define LAS __attribute__((address_space(3)))
DI unsigned xb_ld(unsigned* p)              { return __hip_atomic_load(p, __ATOMIC_RELAXED, __HIP_MEMORY_SCOPE_AGENT); }
DI unsigned xb_add(unsigned* p, unsigned v) { return __hip_atomic_fetch_add(p, v, __ATOMIC_RELAXED, __HIP_MEMORY_SCOPE_AGENT); }
DI unsigned xb_xcc_id() { return (unsigned)__builtin_amdgcn_s_getreg((3 << 11) | 20) & 0xFu; }
#define XB_SPIN(cond, bar) do { unsigned _sp = 0; while (cond) { __builtin_amdgcn_s_sleep(1); \
    if ((++_sp & 255u) == 0u) { if (xb_ld(&(bar)[XB_TMO])) break; if (_sp > XB_SPIN_CAP) { atomicAdd(&(bar)[XB_TMO], 1u); break; } } } } while (0)
struct XcdBarrier { unsigned* bar; unsigned x; volatile LAS unsigned* st; };
DI XcdBarrier xcd_barrier_post(unsigned* bar, volatile LAS unsigned* st) {
  XcdBarrier b; b.bar = bar; b.x = xb_xcc_id(); b.st = st;
  if (__builtin_amdgcn_workitem_id_x() == 0) (void)xb_add(&bar[XB_XCNT(b.x)], 1u);
  return b;
}
DI void xcd_barrier_complete(unsigned* bar, unsigned x, unsigned& nloc, unsigned& nx) {
  const unsigned G = gridDim.x * gridDim.y * gridDim.z;
  unsigned sum, cnt, mine, sp = 0u;
  for (;;) {
    sum = 0u; cnt = 0u; mine = 0u;
#pragma unroll
    for (unsigned j = 0; j < 16; ++j) { const unsigned c = xb_ld(&bar[XB_XCNT(j)]); sum += c; cnt += (c > 0u) ? 1u : 0u; mine = (j == x) ? c : mine; }
    if (sum == G) break;
    __builtin_amdgcn_s_sleep(1);
    if ((++sp & 255u) == 0u) { if (xb_ld(&bar[XB_TMO])) break; if (sp > XB_SPIN_CAP) { atomicAdd(&bar[XB_TMO], 1u); break; } }
  }
  nloc = mine > 0u ? mine : 1u; nx = cnt > 0u ? cnt : 1u;
}
DI void xcd_barrier(const XcdBarrier& b) {
  asm volatile("s_waitcnt vmcnt(0)" ::: "memory");
  __syncthreads();
  if (__builtin_amdgcn_workitem_id_x() == 0) {
    unsigned* bar = b.bar;
    __builtin_amdgcn_s_waitcnt(0);
    unsigned nloc = b.st[0], nx = b.st[1];
    if (nloc == 0u) { xcd_barrier_complete(bar, b.x, nloc, nx); b.st[0] = nloc; b.st[1] = nx; }
    const unsigned old = xb_add(&bar[XB_XSUB(b.x)], 1u);
    const unsigned gen = old / nloc;
    if (old + 1u == (gen + 1u) * nloc) {
      __builtin_amdgcn_fence(__ATOMIC_RELEASE, "agent");
      asm volatile("s_waitcnt vmcnt(0)" ::: "memory");
      const unsigned og = xb_add(&bar[XB_TOP], 1u);
      const unsigned tg = og / nx;
      if (og + 1u == (tg + 1u) * nx) xb_add(&bar[XB_TOPGEN], 1u);
      else XB_SPIN(xb_ld(&bar[XB_TOPGEN]) == tg, bar);
      __builtin_amdgcn_fence(__ATOMIC_ACQUIRE, "agent");
      xb_add(&bar[XB_XGEN(b.x)], 1u);
      asm volatile("s_waitcnt vmcnt(0)" ::: "memory");
    } else {
      XB_SPIN(xb_ld(&bar[XB_XGEN(b.x)]) == gen, bar);
      __builtin_amdgcn_fence(__ATOMIC_ACQUIRE, "agent");
      asm volatile("s_waitcnt vmcnt(0)" ::: "memory");
    }
  }
  __syncthreads();
}

__global__ void __launch_bounds__(256, 2) fwd_kernel(Params p, int ph_lo, int ph_hi) {
  extern __shared__ __attribute__((aligned(16))) char smem[];
  char* ws = p.ws;
#ifndef DOUBLE_MASK
#define DOUBLE_MASK 0
#endif
  const bool multi = (ph_hi - ph_lo) > 1;
  XcdBarrier xb;
  if (multi) {
    volatile LAS unsigned* st = (volatile LAS unsigned*)(smem + SMEM_BYTES - 16);
    if (__builtin_amdgcn_workitem_id_x() == 0) { st[0] = 0u; st[1] = 0u; }
    __syncthreads();
    xb = xcd_barrier_post((unsigned*)(ws + OFF_BAR), st);
  }
  if (ph_lo < -1000) cg::this_grid().sync();
#define RUN_PHASE(k, call) if (ph_lo <= (k) && (k) < ph_hi) { \
    _Pragma("unroll 1") for (int rep = ((DOUBLE_MASK >> (k)) & 1); rep >= 0; --rep) { call; if (rep > 0 || (k) + 1 < ph_hi) xcd_barrier(xb); } }
  RUN_PHASE(0, phase_prep(p, smem))
  RUN_PHASE(1, phase_proj(p, smem))
  RUN_PHASE(2, phase_chunks(p, smem))
  RUN_PHASE(3, phase_scan(p, smem))
  RUN_PHASE(4, phase_gate(p))
  RUN_PHASE(5, phase_resid((const u16*)(ws + OFF_YMIX), (const u16*)(ws + OFF_WOUT), p.x, p.out, (u16*)(ws + OFF_XB), (float*)(ws + OFF_SSQ1), smem))
  RUN_PHASE(6, phase_scaled((const u16*)(ws + OFF_XB), (const u16*)(ws + OFF_WXQ), (const float*)(ws + OFF_SSQ1), (u16*)(ws + OFF_QX), smem))
  RUN_PHASE(7, phase_attn(p, smem))
  RUN_PHASE(8, phase_resid((const u16*)(ws + OFF_OX), (const u16*)(ws + OFF_WXO), p.out, p.out, (u16*)(ws + OFF_XB), (float*)(ws + OFF_SSQ2), smem))
  RUN_PHASE(9, phase_scaled((const u16*)(ws + OFF_XB), (const u16*)(ws + OFF_WPQ), (const float*)(ws + OFF_SSQ2), (u16*)(ws + OFF_PQ), smem))
  RUN_PHASE(10, phase_topk(p))
#if (DOUBLE_MASK >> 11) & 1
  if (ph_lo <= 11 && 11 < ph_hi) { phase_peer(p, smem, (float*)(ws + OFF_PROJ)); xcd_barrier(xb); }
#endif
  if (ph_lo <= 11 && 11 < ph_hi) phase_peer(p, smem, p.out);
}

extern "C" void kernel_launch(void* const* d_in, const int* in_sizes, int n_in, void* d_out, int out_size, void* d_ws, size_t ws_size,
                              hipStream_t stream) {
  static int grid = 0;
  if (grid == 0) {
    if (n_in != 21 || out_size != T_TOK * DM || ws_size < WS_END) {
      fprintf(stderr, "kernel_launch: unexpected shapes (n_in %d out %d ws %zu need %zu)\n", n_in, out_size, ws_size, (size_t)WS_END);
      grid = -1;
      return;
    }
    int dev = 0, cus = 0, per_cu = 0;
    hipGetDevice(&dev);
    hipDeviceGetAttribute(&cus, hipDeviceAttributeMultiprocessorCount, dev);
    hipFuncSetAttribute((const void*)fwd_kernel, hipFuncAttributeMaxDynamicSharedMemorySize, SMEM_BYTES);
    hipOccupancyMaxActiveBlocksPerMultiprocessor(&per_cu, (const void*)fwd_kernel, 256, SMEM_BYTES);
    if (per_cu < 1) per_cu = 1;
    if (per_cu > 2) per_cu = 2;
    grid = cus * per_cu;
    if (grid < 128) { fprintf(stderr, "kernel_launch: grid %d too small\n", grid); grid = -1; return; }
  }
  if (grid < 0) return;
  Params p{};
  const float** pp = (const float**)&p;
  for (int i = 0; i < 21; ++i) pp[i] = (const float*)d_in[i];
  p.out = (float*)d_out;
  p.ws = (char*)d_ws;
#if ONE_LAUNCH
  hipMemsetAsync((char*)d_ws + OFF_BAR, 0, BAR_BYTES, stream);
  int lo = 0, hi = NPH;
  void* args[] = {&p, &lo, &hi};
  hipError_t e = hipLaunchCooperativeKernel((const void*)fwd_kernel, dim3(grid), dim3(256), args, SMEM_BYTES, stream);
  if (e != hipSuccess) fprintf(stderr, "cooperative launch failed: %s (grid %d)\n", hipGetErrorString(e), grid);
#else
  for (int ph = 0; ph < NPH; ++ph) hipLaunchKernelGGL(fwd_kernel, dim3(grid), dim3(256), SMEM_BYTES, stream, p, ph, ph + 1);
#endif
}
```

```cpp
#include <hip/hip_runtime.h>
#include <hip/hip_cooperative_groups.h>
#include <stdint.h>
#include <stdio.h>
namespace cg = cooperative_groups;

typedef unsigned short u16;
using bf16x8 = __attribute__((ext_vector_type(8))) short;
using f32x4  = __attribute__((ext_vector_type(4))) float;
using f32x16 = __attribute__((ext_vector_type(16))) float;
using f32x2  = __attribute__((ext_vector_type(2))) float;
using bf16x2v = __attribute__((ext_vector_type(2))) __bf16;

#define DI __device__ __forceinline__
#define MFMA32(a, b, c) __builtin_amdgcn_mfma_f32_32x32x16_bf16((a), (b), (c), 0, 0, 0)
#define MFMA16(a, b, c) __builtin_amdgcn_mfma_f32_16x16x32_bf16((a), (b), (c), 0, 0, 0)

#ifndef ONE_LAUNCH
#define ONE_LAUNCH 1
#endif

constexpr int T_TOK = 32768;
constexpr int SEQ = 8192;
constexpr int DM = 1024;
constexpr int INC = 3592;
constexpr int NPH = 12;
constexpr float EPS = 1e-6f;
constexpr float EU_SCALE = 64.f, EV_SCALE = 8.f;

constexpr size_t MiB = 1024ull * 1024ull;
constexpr size_t OFF_WIN  = 0;
constexpr size_t OFF_WOUT = OFF_WIN + 3712ull * 1024 * 2;
constexpr size_t OFF_WXQ  = OFF_WOUT + 2 * MiB;
constexpr size_t OFF_WXKV = OFF_WXQ + 2 * MiB;
constexpr size_t OFF_WXO  = OFF_WXKV + 4 * MiB;
constexpr size_t OFF_WPQ  = OFF_WXO + 2 * MiB;
constexpr size_t OFF_KEYS = OFF_WPQ + 2 * MiB;
constexpr size_t OFF_EU   = OFF_KEYS + 262144;
constexpr size_t OFF_EV   = OFF_EU + 32 * MiB;
constexpr size_t OFF_XB   = OFF_EV + 32 * MiB;
constexpr size_t OFF_MEMB = OFF_XB + 64 * MiB;
constexpr size_t OFF_KX   = OFF_MEMB + 2 * MiB;
constexpr size_t OFF_VT   = OFF_KX + 2 * MiB;
constexpr size_t OFF_RSTD0 = OFF_VT + 2 * MiB;
constexpr size_t OFF_RSTDM = OFF_RSTD0 + 131072;
constexpr size_t OFF_SSQ1 = OFF_RSTDM + 4096;
constexpr size_t OFF_SSQ2 = OFF_SSQ1 + 1 * MiB;
constexpr size_t OFF_BA   = OFF_SSQ2 + 1 * MiB;
constexpr size_t OFF_GL   = OFF_BA + 1 * MiB;
constexpr size_t OFF_YMIX = OFF_GL + 8192;
constexpr size_t OFF_PROJ = OFF_YMIX + 64 * MiB;
constexpr size_t PROJ_BYTES = (size_t)T_TOK * INC * 2;
constexpr size_t OFF_BAR  = OFF_PROJ + PROJ_BYTES;
constexpr size_t BAR_BYTES = 16384;
constexpr size_t OFF_TS   = OFF_BAR + BAR_BYTES;
constexpr size_t WS_END   = OFF_TS + 4096;
constexpr size_t OFF_QX   = OFF_PROJ;
constexpr size_t OFF_OX   = OFF_PROJ + 64 * MiB;
constexpr size_t OFF_PQ   = OFF_PROJ + 128 * MiB;
constexpr size_t OFF_SELI = OFF_PROJ + 192 * MiB;
constexpr size_t OFF_SELG = OFF_PROJ + 208 * MiB;

constexpr int SMEM_BYTES = 75776;

struct Params {
  const float *x, *mem, *norm_mix, *w_in, *conv_w, *dn_conv_w, *dn_a_log, *dn_dt_bias, *dn_norm, *w_out,
      *norm_x, *norm_mem, *w_xq, *w_xkv, *w_xo, *norm_ffn, *w_pq, *peer_keys, *expert_u, *expert_v, *norm_final;
  float* out;
  char* ws;
};

DI int tidx() { int t = (int)__builtin_amdgcn_workitem_id_x(); asm volatile("" : "+v"(t)); return t; }
DI u16 f2bf(float x) { uint32_t u = __float_as_uint(x); u += 0x7fffu + ((u >> 16) & 1u); return (u16)(u >> 16); }
DI float bf2f(u16 v) { return __uint_as_float(((uint32_t)v) << 16); }
DI uint32_t pack2(float a, float b) { return (uint32_t)f2bf(a) | ((uint32_t)f2bf(b) << 16); }
DI float bflo(uint32_t u) { return __uint_as_float(u << 16); }
DI float bfhi(uint32_t u) { return __uint_as_float(u & 0xffff0000u); }
DI int crow32(int i, int h) { return (i & 3) + 8 * (i >> 2) + 4 * h; }
DI float silu_f(float v) { return v / (1.f + __expf(-v)); }
DI float wave_sum(float v) {
#pragma unroll
  for (int o = 32; o >= 1; o >>= 1) v += __shfl_xor(v, o);
  return v;
}
DI void unpack8(const uint4& r, float* f) {
  f[0] = bflo(r.x); f[1] = bfhi(r.x); f[2] = bflo(r.y); f[3] = bfhi(r.y);
  f[4] = bflo(r.z); f[5] = bfhi(r.z); f[6] = bflo(r.w); f[7] = bfhi(r.w);
}
DI uint4 pack8(const float* f) { return make_uint4(pack2(f[0], f[1]), pack2(f[2], f[3]), pack2(f[4], f[5]), pack2(f[6], f[7])); }

DI void rowconv(const float* __restrict__ src, u16* __restrict__ dst, const float* __restrict__ gain, float* __restrict__ rstd, int rows) {
  const int lane = tidx() & 63;
  const int gw = blockIdx.x * 4 + (tidx() >> 6), nw = gridDim.x * 4;
  for (int r = gw; r < rows; r += nw) {
    const float4* s = (const float4*)(src + (size_t)r * 1024);
    float4 a0 = s[lane * 2], a1 = s[lane * 2 + 1], b0 = s[128 + lane * 2], b1 = s[128 + lane * 2 + 1];
    float f[16] = {a0.x, a0.y, a0.z, a0.w, a1.x, a1.y, a1.z, a1.w, b0.x, b0.y, b0.z, b0.w, b1.x, b1.y, b1.z, b1.w};
    if (rstd) {
      float ss = 0.f;
#pragma unroll
      for (int i = 0; i < 16; ++i) ss += f[i] * f[i];
      ss = wave_sum(ss);
      if (lane == 0) rstd[r] = rsqrtf(ss * (1.f / 1024.f) + EPS);
    }
    if (gain) {
      const float4* gp = (const float4*)gain;
      float4 g0 = gp[lane * 2], g1 = gp[lane * 2 + 1], g2 = gp[128 + lane * 2], g3 = gp[128 + lane * 2 + 1];
      float gg[16] = {g0.x, g0.y, g0.z, g0.w, g1.x, g1.y, g1.z, g1.w, g2.x, g2.y, g2.z, g2.w, g3.x, g3.y, g3.z, g3.w};
#pragma unroll
      for (int i = 0; i < 16; ++i) f[i] *= gg[i];
    }
    *(uint4*)(dst + (size_t)r * 1024 + lane * 8) = pack8(f);
    *(uint4*)(dst + (size_t)r * 1024 + 512 + lane * 8) = pack8(f + 8);
  }
}


DI void rowconv8(const float* __restrict__ src, unsigned char* __restrict__ dst, const float* __restrict__ gain, float scale, int rows, int bid, int nb) {
  const int lane = tidx() & 63;
  const int gw = bid * 4 + (tidx() >> 6), nw = nb * 4;
  float gg[16];
#pragma unroll
  for (int i = 0; i < 16; ++i) gg[i] = scale;
  if (gain) {
    const float4* gp = (const float4*)(gain + lane * 16);
#pragma unroll
    for (int q = 0; q < 4; ++q) { const float4 g4 = gp[q]; gg[4 * q] *= g4.x; gg[4 * q + 1] *= g4.y; gg[4 * q + 2] *= g4.z; gg[4 * q + 3] *= g4.w; }
  }
  for (int r = gw; r < rows; r += nw) {
    const float4* s = (const float4*)(src + (size_t)r * 1024 + lane * 16);
    uint32_t o[4];
#pragma unroll
    for (int q = 0; q < 4; ++q) {
      const float4 v = s[q];
      int pk = __builtin_amdgcn_cvt_pk_fp8_f32(v.x * gg[4 * q], v.y * gg[4 * q + 1], 0, false);
      pk = __builtin_amdgcn_cvt_pk_fp8_f32(v.z * gg[4 * q + 2], v.w * gg[4 * q + 3], pk, true);
      o[q] = (uint32_t)pk;
    }
    *(uint4*)(dst + (size_t)r * 1024 + lane * 16) = make_uint4(o[0], o[1], o[2], o[3]);
  }
}

DI void transpose_tile(const float* __restrict__ W, int N, const float* __restrict__ gain, u16* __restrict__ Wt, int nt, int kt, float* tile) {
  const int t = tidx();
  const int k0 = kt * 64, n0 = nt * 64;
#pragma unroll
  for (int i = 0; i < 16; ++i) {
    int kk = i * 4 + (t >> 6), nn = t & 63;
    float v = 0.f;
    if (n0 + nn < N) v = W[(size_t)(k0 + kk) * N + n0 + nn] * (gain ? gain[k0 + kk] : 1.f);
    tile[kk * 65 + nn] = v;
  }
  __syncthreads();
#pragma unroll
  for (int i = 0; i < 16; ++i) {
    int nn = i * 4 + (t >> 6), kk = t & 63;
    if (n0 + nn < N) Wt[(size_t)(n0 + nn) * 1024 + k0 + kk] = f2bf(tile[kk * 65 + nn]);
  }
  __syncthreads();
}

DI void weight_transposes(const Params& p, char* smem, unsigned mask, int bid, int nb) {
  char* ws = p.ws;
  const int cnt_all[6] = {57 * 16, 256, 256, 512, 256, 256};
  int cnt[6], total = 0;
  for (int i = 0; i < 6; ++i) { cnt[i] = ((mask >> i) & 1u) ? cnt_all[i] : 0; total += cnt[i]; }
  for (int job = bid; job < total; job += nb) {
    int j = job, w = 0;
    while (j >= cnt[w]) { j -= cnt[w]; ++w; }
    const float* W; const float* gain; u16* dst; int N;
    switch (w) {
      case 0: W = p.w_in; gain = p.norm_mix; dst = (u16*)(ws + OFF_WIN); N = INC; break;
      case 1: W = p.w_out; gain = nullptr; dst = (u16*)(ws + OFF_WOUT); N = 1024; break;
      case 2: W = p.w_xq; gain = p.norm_x; dst = (u16*)(ws + OFF_WXQ); N = 1024; break;
      case 3: W = p.w_xkv; gain = p.norm_mem; dst = (u16*)(ws + OFF_WXKV); N = 2048; break;
      case 4: W = p.w_xo; gain = nullptr; dst = (u16*)(ws + OFF_WXO); N = 1024; break;
      default: W = p.w_pq; gain = p.norm_ffn; dst = (u16*)(ws + OFF_WPQ); N = 1024; break;
    }
    transpose_tile(W, N, gain, dst, j >> 4, j & 15, (float*)smem);
  }
}
DI void keys_convert(const Params& p, int bid, int nb) {
  u16* kd = (u16*)(p.ws + OFF_KEYS);
  for (int i = bid * 256 + tidx(); i < 131072; i += nb * 256) kd[i] = f2bf(p.peer_keys[i]);
}

DI void phase_prep(const Params& p, char* smem) {
  char* ws = p.ws;
  const bool defer = gridDim.x >= 256;
  weight_transposes(p, smem, defer ? 0x09u : 0x3Fu, blockIdx.x, gridDim.x);
  rowconv(p.x, (u16*)(ws + OFF_XB), nullptr, (float*)(ws + OFF_RSTD0), T_TOK);
  rowconv(p.mem, (u16*)(ws + OFF_MEMB), nullptr, (float*)(ws + OFF_RSTDM), 1024);
  if (!defer) {
    rowconv8(p.expert_u, (unsigned char*)(ws + OFF_EU), p.norm_ffn, EU_SCALE, 16384, blockIdx.x, gridDim.x);
    rowconv8(p.expert_v, (unsigned char*)(ws + OFF_EV), nullptr, EV_SCALE, 16384, blockIdx.x, gridDim.x);
    keys_convert(p, blockIdx.x, gridDim.x);
  }
}

typedef unsigned u32x4 __attribute__((ext_vector_type(4)));
DI void gload16(u32x4& dst, const void* p) { asm volatile("global_load_dwordx4 %0, %1, off" : "=&v"(dst) : "v"(p) : "memory"); }
DI void gwait8_all(u32x4& a0, u32x4& a1, u32x4& a2, u32x4& a3, u32x4& b0, u32x4& b1, u32x4& b2, u32x4& b3) {
  asm volatile("s_waitcnt vmcnt(0)" : "+v"(a0), "+v"(a1), "+v"(a2), "+v"(a3), "+v"(b0), "+v"(b1), "+v"(b2), "+v"(b3) : : "memory");
}
DI void gwait8_keep8(u32x4& a0, u32x4& a1, u32x4& a2, u32x4& a3, u32x4& b0, u32x4& b1, u32x4& b2, u32x4& b3) {
  asm volatile("s_waitcnt vmcnt(8)" : "+v"(a0), "+v"(a1), "+v"(a2), "+v"(a3), "+v"(b0), "+v"(b1), "+v"(b2), "+v"(b3) : : "memory");
}

DI void gemm_main(const u16* __restrict__ A, const u16* __restrict__ Bt, int m0, int n0, char* smem, f32x16 (&acc)[2][2]) {
  const int tid = tidx(), lane = tid & 63, wave = tid >> 6;
  const int wm = wave >> 1, wn = wave & 1;
  u16* As = (u16*)smem;
  u16* Bs = (u16*)(smem + 36864);
  const int srow = tid >> 3, scol = (tid & 7) * 8;
  const u16* Ap = A + (size_t)(m0 + srow) * 1024 + scol;
  const u16* Bp = Bt + (size_t)(n0 + srow) * 1024 + scol;
  u32x4 r0a[4], r0b[4], r1a[4], r1b[4];
#pragma unroll
  for (int mi = 0; mi < 2; ++mi)
#pragma unroll
    for (int ni = 0; ni < 2; ++ni)
#pragma unroll
      for (int i = 0; i < 16; ++i) acc[mi][ni][i] = 0.f;
#define ISSUE(ra_, rb_, k_) { _Pragma("unroll") for (int i = 0; i < 4; ++i) { gload16(ra_[i], Ap + (size_t)i * 32 * 1024 + (k_) * 64); gload16(rb_[i], Bp + (size_t)i * 32 * 1024 + (k_) * 64); } }
#define STORE(ra_, rb_, buf_) { u16* as2 = As + (buf_) * 128 * 72; u16* bs2 = Bs + (buf_) * 128 * 72; \
    _Pragma("unroll") for (int i = 0; i < 4; ++i) { *(u32x4*)(as2 + (srow + 32 * i) * 72 + scol) = ra_[i]; *(u32x4*)(bs2 + (srow + 32 * i) * 72 + scol) = rb_[i]; } }
  auto compute = [&](int cur) {
    const u16* as = As + cur * 128 * 72;
    const u16* bs = Bs + cur * 128 * 72;
#pragma unroll
    for (int ks = 0; ks < 4; ++ks) {
      bf16x8 a[2], b[2];
#pragma unroll
      for (int mi = 0; mi < 2; ++mi) a[mi] = *(const bf16x8*)(as + (64 * wm + 32 * mi + (lane & 31)) * 72 + 16 * ks + 8 * (lane >> 5));
#pragma unroll
      for (int ni = 0; ni < 2; ++ni) b[ni] = *(const bf16x8*)(bs + (64 * wn + 32 * ni + (lane & 31)) * 72 + 16 * ks + 8 * (lane >> 5));
#pragma unroll
      for (int mi = 0; mi < 2; ++mi)
#pragma unroll
        for (int ni = 0; ni < 2; ++ni) acc[mi][ni] = MFMA32(b[ni], a[mi], acc[mi][ni]);
    }
  };
  ISSUE(r0a, r0b, 0)
  ISSUE(r1a, r1b, 1)
  gwait8_keep8(r0a[0], r0a[1], r0a[2], r0a[3], r0b[0], r0b[1], r0b[2], r0b[3]);
  STORE(r0a, r0b, 0)
  __syncthreads();
#pragma unroll 1
  for (int kk = 0; kk < 16; kk += 2) {
    const int k2 = (kk + 2 < 16) ? kk + 2 : 15, k3 = (kk + 3 < 16) ? kk + 3 : 15;
    ISSUE(r0a, r0b, k2)
    compute(0);
    gwait8_keep8(r1a[0], r1a[1], r1a[2], r1a[3], r1b[0], r1b[1], r1b[2], r1b[3]);
    STORE(r1a, r1b, 1)
    __syncthreads();
    ISSUE(r1a, r1b, k3)
    compute(1);
    gwait8_keep8(r0a[0], r0a[1], r0a[2], r0a[3], r0b[0], r0b[1], r0b[2], r0b[3]);
    STORE(r0a, r0b, 0)
    __syncthreads();
  }
  gwait8_all(r1a[0], r1a[1], r1a[2], r1a[3], r1b[0], r1b[1], r1b[2], r1b[3]);
#undef ISSUE
#undef STORE
}

DI bool tile_map(int it, int MT, int NT, int& mt, int& nt) {
  const int nb = gridDim.x >> 3;
  if ((gridDim.x & 7) != 0) {
    const int tile = blockIdx.x + it * gridDim.x;
    if (tile >= MT * NT) return false;
    mt = tile / NT; nt = tile % NT;
    return true;
  }
  const int vx = blockIdx.x & 7, lb = blockIdx.x >> 3;
  const int per = (MT >> 3) * NT;
  const int q = it * nb + lb;
  if (q >= per) return false;
  const int grp = q / (8 * NT), r = q % (8 * NT);
  mt = vx * (MT >> 3) + grp * 8 + (r & 7);
  nt = r >> 3;
  return true;
}

DI float* rs_ptr(char* smem) { return (float*)(smem + 73728); }
DI float* sq_ptr(char* smem) { return (float*)(smem + 73728 + 512); }

DI void kv_gemm(const Params& p, char* smem, int bid, int nb);
DI void phase_proj(const Params& p, char* smem) {
  char* ws = p.ws;
  const int tid = tidx(), lane = tid & 63, wave = tid >> 6, wm = wave >> 1, wn = wave & 1, hh = lane >> 5;
  float* rs = rs_ptr(smem);
  u16* proj = (u16*)(ws + OFF_PROJ);
  float* ba = (float*)(ws + OFF_BA);
  for (int it = 0;; ++it) {
    int mt, nt;
    if (!tile_map(it, 256, 29, mt, nt)) break;
    const int m0 = mt * 128, n0 = nt * 128;
    f32x16 acc[2][2];
    gemm_main((const u16*)(ws + OFF_XB), (const u16*)(ws + OFF_WIN), m0, n0, smem, acc);
    if (tid < 128) rs[tid] = ((const float*)(ws + OFF_RSTD0))[m0 + tid];
    __syncthreads();
#pragma unroll
    for (int mi = 0; mi < 2; ++mi) {
      const int rl = 64 * wm + 32 * mi + (lane & 31);
      const float sc = rs[rl];
      const size_t row = (size_t)(m0 + rl);
#pragma unroll
      for (int ni = 0; ni < 2; ++ni)
#pragma unroll
        for (int q = 0; q < 4; ++q) {
          const int col = n0 + 64 * wn + 32 * ni + 8 * q + 4 * hh;
          const float v0 = acc[mi][ni][4 * q] * sc, v1 = acc[mi][ni][4 * q + 1] * sc, v2 = acc[mi][ni][4 * q + 2] * sc, v3 = acc[mi][ni][4 * q + 3] * sc;
          if (col < 3584) *(uint2*)(proj + row * INC + col) = make_uint2(pack2(v0, v1), pack2(v2, v3));
          else if (col < INC) *(float4*)(ba + row * 8 + (col - 3584)) = make_float4(v0, v1, v2, v3);
        }
    }
    __syncthreads();
  }
  if (gridDim.x < 256) kv_gemm(p, smem, blockIdx.x, gridDim.x);
}

DI void kv_gemm(const Params& p, char* smem, int bid, int nb) {
  char* ws = p.ws;
  const int tid = tidx(), lane = tid & 63, wave = tid >> 6, wm = wave >> 1, wn = wave & 1, hh = lane >> 5;
  float* rs = rs_ptr(smem);
  u16* kx = (u16*)(ws + OFF_KX);
  u16* vt = (u16*)(ws + OFF_VT);
  for (int t2 = bid; t2 < 128; t2 += nb) {
    const int mt = t2 >> 4, nt = t2 & 15, m0 = mt * 128, n0 = nt * 128;
    f32x16 acc[2][2];
    gemm_main((const u16*)(ws + OFF_MEMB), (const u16*)(ws + OFF_WXKV), m0, n0, smem, acc);
    if (tid < 128) rs[tid] = ((const float*)(ws + OFF_RSTDM))[m0 + tid];
    __syncthreads();
#pragma unroll
    for (int mi = 0; mi < 2; ++mi) {
      const int rl = 64 * wm + 32 * mi + (lane & 31);
      const float sc = rs[rl];
      const int row = m0 + rl, b = row >> 8, mm = row & 255;
#pragma unroll
      for (int ni = 0; ni < 2; ++ni)
#pragma unroll
        for (int q = 0; q < 4; ++q) {
          const int col = n0 + 64 * wn + 32 * ni + 8 * q + 4 * hh;
          const float v0 = acc[mi][ni][4 * q] * sc, v1 = acc[mi][ni][4 * q + 1] * sc, v2 = acc[mi][ni][4 * q + 2] * sc, v3 = acc[mi][ni][4 * q + 3] * sc;
          if (col < 1024) {
            const int head = col >> 8, d = col & 255;
            *(uint2*)(kx + ((size_t)((b * 4 + head) * 256 + mm)) * 256 + d) = make_uint2(pack2(v0, v1), pack2(v2, v3));
          } else {
            const int c2 = col - 1024, head = c2 >> 8, d = c2 & 255;
            u16* vp = vt + ((size_t)((b * 4 + head) * 256 + d)) * 256 + mm;
            vp[0] = f2bf(v0); vp[256] = f2bf(v1); vp[512] = f2bf(v2); vp[768] = f2bf(v3);
          }
        }
    }
    __syncthreads();
  }
}

DI void phase_resid(const u16* A, const u16* Bt, const float* resid, float* hout, u16* hb, float* ssq, char* smem) {
  const int tid = tidx(), lane = tid & 63, wave = tid >> 6, wm = wave >> 1, wn = wave & 1, hh = lane >> 5;
  float* sq = sq_ptr(smem);
  for (int it = 0;; ++it) {
    int mt, nt;
    if (!tile_map(it, 256, 8, mt, nt)) break;
    const int m0 = mt * 128, n0 = nt * 128;
    f32x16 acc[2][2];
    gemm_main(A, Bt, m0, n0, smem, acc);
    if (tid < 128) sq[tid] = 0.f;
    __syncthreads();
#pragma unroll
    for (int mi = 0; mi < 2; ++mi) {
      const int rl = 64 * wm + 32 * mi + (lane & 31);
      const size_t row = (size_t)(m0 + rl);
      float s2 = 0.f;
#pragma unroll
      for (int ni = 0; ni < 2; ++ni)
#pragma unroll
        for (int q = 0; q < 4; ++q) {
          const int col = n0 + 64 * wn + 32 * ni + 8 * q + 4 * hh;
          const float4 r = *(const float4*)(resid + row * 1024 + col);
          const float h0 = r.x + acc[mi][ni][4 * q], h1 = r.y + acc[mi][ni][4 * q + 1], h2 = r.z + acc[mi][ni][4 * q + 2], h3 = r.w + acc[mi][ni][4 * q + 3];
          *(float4*)(hout + row * 1024 + col) = make_float4(h0, h1, h2, h3);
          *(uint2*)(hb + row * 1024 + col) = make_uint2(pack2(h0, h1), pack2(h2, h3));
          s2 += h0 * h0 + h1 * h1 + h2 * h2 + h3 * h3;
        }
      atomicAdd(&sq[rl], s2);
    }
    __syncthreads();
    if (tid < 128) ssq[(size_t)(m0 + tid) * 8 + nt] = sq[tid];
    __syncthreads();
  }
}

DI void phase_scaled(const u16* A, const u16* Bt, const float* ssq, u16* out, char* smem) {
  const int tid = tidx(), lane = tid & 63, wave = tid >> 6, wm = wave >> 1, wn = wave & 1, hh = lane >> 5;
  float* rs = rs_ptr(smem);
  for (int it = 0;; ++it) {
    int mt, nt;
    if (!tile_map(it, 256, 8, mt, nt)) break;
    const int m0 = mt * 128, n0 = nt * 128;
    f32x16 acc[2][2];
    gemm_main(A, Bt, m0, n0, smem, acc);
    if (tid < 128) {
      const float4* sp = (const float4*)(ssq + (size_t)(m0 + tid) * 8);
      float4 s0 = sp[0], s1 = sp[1];
      rs[tid] = rsqrtf((s0.x + s0.y + s0.z + s0.w + s1.x + s1.y + s1.z + s1.w) * (1.f / 1024.f) + EPS);
    }
    __syncthreads();
#pragma unroll
    for (int mi = 0; mi < 2; ++mi) {
      const int rl = 64 * wm + 32 * mi + (lane & 31);
      const float sc = rs[rl];
#pragma unroll
      for (int ni = 0; ni < 2; ++ni)
#pragma unroll
        for (int q = 0; q < 4; ++q) {
          const int col = n0 + 64 * wn + 32 * ni + 8 * q + 4 * hh;
          *(uint2*)(out + (size_t)(m0 + rl) * 1024 + col) =
              make_uint2(pack2(acc[mi][ni][4 * q] * sc, acc[mi][ni][4 * q + 1] * sc), pack2(acc[mi][ni][4 * q + 2] * sc, acc[mi][ni][4 * q + 3] * sc));
        }
    }
    __syncthreads();
  }
}

DI void chunk_job(const Params& p, int cj, char* smem) {
  char* ws = p.ws;
  const int tid = tidx(), lane = tid & 63, wave = tid >> 6;
  const int bh = cj >> 7, n = cj & 127, b = bh >> 2, h = bh & 3;
  const int t0 = b * SEQ + n * 64;
  u16* Kb  = (u16*)smem;
  u16* Qb  = (u16*)(smem + 17408);
  u16* Vt  = (u16*)(smem + 34816);
  u16* KGt = (u16*)(smem + 53248);
  float* gc = (float*)(smem + 71680);
  float* bt = gc + 64;
  float* As = (float*)(smem + 17408);
  u16* Tb = (u16*)smem;
  const u16* proj = (const u16*)(ws + OFF_PROJ);
  u16* QD = (u16*)p.out;
  u16* KD = (u16*)((char*)p.out + 32 * MiB);
  u16* UU = (u16*)((char*)p.out + 64 * MiB);
  u16* WW = (u16*)((char*)p.out + 96 * MiB);
  u16* IN = (u16*)(ws + OFF_XB);
  float* GL = (float*)(ws + OFF_GL);

  if (wave == 0) {
    const float* ba = (const float*)(ws + OFF_BA) + (size_t)(t0 + lane) * 8;
    const float bl = ba[h], al = ba[4 + h] + p.dn_dt_bias[h];
    const float sp = fmaxf(al, 0.f) + log1pf(expf(-fabsf(al)));
    float g = -expf(p.dn_a_log[h]) * sp;
#pragma unroll
    for (int o = 1; o < 64; o <<= 1) { float v = __shfl_up(g, o); if (lane >= o) g += v; }
    gc[lane] = g;
    bt[lane] = 1.f / (1.f + expf(-bl));
    if (lane == 63) GL[cj] = expf(g);
  }
  __syncthreads();

  {
    const int cgp = tid & 15, ts = tid >> 4;
    const float glast = gc[63];
    float eg[4], ed[4], be[4];
#pragma unroll
    for (int tt = 0; tt < 4; ++tt) { const float gv = gc[4 * ts + tt]; eg[tt] = expf(gv); ed[tt] = expf(glast - gv); be[tt] = bt[4 * ts + tt]; }
#pragma unroll 1
    for (int part = 0; part < 3; ++part) {
      const int cc = part * 512 + h * 128 + cgp * 8;
      const int cb = 1536 + cc;
      float xin[7][8];
#pragma unroll
      for (int r = 0; r < 7; ++r) {
        const int sp = n * 64 + 4 * ts - 3 + r;
        if (sp >= 0) { uint4 raw = *(const uint4*)(proj + (size_t)(t0 + 4 * ts - 3 + r) * INC + cb); unpack8(raw, xin[r]); }
        else {
#pragma unroll
          for (int c = 0; c < 8; ++c) xin[r][c] = 0.f;
        }
      }
      float o[4][8];
#pragma unroll
      for (int tt = 0; tt < 4; ++tt)
#pragma unroll
        for (int c = 0; c < 8; ++c) o[tt][c] = 0.f;
#pragma unroll
      for (int j = 0; j < 4; ++j) {
        const float4 w0 = *(const float4*)(p.dn_conv_w + j * 1536 + cc), w1 = *(const float4*)(p.dn_conv_w + j * 1536 + cc + 4);
        const float wj[8] = {w0.x, w0.y, w0.z, w0.w, w1.x, w1.y, w1.z, w1.w};
#pragma unroll
        for (int tt = 0; tt < 4; ++tt)
#pragma unroll
          for (int c = 0; c < 8; ++c) o[tt][c] += wj[c] * xin[tt + j][c];
      }
#pragma unroll
      for (int tt = 0; tt < 4; ++tt)
#pragma unroll
        for (int c = 0; c < 8; ++c) o[tt][c] = silu_f(o[tt][c]);
      if (part < 2) {
#pragma unroll
        for (int tt = 0; tt < 4; ++tt) {
          float ss = 0.f;
#pragma unroll
          for (int c = 0; c < 8; ++c) ss += o[tt][c] * o[tt][c];
          ss += __shfl_xor(ss, 1); ss += __shfl_xor(ss, 2); ss += __shfl_xor(ss, 4); ss += __shfl_xor(ss, 8);
          const float rn = rsqrtf(ss + EPS) * (part == 0 ? 0.08838834764831845f : 1.f);
#pragma unroll
          for (int c = 0; c < 8; ++c) o[tt][c] *= rn;
        }
      }
      if (part == 0) {
#pragma unroll
        for (int tt = 0; tt < 4; ++tt) {
          const int tok = 4 * ts + tt;
          *(uint4*)(Qb + tok * 136 + cgp * 8) = pack8(o[tt]);
          float qd[8];
#pragma unroll
          for (int c = 0; c < 8; ++c) qd[c] = o[tt][c] * eg[tt];
          *(uint4*)(QD + ((size_t)cj * 64 + tok) * 128 + cgp * 8) = pack8(qd);
        }
      } else if (part == 1) {
#pragma unroll
        for (int tt = 0; tt < 4; ++tt) *(uint4*)(Kb + (4 * ts + tt) * 136 + cgp * 8) = pack8(o[tt]);
#pragma unroll
        for (int c = 0; c < 8; ++c) {
          const int d = cgp * 8 + c;
          *(uint2*)(KGt + d * 72 + 4 * ts) = make_uint2(pack2(o[0][c] * be[0] * eg[0], o[1][c] * be[1] * eg[1]), pack2(o[2][c] * be[2] * eg[2], o[3][c] * be[3] * eg[3]));
          *(uint2*)(KD + ((size_t)cj * 128 + d) * 64 + 4 * ts) = make_uint2(pack2(o[0][c] * ed[0], o[1][c] * ed[1]), pack2(o[2][c] * ed[2], o[3][c] * ed[3]));
        }
      } else {
#pragma unroll
        for (int c = 0; c < 8; ++c) {
          const int d = cgp * 8 + c;
          *(uint2*)(Vt + d * 72 + 4 * ts) = make_uint2(pack2(o[0][c] * be[0], o[1][c] * be[1]), pack2(o[2][c] * be[2], o[3][c] * be[3]));
        }
      }
    }
  }
  __syncthreads();

  {
    const int wi = wave >> 1, wj = wave & 1, hh = lane >> 5;
    f32x16 aK, aQ;
#pragma unroll
    for (int i = 0; i < 16; ++i) { aK[i] = 0.f; aQ[i] = 0.f; }
    if (wi >= wj) {
#pragma unroll
      for (int ks = 0; ks < 8; ++ks) {
        const bf16x8 fk = *(const bf16x8*)(Kb + (32 * wi + (lane & 31)) * 136 + 16 * ks + 8 * hh);
        const bf16x8 fq = *(const bf16x8*)(Qb + (32 * wi + (lane & 31)) * 136 + 16 * ks + 8 * hh);
        const bf16x8 fb = *(const bf16x8*)(Kb + (32 * wj + (lane & 31)) * 136 + 16 * ks + 8 * hh);
        aK = MFMA32(fk, fb, aK);
        aQ = MFMA32(fq, fb, aQ);
      }
    }
    __syncthreads();
    const int j = 32 * wj + (lane & 31);
    const float gj = gc[j];
#pragma unroll
    for (int ii = 0; ii < 16; ++ii) {
      const int i = 32 * wi + crow32(ii, hh);
      const float dec = (i >= j) ? expf(gc[i] - gj) : 0.f;
      As[i * 68 + j] = (i > j) ? aK[ii] * bt[i] * dec : 0.f;
      IN[((size_t)cj * 64 + i) * 64 + j] = f2bf((i >= j) ? aQ[ii] * dec : 0.f);
    }
  }
  __syncthreads();

  if (wave == 0) {
    float xcol[64];
#pragma unroll
    for (int i = 0; i < 64; ++i) {
      int lv = lane;
      asm volatile("" : "+v"(lv));
      float s = (i == lv) ? 1.f : 0.f;
#pragma unroll
      for (int j4 = 0; j4 < (i + 3) / 4; ++j4) {
        const float4 a4 = *(const float4*)(As + i * 68 + 4 * j4);
        if (4 * j4 + 0 < i) s -= a4.x * xcol[4 * j4 + 0];
        if (4 * j4 + 1 < i) s -= a4.y * xcol[4 * j4 + 1];
        if (4 * j4 + 2 < i) s -= a4.z * xcol[4 * j4 + 2];
        if (4 * j4 + 3 < i) s -= a4.w * xcol[4 * j4 + 3];
      }
      xcol[i] = s;
      asm volatile("" ::: "memory");
    }
#pragma unroll
    for (int i = 0; i < 64; ++i) Tb[i * 72 + lane] = f2bf(xcol[i]);
  }
  __syncthreads();

  {
    const int hh = lane >> 5;
    f32x16 aU[2], aW[2];
#pragma unroll
    for (int mi = 0; mi < 2; ++mi)
#pragma unroll
      for (int i = 0; i < 16; ++i) { aU[mi][i] = 0.f; aW[mi][i] = 0.f; }
#pragma unroll
    for (int ks = 0; ks < 4; ++ks) {
      const bf16x8 bv = *(const bf16x8*)(Vt + (32 * wave + (lane & 31)) * 72 + 16 * ks + 8 * hh);
      const bf16x8 bk = *(const bf16x8*)(KGt + (32 * wave + (lane & 31)) * 72 + 16 * ks + 8 * hh);
#pragma unroll
      for (int mi = 0; mi < 2; ++mi) {
        const bf16x8 a = *(const bf16x8*)(Tb + (32 * mi + (lane & 31)) * 72 + 16 * ks + 8 * hh);
        aU[mi] = MFMA32(a, bv, aU[mi]);
        aW[mi] = MFMA32(a, bk, aW[mi]);
      }
    }
    const int d = 32 * wave + (lane & 31);
#pragma unroll
    for (int mi = 0; mi < 2; ++mi)
#pragma unroll
      for (int ii = 0; ii < 16; ++ii) {
        const int i = 32 * mi + crow32(ii, hh);
        UU[((size_t)cj * 64 + i) * 128 + d] = f2bf(aU[mi][ii]);
        WW[((size_t)cj * 64 + i) * 128 + d] = f2bf(aW[mi][ii]);
      }
  }
  __syncthreads();
}

DI void conv_items(const Params& p, int bid, int nb) {
  char* ws = p.ws;
  const u16* proj = (const u16*)(ws + OFF_PROJ);
  u16* ymix = (u16*)(ws + OFF_YMIX);
  for (int item = bid * 256 + tidx(); item < T_TOK * 64; item += nb * 256) {
    const int t = item >> 6, c0 = (item & 63) * 8;
    const int s = t & (SEQ - 1);
    float accv[8];
#pragma unroll
    for (int c = 0; c < 8; ++c) accv[c] = 0.f;
#pragma unroll
    for (int k = 0; k < 3; ++k) {
      if (s - 2 + k >= 0) {
        const size_t row = (size_t)(t - 2 + k) * INC;
        float cg8[8], hc8[8];
        unpack8(*(const uint4*)(proj + row + 512 + c0), cg8);
        unpack8(*(const uint4*)(proj + row + 1024 + c0), hc8);
        const float4 w0 = *(const float4*)(p.conv_w + k * 512 + c0), w1 = *(const float4*)(p.conv_w + k * 512 + c0 + 4);
        const float wk[8] = {w0.x, w0.y, w0.z, w0.w, w1.x, w1.y, w1.z, w1.w};
#pragma unroll
        for (int c = 0; c < 8; ++c) accv[c] += wk[c] * cg8[c] * hc8[c];
      }
    }
    float bg[8];
    unpack8(*(const uint4*)(proj + (size_t)t * INC + c0), bg);
#pragma unroll
    for (int c = 0; c < 8; ++c) accv[c] *= bg[c];
    *(uint4*)(ymix + (size_t)t * 1024 + c0) = pack8(accv);
  }
}

DI void phase_chunks(const Params& p, char* smem) {
  char* ws = p.ws;
  for (int cj = blockIdx.x; cj < 2048; cj += gridDim.x) chunk_job(p, cj, smem);
  if (gridDim.x < 256) conv_items(p, blockIdx.x, gridDim.x);
}

struct ScanFrag {
  bf16x8 wf[4], qf[4], inf[2], kf[2][2];
  float uf[4];
  float gl;
};

DI void phase_scan(const Params& p, char* smem) {
  char* ws = p.ws;
  if (blockIdx.x >= 128) {
    if (gridDim.x >= 256) {
      const int bid = blockIdx.x - 128, nb = gridDim.x - 128;
      conv_items(p, bid, nb);
      kv_gemm(p, smem, bid, nb);
      weight_transposes(p, smem, 0x36u, bid, nb);
      keys_convert(p, bid, nb);
      rowconv8(p.expert_u, (unsigned char*)(ws + OFF_EU), p.norm_ffn, EU_SCALE, 16384, bid, nb);
      rowconv8(p.expert_v, (unsigned char*)(ws + OFF_EV), nullptr, EV_SCALE, 16384, bid, nb);
    }
    return;
  }
  const int tid = tidx(), lane = tid & 63, w = tid >> 6, m = lane & 15, g = lane >> 4;
  const int bid = blockIdx.x;
  const int bh = (bid & 7) + 8 * ((bid >> 3) & 1), sl = bid >> 4;
  const int b = bh >> 2, h = bh & 3, e0 = sl * 16;
  u16* ST = (u16*)smem;
  u16* VT = (u16*)(smem + 4352);
  const u16* QD = (const u16*)p.out;
  const u16* KD = (const u16*)((const char*)p.out + 32 * MiB);
  const u16* UU = (const u16*)((const char*)p.out + 64 * MiB);
  const u16* WW = (const u16*)((const char*)p.out + 96 * MiB);
  const u16* IN = (const u16*)(ws + OFF_XB);
  const float* GL = (const float*)(ws + OFF_GL);
  u16* ymix = (u16*)(ws + OFF_YMIX);

  for (int i = tid; i < 16 * 136 / 2; i += 256) ((uint32_t*)ST)[i] = 0u;
  f32x4 Sacc[2];
#pragma unroll
  for (int mt = 0; mt < 2; ++mt)
#pragma unroll
    for (int j = 0; j < 4; ++j) Sacc[mt][j] = 0.f;

  auto load = [&](int c, ScanFrag& f) {
    const u16* wp = WW + ((size_t)c * 64 + 16 * w + m) * 128 + 8 * g;
    const u16* qp = QD + ((size_t)c * 64 + 16 * w + m) * 128 + 8 * g;
#pragma unroll
    for (int ks = 0; ks < 4; ++ks) { f.wf[ks] = *(const bf16x8*)(wp + 32 * ks); f.qf[ks] = *(const bf16x8*)(qp + 32 * ks); }
    const u16* ip = IN + ((size_t)c * 64 + 16 * w + m) * 64 + 8 * g;
#pragma unroll
    for (int ks = 0; ks < 2; ++ks) f.inf[ks] = *(const bf16x8*)(ip + 32 * ks);
#pragma unroll
    for (int mt = 0; mt < 2; ++mt)
#pragma unroll
      for (int ks = 0; ks < 2; ++ks) f.kf[mt][ks] = *(const bf16x8*)(KD + ((size_t)c * 128 + 32 * w + 16 * mt + m) * 64 + 32 * ks + 8 * g);
#pragma unroll
    for (int j = 0; j < 4; ++j) f.uf[j] = bf2f(UU[((size_t)c * 64 + 16 * w + 4 * g + j) * 128 + e0 + m]);
    f.gl = GL[c];
  };

  const int c0 = bh * 128;
  const int t0 = b * SEQ;
  ScanFrag cur, nxt;
  load(c0, cur);
  nxt = cur;
  __syncthreads();
  for (int n = 0; n < 128; ++n) {
    if (n + 1 < 128) load(c0 + n + 1, nxt);
    f32x4 av = {0.f, 0.f, 0.f, 0.f}, aq = {0.f, 0.f, 0.f, 0.f};
#pragma unroll
    for (int ks = 0; ks < 4; ++ks) {
      const bf16x8 sf = *(const bf16x8*)(ST + m * 136 + 32 * ks + 8 * g);
      av = MFMA16(cur.wf[ks], sf, av);
      aq = MFMA16(cur.qf[ks], sf, aq);
    }
    float vn[4];
#pragma unroll
    for (int j = 0; j < 4; ++j) vn[j] = cur.uf[j] - av[j];
    *(uint2*)(VT + m * 72 + 16 * w + 4 * g) = make_uint2(pack2(vn[0], vn[1]), pack2(vn[2], vn[3]));
    __syncthreads();
    bf16x8 vf[2];
#pragma unroll
    for (int ks = 0; ks < 2; ++ks) vf[ks] = *(const bf16x8*)(VT + m * 72 + 32 * ks + 8 * g);
#pragma unroll
    for (int ks = 0; ks < 2; ++ks) aq = MFMA16(cur.inf[ks], vf[ks], aq);
#pragma unroll
    for (int j = 0; j < 4; ++j)
      ymix[(size_t)(t0 + n * 64 + 16 * w + 4 * g + j) * 1024 + 512 + h * 128 + e0 + m] = f2bf(aq[j]);
#pragma unroll
    for (int mt = 0; mt < 2; ++mt) {
#pragma unroll
      for (int j = 0; j < 4; ++j) Sacc[mt][j] *= cur.gl;
#pragma unroll
      for (int ks = 0; ks < 2; ++ks) Sacc[mt] = MFMA16(cur.kf[mt][ks], vf[ks], Sacc[mt]);
      *(uint2*)(ST + m * 136 + 32 * w + 16 * mt + 4 * g) = make_uint2(pack2(Sacc[mt][0], Sacc[mt][1]), pack2(Sacc[mt][2], Sacc[mt][3]));
    }
    __syncthreads();
    cur = nxt;
  }
}

DI void phase_gate(const Params& p) {
  char* ws = p.ws;
  const u16* proj = (const u16*)(ws + OFF_PROJ);
  u16* ymix = (u16*)(ws + OFF_YMIX);
  for (int item = blockIdx.x * 256 + tidx(); item < T_TOK * 64; item += gridDim.x * 256) {
    const int t = item >> 6, hh = (item >> 4) & 3, part = item & 15;
    u16* op = ymix + (size_t)t * 1024 + 512 + hh * 128 + part * 8;
    float o[8], z[8];
    unpack8(*(const uint4*)op, o);
    unpack8(*(const uint4*)(proj + (size_t)t * INC + 3072 + hh * 128 + part * 8), z);
    float ss = 0.f;
#pragma unroll
    for (int c = 0; c < 8; ++c) ss += o[c] * o[c];
    ss += __shfl_xor(ss, 1); ss += __shfl_xor(ss, 2); ss += __shfl_xor(ss, 4); ss += __shfl_xor(ss, 8);
    const float rn = rsqrtf(ss * (1.f / 128.f) + EPS);
    const float4 g0 = *(const float4*)(p.dn_norm + part * 8), g1 = *(const float4*)(p.dn_norm + part * 8 + 4);
    const float gg[8] = {g0.x, g0.y, g0.z, g0.w, g1.x, g1.y, g1.z, g1.w};
#pragma unroll
    for (int c = 0; c < 8; ++c) o[c] = o[c] * rn * gg[c] * silu_f(z[c]);
    *(uint4*)op = pack8(o);
  }
}

DI void phase_attn(const Params& p, char* smem) {
  char* ws = p.ws;
  const int tid = tidx(), lane = tid & 63, wave = tid >> 6, m = lane & 15, g = lane >> 4;
  const u16* QX = (const u16*)(ws + OFF_QX);
  const u16* KX = (const u16*)(ws + OFF_KX);
  const u16* VTp = (const u16*)(ws + OFF_VT);
  u16* OX = (u16*)(ws + OFF_OX);
  u16* Kc = (u16*)smem;
  u16* Vc = (u16*)(smem + 34816);
  for (int job = blockIdx.x; job < 2048; job += gridDim.x) {
    const int head = job & 3, qt = (job >> 2) & 127, b = job >> 9;
    const size_t qrow = (size_t)b * SEQ + qt * 64 + wave * 16;
    bf16x8 qf[8];
#pragma unroll
    for (int ks = 0; ks < 8; ++ks) qf[ks] = *(const bf16x8*)(QX + (qrow + m) * 1024 + head * 256 + 32 * ks + 8 * g);
    const u16* kb = KX + (size_t)(b * 4 + head) * 65536;
    const u16* vb = VTp + (size_t)(b * 4 + head) * 65536;
    const u16* ksrc = kb + (size_t)(tid >> 5) * 256 + (tid & 31) * 8;
    const u16* vsrc = vb + (size_t)(tid >> 3) * 256 + (tid & 7) * 8;
    u16* kdst = Kc + (tid >> 5) * 264 + (tid & 31) * 8;
    u16* vdst = Vc + (tid >> 3) * 72 + (tid & 7) * 8;

    u32x4 st[8];
#define ATT_ISSUE_K(c_) { _Pragma("unroll") for (int i = 0; i < 8; ++i) gload16(st[i], ksrc + (size_t)((c_) * 64 + i * 8) * 256); }
#define ATT_ISSUE_V(c_) { _Pragma("unroll") for (int i = 0; i < 8; ++i) gload16(st[i], vsrc + (size_t)(i * 32) * 256 + (c_) * 64); }
#define ATT_LAND_K() { gwait8_all(st[0], st[1], st[2], st[3], st[4], st[5], st[6], st[7]); \
                       _Pragma("unroll") for (int i = 0; i < 8; ++i) *(u32x4*)(kdst + i * 8 * 264) = st[i]; }
#define ATT_LAND_V() { gwait8_all(st[0], st[1], st[2], st[3], st[4], st[5], st[6], st[7]); \
                       _Pragma("unroll") for (int i = 0; i < 8; ++i) *(u32x4*)(vdst + i * 32 * 72) = st[i]; }
    f32x4 s[16];
#pragma unroll
    for (int mt = 0; mt < 16; ++mt) s[mt] = {0.f, 0.f, 0.f, 0.f};
    ATT_ISSUE_K(0)
#pragma unroll
    for (int kc = 0; kc < 4; ++kc) {
      ATT_LAND_K()
      if (kc < 3) ATT_ISSUE_K(kc + 1) else ATT_ISSUE_V(0)
      __syncthreads();
      const u16* kbase = Kc + m * 264 + 8 * g;
      asm volatile("" : "+v"(kbase));
#pragma unroll
      for (int mt2 = 0; mt2 < 4; ++mt2)
#pragma unroll
        for (int ks = 0; ks < 8; ++ks) {
          const bf16x8 a = *(const bf16x8*)(kbase + 16 * mt2 * 264 + 32 * ks);
          s[kc * 4 + mt2] = MFMA16(a, qf[ks], s[kc * 4 + mt2]);
          if (ks == 7) asm volatile("" ::: "memory");
        }
      __syncthreads();
    }
    float mx = -1e30f;
#pragma unroll
    for (int mt = 0; mt < 16; ++mt)
#pragma unroll
      for (int j = 0; j < 4; ++j) { s[mt][j] *= 0.0625f; mx = fmaxf(mx, s[mt][j]); }
    mx = fmaxf(mx, __shfl_xor(mx, 16)); mx = fmaxf(mx, __shfl_xor(mx, 32));
    float sum = 0.f;
#pragma unroll
    for (int mt = 0; mt < 16; ++mt)
#pragma unroll
      for (int j = 0; j < 4; ++j) { s[mt][j] = __expf(s[mt][j] - mx); sum += s[mt][j]; }
    sum += __shfl_xor(sum, 16); sum += __shfl_xor(sum, 32);
    const float inv = 1.f / sum;
    bf16x8 pf[8];
#pragma unroll
    for (int k2 = 0; k2 < 8; ++k2) {
      uint4 u = make_uint4(pack2(s[2 * k2][0], s[2 * k2][1]), pack2(s[2 * k2][2], s[2 * k2][3]),
                           pack2(s[2 * k2 + 1][0], s[2 * k2 + 1][1]), pack2(s[2 * k2 + 1][2], s[2 * k2 + 1][3]));
      pf[k2] = __builtin_bit_cast(bf16x8, u);
    }
    float invr[4];
#pragma unroll
    for (int j = 0; j < 4; ++j) invr[j] = __shfl(inv, 4 * g + j);
    f32x4 o[16];
#pragma unroll
    for (int nt = 0; nt < 16; ++nt) o[nt] = {0.f, 0.f, 0.f, 0.f};
#pragma unroll
    for (int vc = 0; vc < 4; ++vc) {
      ATT_LAND_V()
      if (vc < 3) ATT_ISSUE_V(vc + 1)
      __syncthreads();
      const u16* vbase = Vc + m * 72 + 4 * g;
      asm volatile("" : "+v"(vbase));
#pragma unroll
      for (int nt = 0; nt < 16; ++nt) {
#pragma unroll
        for (int k2l = 0; k2l < 2; ++k2l) {
          const uint2 lo = *(const uint2*)(vbase + 16 * nt * 72 + 32 * k2l);
          const uint2 hi = *(const uint2*)(vbase + 16 * nt * 72 + 32 * k2l + 16);
          const uint4 u = make_uint4(lo.x, lo.y, hi.x, hi.y);
          o[nt] = MFMA16(pf[2 * vc + k2l], __builtin_bit_cast(bf16x8, u), o[nt]);
        }
        if ((nt & 3) == 3) asm volatile("" ::: "memory");
      }
      __syncthreads();
    }
#undef ATT_ISSUE_K
#undef ATT_ISSUE_V
#undef ATT_LAND_K
#undef ATT_LAND_V
#pragma unroll
    for (int j = 0; j < 4; ++j) {
      u16* ob = OX + (qrow + 4 * g + j) * 1024 + head * 256 + m;
      asm volatile("" : "+v"(ob));
#pragma unroll
      for (int nt = 0; nt < 16; ++nt) ob[16 * nt] = f2bf(o[nt][j] * invr[j]);
    }
  }
}

DI uint32_t ordf(float f) { uint32_t u = __float_as_uint(f); return u ^ ((uint32_t)((int32_t)u >> 31) | 0x80000000u); }
DI float unordf(uint32_t k) { return __uint_as_float(k ^ ((~(uint32_t)((int32_t)k >> 31)) | 0x80000000u)); }
DI void ins32(uint32_t (&top)[16], uint32_t x) {
#pragma unroll
  for (int i = 0; i < 16; ++i) { const uint32_t hi = max(top[i], x); x = min(top[i], x); top[i] = hi; }
}
DI void ins64(uint32_t (&tk)[16], uint32_t (&tv)[16], uint32_t xk, uint32_t xv) {
#pragma unroll
  for (int i = 0; i < 16; ++i) {
    const bool gt = xk > tk[i];
    const uint32_t nk = gt ? xk : tk[i], nv = gt ? xv : tv[i];
    xk = gt ? tk[i] : xk; xv = gt ? tv[i] : xv;
    tk[i] = nk; tv[i] = nv;
  }
}

DI void sort16_desc(uint32_t (&v)[16]) {
#pragma unroll
  for (int k = 2; k <= 16; k <<= 1)
#pragma unroll
    for (int j = k >> 1; j > 0; j >>= 1)
#pragma unroll
      for (int i = 0; i < 16; ++i) {
        const int l = i ^ j;
        if (l > i) {
          const uint32_t hi = max(v[i], v[l]), lo = min(v[i], v[l]);
          if ((i & k) == 0) { v[i] = hi; v[l] = lo; } else { v[i] = lo; v[l] = hi; }
        }
      }
}
DI void merge16_desc(uint32_t (&a)[16], const uint32_t (&b)[16]) {
#pragma unroll
  for (int i = 0; i < 16; ++i) a[i] = max(a[i], b[15 - i]);
#pragma unroll
  for (int st = 8; st >= 1; st >>= 1)
#pragma unroll
    for (int i = 0; i < 16; ++i)
      if ((i & st) == 0) { const uint32_t hi = max(a[i], a[i + st]), lo = min(a[i], a[i + st]); a[i] = hi; a[i + st] = lo; }
}

__device__ constexpr int PAIR_I[50] = {0,0,0,0,0,0,0,0,0,0,0,0,0,0,0,0,1,1,1,1,1,1,1,1,2,2,2,2,2,3,3,3,3,4,4,4,5,5,6,6,7,7,8,9,10,11,12,13,14,15};
__device__ constexpr int PAIR_J[50] = {0,1,2,3,4,5,6,7,8,9,10,11,12,13,14,15,0,1,2,3,4,5,6,7,0,1,2,3,4,0,1,2,3,0,1,2,0,1,0,1,0,1,0,0,0,0,0,0,0,0};

DI void phase_topk(const Params& p) {
  char* ws = p.ws;
  const int lane = tidx() & 63, l31 = lane & 31, hh = lane >> 5;
  const uint32_t hh4 = (uint32_t)hh << 2;
  const u16* PQ = (const u16*)(ws + OFF_PQ);
  const u16* KEYS = (const u16*)(ws + OFF_KEYS);
  int* SELI = (int*)(ws + OFF_SELI);
  float* SELG = (float*)(ws + OFF_SELG);
  const int gw = blockIdx.x * 4 + (tidx() >> 6), nw = gridDim.x * 4;
  for (int job = gw; job < 1024 * 8; job += nw) {
    const int hd = job & 7, tt = job >> 3;
    const size_t tok = (size_t)tt * 32 + l31;
    uint32_t top[2][16];
#pragma unroll
    for (int pp = 0; pp < 2; ++pp) {
      bf16x8 qf[4];
#pragma unroll
      for (int ks = 0; ks < 4; ++ks) qf[ks] = *(const bf16x8*)(PQ + tok * 1024 + hd * 128 + pp * 64 + 16 * ks + 8 * hh);
      f32x16 acc[4];
#pragma unroll
      for (int mt = 0; mt < 4; ++mt) {
#pragma unroll
        for (int i = 0; i < 16; ++i) acc[mt][i] = 0.f;
#pragma unroll
        for (int ks = 0; ks < 4; ++ks) {
          const bf16x8 a = *(const bf16x8*)(KEYS + (size_t)((hd * 2 + pp) * 128 + 32 * mt + l31) * 64 + 16 * ks + 8 * hh);
          acc[mt] = MFMA32(a, qf[ks], acc[mt]);
        }
      }
      uint32_t lst[4][16];
#pragma unroll
      for (int mt = 0; mt < 4; ++mt) {
#pragma unroll
        for (int i = 0; i < 16; ++i) {
          const uint32_t kc = (uint32_t)(127 - (32 * mt + (i & 3) + 8 * (i >> 2)));
          lst[mt][i] = ((ordf(acc[mt][i]) & 0xFFFFFF80u) | kc) ^ hh4;
        }
        sort16_desc(lst[mt]);
      }
      merge16_desc(lst[0], lst[1]);
      merge16_desc(lst[2], lst[3]);
      merge16_desc(lst[0], lst[2]);
#pragma unroll
      for (int i = 0; i < 16; ++i) top[pp][i] = lst[0][i];
      uint32_t c[16];
#pragma unroll
      for (int i = 0; i < 16; ++i) c[i] = max(top[pp][i], (uint32_t)__shfl_xor((int)top[pp][15 - i], 32));
#pragma unroll
      for (int st = 8; st >= 1; st >>= 1)
#pragma unroll
        for (int i = 0; i < 16; ++i)
          if ((i & st) == 0) { const uint32_t hi = max(c[i], c[i + st]), lo = min(c[i], c[i + st]); c[i] = hi; c[i + st] = lo; }
#pragma unroll
      for (int i = 0; i < 16; ++i) top[pp][i] = c[i];
    }
    uint32_t tk[16], tv[16];
#pragma unroll
    for (int i = 0; i < 16; ++i) { tk[i] = 0u; tv[i] = 0u; }
#pragma unroll
    for (int q = 0; q < 25; ++q) {
      const int ia = PAIR_I[2 * q], ja = PAIR_J[2 * q], ib = PAIR_I[2 * q + 1], jb = PAIR_J[2 * q + 1];
      const uint32_t k1 = hh ? top[0][ib] : top[0][ia];
      const uint32_t k2 = hh ? top[1][jb] : top[1][ja];
      const float xs = unordf(k1 & 0xFFFFFF80u) + unordf(k2 & 0xFFFFFF80u);
      const uint32_t xv = (127u - (k1 & 127u)) * 128u + (127u - (k2 & 127u));
      ins64(tk, tv, ordf(xs), xv);
    }
    {
      uint32_t ck[16], cv[16];
#pragma unroll
      for (int i = 0; i < 16; ++i) {
        const uint32_t ok = (uint32_t)__shfl_xor((int)tk[15 - i], 32), ov = (uint32_t)__shfl_xor((int)tv[15 - i], 32);
        const bool gt = ok > tk[i];
        ck[i] = gt ? ok : tk[i]; cv[i] = gt ? ov : tv[i];
      }
#pragma unroll
      for (int i = 0; i < 16; ++i) { tk[i] = ck[i]; tv[i] = cv[i]; }
    }
    float e[16], sum = 0.f;
    uint32_t mk = tk[0];
#pragma unroll
    for (int i = 1; i < 16; ++i) mk = max(mk, tk[i]);
    const float mx = unordf(mk);
#pragma unroll
    for (int i = 0; i < 16; ++i) { e[i] = __expf(unordf(tk[i]) - mx); sum += e[i]; }
    const float inv = 1.f / sum;
    int* ip = SELI + (tok * 8 + hd) * 16;
    float* gp = SELG + (tok * 8 + hd) * 16;
    if (hh == 0) {
      *(uint4*)ip = make_uint4(tv[0], tv[1], tv[2], tv[3]);
      *(uint4*)(ip + 4) = make_uint4(tv[4], tv[5], tv[6], tv[7]);
      *(uint4*)(ip + 8) = make_uint4(tv[8], tv[9], tv[10], tv[11]);
      *(uint4*)(ip + 12) = make_uint4(tv[12], tv[13], tv[14], tv[15]);
      *(float4*)gp = make_float4(e[0] * inv, e[1] * inv, e[2] * inv, e[3] * inv);
      *(float4*)(gp + 4) = make_float4(e[4] * inv, e[5] * inv, e[6] * inv, e[7] * inv);
      *(float4*)(gp + 8) = make_float4(e[8] * inv, e[9] * inv, e[10] * inv, e[11] * inv);
      *(float4*)(gp + 12) = make_float4(e[12] * inv, e[13] * inv, e[14] * inv, e[15] * inv);
    }
  }
}

DI bf16x8 fp8x8_to_bf16(uint32_t d0, uint32_t d1) {
  const bf16x2v c0 = __builtin_amdgcn_cvt_scalef32_pk_bf16_fp8((int)d0, 1.0f, false);
  const bf16x2v c1 = __builtin_amdgcn_cvt_scalef32_pk_bf16_fp8((int)d0, 1.0f, true);
  const bf16x2v c2 = __builtin_amdgcn_cvt_scalef32_pk_bf16_fp8((int)d1, 1.0f, false);
  const bf16x2v c3 = __builtin_amdgcn_cvt_scalef32_pk_bf16_fp8((int)d1, 1.0f, true);
  const uint4 u = make_uint4(__builtin_bit_cast(uint32_t, c0), __builtin_bit_cast(uint32_t, c1), __builtin_bit_cast(uint32_t, c2), __builtin_bit_cast(uint32_t, c3));
  return __builtin_bit_cast(bf16x8, u);
}

DI void phase_peer(const Params& p, char* smem, float* dst) {
  char* ws = p.ws;
  const int tid = tidx(), lane = tid & 63, wave = tid >> 6, m = lane & 15, g = lane >> 4;
  const u16* HB = (const u16*)(ws + OFF_XB);
  const unsigned char* EU = (const unsigned char*)(ws + OFF_EU);
  const unsigned char* EV = (const unsigned char*)(ws + OFF_EV);
  const int* SELI = (const int*)(ws + OFF_SELI);
  const float* SELG = (const float*)(ws + OFF_SELG);
  const float* SSQ = (const float*)(ws + OFF_SSQ2);
  float* coef = (float*)(smem + wave * 1024);
  int* idxs = (int*)(smem + wave * 1024 + 512);
  for (int tile = blockIdx.x; tile < T_TOK / 4; tile += gridDim.x) {
    const size_t t = (size_t)tile * 4 + wave;
    const float4 q0 = *(const float4*)(SSQ + t * 8), q1 = *(const float4*)(SSQ + t * 8 + 4);
    const float rstd = rsqrtf((q0.x + q0.y + q0.z + q0.w + q1.x + q1.y + q1.z + q1.w) * (1.f / 1024.f) + EPS) * (1.f / EU_SCALE);
    int myidx[8];
#pragma unroll
    for (int grp = 0; grp < 8; ++grp) myidx[grp] = SELI[t * 128 + grp * 16 + m];
    f32x4 acc[8];
#pragma unroll
    for (int grp = 0; grp < 8; ++grp) acc[grp] = {0.f, 0.f, 0.f, 0.f};
    for (int kb2 = 0; kb2 < 8; ++kb2) {
      bf16x8 xf[4];
#pragma unroll
      for (int j = 0; j < 4; ++j) xf[j] = *(const bf16x8*)(HB + t * 1024 + kb2 * 128 + g * 32 + 8 * j);
      uint4 raw0[8], raw1[8];
#pragma unroll
      for (int grp = 0; grp < 8; ++grp) {
        const unsigned char* up = EU + (size_t)myidx[grp] * 1024 + kb2 * 128 + g * 32;
        raw0[grp] = *(const uint4*)up;
        raw1[grp] = *(const uint4*)(up + 16);
      }
#pragma unroll
      for (int grp = 0; grp < 8; ++grp) {
        acc[grp] = MFMA16(fp8x8_to_bf16(raw0[grp].x, raw0[grp].y), xf[0], acc[grp]);
        acc[grp] = MFMA16(fp8x8_to_bf16(raw0[grp].z, raw0[grp].w), xf[1], acc[grp]);
        acc[grp] = MFMA16(fp8x8_to_bf16(raw1[grp].x, raw1[grp].y), xf[2], acc[grp]);
        acc[grp] = MFMA16(fp8x8_to_bf16(raw1[grp].z, raw1[grp].w), xf[3], acc[grp]);
      }
    }
    if (g == 0) {
#pragma unroll
      for (int grp = 0; grp < 8; ++grp) idxs[grp * 16 + m] = myidx[grp];
    }
    if (m == 0) {
#pragma unroll
      for (int grp = 0; grp < 8; ++grp)
#pragma unroll
        for (int j = 0; j < 4; ++j) {
          const int e = grp * 16 + 4 * g + j;
          const float a = acc[grp][j] * rstd;
          const float ge = 0.5f * a * (1.f + erff(a * 0.7071067811865475f));
          coef[e] = SELG[t * 128 + e] * ge * (1.f / EV_SCALE);
        }
    }
    __syncthreads();
    f32x2 y[8];
#pragma unroll
    for (int i = 0; i < 8; ++i) y[i] = {0.f, 0.f};
#pragma unroll 8
    for (int e = 0; e < 128; ++e) {
      const float c = coef[e];
      const f32x2 c2 = {c, c};
      const uint4 r = *(const uint4*)(EV + (size_t)idxs[e] * 1024 + lane * 16);
      y[0] += c2 * __builtin_amdgcn_cvt_pk_f32_fp8((int)r.x, false);
      y[1] += c2 * __builtin_amdgcn_cvt_pk_f32_fp8((int)r.x, true);
      y[2] += c2 * __builtin_amdgcn_cvt_pk_f32_fp8((int)r.y, false);
      y[3] += c2 * __builtin_amdgcn_cvt_pk_f32_fp8((int)r.y, true);
      y[4] += c2 * __builtin_amdgcn_cvt_pk_f32_fp8((int)r.z, false);
      y[5] += c2 * __builtin_amdgcn_cvt_pk_f32_fp8((int)r.z, true);
      y[6] += c2 * __builtin_amdgcn_cvt_pk_f32_fp8((int)r.w, false);
      y[7] += c2 * __builtin_amdgcn_cvt_pk_f32_fp8((int)r.w, true);
    }
    const float* hp = p.out + t * 1024 + lane * 16;
    float* dp = dst + t * 1024 + lane * 16;
    float hv[16];
#pragma unroll
    for (int q = 0; q < 4; ++q) { const float4 h4 = *(const float4*)(hp + 4 * q); hv[4 * q] = h4.x; hv[4 * q + 1] = h4.y; hv[4 * q + 2] = h4.z; hv[4 * q + 3] = h4.w; }
    float ss = 0.f;
#pragma unroll
    for (int i = 0; i < 8; ++i) { hv[2 * i] += y[i][0]; hv[2 * i + 1] += y[i][1]; }
#pragma unroll
    for (int i = 0; i < 16; ++i) ss += hv[i] * hv[i];
    ss = wave_sum(ss);
    const float rn = rsqrtf(ss * (1.f / 1024.f) + EPS);
#pragma unroll
    for (int q = 0; q < 4; ++q) {
      const float4 n4 = *(const float4*)(p.norm_final + lane * 16 + 4 * q);
      *(float4*)(dp + 4 * q) = make_float4(hv[4 * q] * rn * n4.x, hv[4 * q + 1] * rn * n4.y, hv[4 * q + 2] * rn * n4.z, hv[4 * q + 3] * rn * n4.w);
    }
    __syncthreads();
  }
}

#define XB_TMO      128
#define XB_XCNT(j)  (256  + 64 * (j))
#define XB_XSUB(j)  (1280 + 64 * (j))
#define XB_XGEN(j)  (2304 + 64 * (j))
#define XB_TOP      3328
#define XB_TOPGEN   3392
#define XCD_BAR_WORDS 3456
#define XB_SPIN_CAP (1u << 22)
#define LAS __attribute__((address_space(3)))
DI unsigned xb_ld(unsigned* p)              { return __hip_atomic_load(p, __ATOMIC_RELAXED, __HIP_MEMORY_SCOPE_AGENT); }
DI unsigned xb_add(unsigned* p, unsigned v) { return __hip_atomic_fetch_add(p, v, __ATOMIC_RELAXED, __HIP_MEMORY_SCOPE_AGENT); }
DI unsigned xb_xcc_id() { return (unsigned)__builtin_amdgcn_s_getreg((3 << 11) | 20) & 0xFu; }
#define XB_SPIN(cond, bar) do { unsigned _sp = 0; while (cond) { __builtin_amdgcn_s_sleep(1); \
    if ((++_sp & 255u) == 0u) { if (xb_ld(&(bar)[XB_TMO])) break; if (_sp > XB_SPIN_CAP) { atomicAdd(&(bar)[XB_TMO], 1u); break; } } } } while (0)
struct XcdBarrier { unsigned* bar; unsigned x; volatile LAS unsigned* st; };
DI XcdBarrier xcd_barrier_post(unsigned* bar, volatile LAS unsigned* st) {
  XcdBarrier b; b.bar = bar; b.x = xb_xcc_id(); b.st = st;
  if (__builtin_amdgcn_workitem_id_x() == 0) (void)xb_add(&bar[XB_XCNT(b.x)], 1u);
  return b;
}
DI void xcd_barrier_complete(unsigned* bar, unsigned x, unsigned& nloc, unsigned& nx) {
  const unsigned G = gridDim.x * gridDim.y * gridDim.z;
  unsigned sum, cnt, mine, sp = 0u;
  for (;;) {
    sum = 0u; cnt = 0u; mine = 0u;
#pragma unroll
    for (unsigned j = 0; j < 16; ++j) { const unsigned c = xb_ld(&bar[XB_XCNT(j)]); sum += c; cnt += (c > 0u) ? 1u : 0u; mine = (j == x) ? c : mine; }
    if (sum == G) break;
    __builtin_amdgcn_s_sleep(1);
    if ((++sp & 255u) == 0u) { if (xb_ld(&bar[XB_TMO])) break; if (sp > XB_SPIN_CAP) { atomicAdd(&bar[XB_TMO], 1u); break; } }
  }
  nloc = mine > 0u ? mine : 1u; nx = cnt > 0u ? cnt : 1u;
}
DI void xcd_barrier(const XcdBarrier& b) {
  asm volatile("s_waitcnt vmcnt(0)" ::: "memory");
  __syncthreads();
  if (__builtin_amdgcn_workitem_id_x() == 0) {
    unsigned* bar = b.bar;
    __builtin_amdgcn_s_waitcnt(0);
    unsigned nloc = b.st[0], nx = b.st[1];
    if (nloc == 0u) { xcd_barrier_complete(bar, b.x, nloc, nx); b.st[0] = nloc; b.st[1] = nx; }
    const unsigned old = xb_add(&bar[XB_XSUB(b.x)], 1u);
    const unsigned gen = old / nloc;
    if (old + 1u == (gen + 1u) * nloc) {
      __builtin_amdgcn_fence(__ATOMIC_RELEASE, "agent");
      asm volatile("s_waitcnt vmcnt(0)" ::: "memory");
      const unsigned og = xb_add(&bar[XB_TOP], 1u);
      const unsigned tg = og / nx;
      if (og + 1u == (tg + 1u) * nx) xb_add(&bar[XB_TOPGEN], 1u);
      else XB_SPIN(xb_ld(&bar[XB_TOPGEN]) == tg, bar);
      __builtin_amdgcn_fence(__ATOMIC_ACQUIRE, "agent");
      xb_add(&bar[XB_XGEN(b.x)], 1u);
      asm volatile("s_waitcnt vmcnt(0)" ::: "memory");
    } else {
      XB_SPIN(xb_ld(&bar[XB_XGEN(b.x)]) == gen, bar);
      __builtin_amdgcn_fence(__ATOMIC_ACQUIRE, "agent");
      asm volatile("s_waitcnt vmcnt(0)" ::: "memory");
    }
  }
  __syncthreads();
}

__global__ void __launch_bounds__(256, 2) fwd_kernel(Params p_in, int ph_lo, int ph_hi) {
  extern __shared__ __attribute__((aligned(16))) char smem[];
  char* ws0 = p_in.ws;
#ifndef DOUBLE_MASK
#define DOUBLE_MASK 0
#endif
  const bool multi = (ph_hi - ph_lo) > 1;
  XcdBarrier xb;
  if (multi) {
    volatile LAS unsigned* st = (volatile LAS unsigned*)(smem + SMEM_BYTES - 16);
    if (__builtin_amdgcn_workitem_id_x() == 0) { st[0] = 0u; st[1] = 0u; }
    __syncthreads();
    xb = xcd_barrier_post((unsigned*)(ws0 + OFF_BAR), st);
  }
  if (ph_lo < -1000) cg::this_grid().sync();
#if defined(__HIP_DEVICE_COMPILE__)
#define LOAD_PARAMS(dst_) { const __attribute__((address_space(4))) char* kp_ = (const __attribute__((address_space(4))) char*)__builtin_amdgcn_kernarg_segment_ptr(); \
                            asm volatile("" : "+s"(kp_)); __builtin_memcpy(&(dst_), kp_, sizeof(Params)); }
#else
#define LOAD_PARAMS(dst_) { dst_ = p_in; }
#endif
#define RUN_PHASE(k, call) if (ph_lo <= (k) && (k) < ph_hi) { \
    _Pragma("unroll 1") for (int rep = ((DOUBLE_MASK >> (k)) & 1); rep >= 0; --rep) { \
      Params pl; LOAD_PARAMS(pl); const Params& p = pl; char* ws = p.ws; (void)ws; \
      call; if (rep > 0 || (k) + 1 < ph_hi) xcd_barrier(xb); } }
  RUN_PHASE(0, phase_prep(p, smem))
  RUN_PHASE(1, phase_proj(p, smem))
  RUN_PHASE(2, phase_chunks(p, smem))
  RUN_PHASE(3, phase_scan(p, smem))
  RUN_PHASE(4, phase_gate(p))
  RUN_PHASE(5, phase_resid((const u16*)(ws + OFF_YMIX), (const u16*)(ws + OFF_WOUT), p.x, p.out, (u16*)(ws + OFF_XB), (float*)(ws + OFF_SSQ1), smem))
  RUN_PHASE(6, phase_scaled((const u16*)(ws + OFF_XB), (const u16*)(ws + OFF_WXQ), (const float*)(ws + OFF_SSQ1), (u16*)(ws + OFF_QX), smem))
  RUN_PHASE(7, phase_attn(p, smem))
  RUN_PHASE(8, phase_resid((const u16*)(ws + OFF_OX), (const u16*)(ws + OFF_WXO), p.out, p.out, (u16*)(ws + OFF_XB), (float*)(ws + OFF_SSQ2), smem))
  RUN_PHASE(9, phase_scaled((const u16*)(ws + OFF_XB), (const u16*)(ws + OFF_WPQ), (const float*)(ws + OFF_SSQ2), (u16*)(ws + OFF_PQ), smem))
  RUN_PHASE(10, phase_topk(p))
  if (ph_lo <= 11 && 11 < ph_hi) {
    Params pl; LOAD_PARAMS(pl); const Params& p = pl;
#if (DOUBLE_MASK >> 11) & 1
    phase_peer(p, smem, (float*)(p.ws + OFF_PROJ)); xcd_barrier(xb);
#endif
    phase_peer(p, smem, p.out);
  }
}

extern "C" void kernel_launch(void* const* d_in, const int* in_sizes, int n_in, void* d_out, int out_size, void* d_ws, size_t ws_size,
                              hipStream_t stream) {
  static int grid = 0;
  if (grid == 0) {
    if (n_in != 21 || out_size != T_TOK * DM || ws_size < WS_END) {
      fprintf(stderr, "kernel_launch: unexpected shapes (n_in %d out %d ws %zu need %zu)\n", n_in, out_size, ws_size, (size_t)WS_END);
      grid = -1;
      return;
    }
    int dev = 0, cus = 0, per_cu = 0;
    hipGetDevice(&dev);
    hipDeviceGetAttribute(&cus, hipDeviceAttributeMultiprocessorCount, dev);
    hipFuncSetAttribute((const void*)fwd_kernel, hipFuncAttributeMaxDynamicSharedMemorySize, SMEM_BYTES);
    hipOccupancyMaxActiveBlocksPerMultiprocessor(&per_cu, (const void*)fwd_kernel, 256, SMEM_BYTES);
    if (per_cu < 1) per_cu = 1;
    if (per_cu > 2) per_cu = 2;
    grid = cus * per_cu;
    if (grid < 128) { fprintf(stderr, "kernel_launch: grid %d too small\n", grid); grid = -1; return; }
  }
  if (grid < 0) return;
  Params p{};
  const float** pp = (const float**)&p;
  for (int i = 0; i < 21; ++i) pp[i] = (const float*)d_in[i];
  p.out = (float*)d_out;
  p.ws = (char*)d_ws;
#if ONE_LAUNCH
  hipMemsetAsync((char*)d_ws + OFF_BAR, 0, BAR_BYTES, stream);
  int lo = 0, hi = NPH;
  void* args[] = {&p, &lo, &hi};
  hipError_t e = hipLaunchCooperativeKernel((const void*)fwd_kernel, dim3(grid), dim3(256), args, SMEM_BYTES, stream);
  if (e != hipSuccess) fprintf(stderr, "cooperative launch failed: %s (grid %d)\n", hipGetErrorString(e), grid);
#else
  for (int ph = 0; ph < NPH; ++ph) hipLaunchKernelGGL(fwd_kernel, dim3(grid), dim3(256), SMEM_BYTES, stream, p, ph, ph + 1);
#endif
}
```

```cpp
#include <hip/hip_runtime.h>
#include <hip/hip_cooperative_groups.h>
#include <stdint.h>
#include <stdio.h>
namespace cg = cooperative_groups;

typedef unsigned short u16;
using bf16x8 = __attribute__((ext_vector_type(8))) short;
using f32x4  = __attribute__((ext_vector_type(4))) float;
using f32x16 = __attribute__((ext_vector_type(16))) float;
using f32x2  = __attribute__((ext_vector_type(2))) float;
using bf16x2v = __attribute__((ext_vector_type(2))) __bf16;

#define DI __device__ __forceinline__
#define MFMA32(a, b, c) __builtin_amdgcn_mfma_f32_32x32x16_bf16((a), (b), (c), 0, 0, 0)
#define MFMA16(a, b, c) __builtin_amdgcn_mfma_f32_16x16x32_bf16((a), (b), (c), 0, 0, 0)

#ifndef ONE_LAUNCH
#define ONE_LAUNCH 1
#endif

constexpr int T_TOK = 32768;
constexpr int SEQ = 8192;
constexpr int DM = 1024;
constexpr int INC = 3592;
constexpr int NPH = 12;
constexpr float EPS = 1e-6f;
constexpr float EU_SCALE = 64.f, EV_SCALE = 8.f;

constexpr size_t MiB = 1024ull * 1024ull;
constexpr size_t OFF_WIN  = 0;
constexpr size_t OFF_WOUT = OFF_WIN + 3712ull * 1024 * 2;
constexpr size_t OFF_WXQ  = OFF_WOUT + 2 * MiB;
constexpr size_t OFF_WXKV = OFF_WXQ + 2 * MiB;
constexpr size_t OFF_WXO  = OFF_WXKV + 4 * MiB;
constexpr size_t OFF_WPQ  = OFF_WXO + 2 * MiB;
constexpr size_t OFF_KEYS = OFF_WPQ + 2 * MiB;
constexpr size_t OFF_EU   = OFF_KEYS + 262144;
constexpr size_t OFF_EV   = OFF_EU + 32 * MiB;
constexpr size_t OFF_XB   = OFF_EV + 32 * MiB;
constexpr size_t OFF_MEMB = OFF_XB + 64 * MiB;
constexpr size_t OFF_KX   = OFF_MEMB + 2 * MiB;
constexpr size_t OFF_VT   = OFF_KX + 2 * MiB;
constexpr size_t OFF_RSTD0 = OFF_VT + 2 * MiB;
constexpr size_t OFF_RSTDM = OFF_RSTD0 + 131072;
constexpr size_t OFF_SSQ1 = OFF_RSTDM + 4096;
constexpr size_t OFF_SSQ2 = OFF_SSQ1 + 1 * MiB;
constexpr size_t OFF_BA   = OFF_SSQ2 + 1 * MiB;
constexpr size_t OFF_GL   = OFF_BA + 1 * MiB;
constexpr size_t OFF_YMIX = OFF_GL + 8192;
constexpr size_t OFF_PROJ = OFF_YMIX + 64 * MiB;
constexpr size_t PROJ_BYTES = (size_t)T_TOK * INC * 2;
constexpr size_t OFF_BAR  = OFF_PROJ + PROJ_BYTES;
constexpr size_t BAR_BYTES = 16384;
constexpr size_t OFF_TS   = OFF_BAR + BAR_BYTES;
constexpr size_t WS_END   = OFF_TS + 4096;
constexpr size_t OFF_QX   = OFF_PROJ;
constexpr size_t OFF_OX   = OFF_PROJ + 64 * MiB;
constexpr size_t OFF_PQ   = OFF_PROJ + 128 * MiB;
constexpr size_t OFF_SELI = OFF_PROJ + 192 * MiB;
constexpr size_t OFF_SELG = OFF_PROJ + 208 * MiB;

constexpr int SMEM_BYTES = 75776;

struct Params {
  const float *x, *mem, *norm_mix, *w_in, *conv_w, *dn_conv_w, *dn_a_log, *dn_dt_bias, *dn_norm, *w_out,
      *norm_x, *norm_mem, *w_xq, *w_xkv, *w_xo, *norm_ffn, *w_pq, *peer_keys, *expert_u, *expert_v, *norm_final;
  float* out;
  char* ws;
};

DI int tidx() { int t = (int)__builtin_amdgcn_workitem_id_x(); asm volatile("" : "+v"(t)); return t; }
DI u16 f2bf(float x) { return __builtin_bit_cast(u16, (__bf16)x); }
DI float bf2f(u16 v) { return __uint_as_float(((uint32_t)v) << 16); }
DI uint32_t pack2(float a, float b) { const bf16x2v v = {(__bf16)a, (__bf16)b}; return __builtin_bit_cast(uint32_t, v); }
DI float bflo(uint32_t u) { return __uint_as_float(u << 16); }
DI float bfhi(uint32_t u) { return __uint_as_float(u & 0xffff0000u); }
DI int crow32(int i, int h) { return (i & 3) + 8 * (i >> 2) + 4 * h; }
DI float silu_f(float v) { return v / (1.f + __expf(-v)); }
DI float wave_sum(float v) {
#pragma unroll
  for (int o = 32; o >= 1; o >>= 1) v += __shfl_xor(v, o);
  return v;
}
DI void unpack8(const uint4& r, float* f) {
  f[0] = bflo(r.x); f[1] = bfhi(r.x); f[2] = bflo(r.y); f[3] = bfhi(r.y);
  f[4] = bflo(r.z); f[5] = bfhi(r.z); f[6] = bflo(r.w); f[7] = bfhi(r.w);
}
DI uint4 pack8(const float* f) { return make_uint4(pack2(f[0], f[1]), pack2(f[2], f[3]), pack2(f[4], f[5]), pack2(f[6], f[7])); }

DI void rowconv(const float* __restrict__ src, u16* __restrict__ dst, const float* __restrict__ gain, float* __restrict__ rstd, int rows) {
  const int lane = tidx() & 63;
  const int gw = blockIdx.x * 4 + (tidx() >> 6), nw = gridDim.x * 4;
  for (int r = gw; r < rows; r += nw) {
    const float4* s = (const float4*)(src + (size_t)r * 1024);
    float4 a0 = s[lane * 2], a1 = s[lane * 2 + 1], b0 = s[128 + lane * 2], b1 = s[128 + lane * 2 + 1];
    float f[16] = {a0.x, a0.y, a0.z, a0.w, a1.x, a1.y, a1.z, a1.w, b0.x, b0.y, b0.z, b0.w, b1.x, b1.y, b1.z, b1.w};
    if (rstd) {
      float ss = 0.f;
#pragma unroll
      for (int i = 0; i < 16; ++i) ss += f[i] * f[i];
      ss = wave_sum(ss);
      if (lane == 0) rstd[r] = rsqrtf(ss * (1.f / 1024.f) + EPS);
    }
    if (gain) {
      const float4* gp = (const float4*)gain;
      float4 g0 = gp[lane * 2], g1 = gp[lane * 2 + 1], g2 = gp[128 + lane * 2], g3 = gp[128 + lane * 2 + 1];
      float gg[16] = {g0.x, g0.y, g0.z, g0.w, g1.x, g1.y, g1.z, g1.w, g2.x, g2.y, g2.z, g2.w, g3.x, g3.y, g3.z, g3.w};
#pragma unroll
      for (int i = 0; i < 16; ++i) f[i] *= gg[i];
    }
    *(uint4*)(dst + (size_t)r * 1024 + lane * 8) = pack8(f);
    *(uint4*)(dst + (size_t)r * 1024 + 512 + lane * 8) = pack8(f + 8);
  }
}


DI void rowconv8(const float* __restrict__ src, unsigned char* __restrict__ dst, const float* __restrict__ gain, float scale, int rows, int bid, int nb) {
  const int lane = tidx() & 63;
  const int gw = bid * 4 + (tidx() >> 6), nw = nb * 4;
  float gg[16];
#pragma unroll
  for (int i = 0; i < 16; ++i) gg[i] = scale;
  if (gain) {
    const float4* gp = (const float4*)(gain + lane * 16);
#pragma unroll
    for (int q = 0; q < 4; ++q) { const float4 g4 = gp[q]; gg[4 * q] *= g4.x; gg[4 * q + 1] *= g4.y; gg[4 * q + 2] *= g4.z; gg[4 * q + 3] *= g4.w; }
  }
  for (int r = gw; r < rows; r += nw) {
    const float4* s = (const float4*)(src + (size_t)r * 1024 + lane * 16);
    uint32_t o[4];
#pragma unroll
    for (int q = 0; q < 4; ++q) {
      const float4 v = s[q];
      int pk = __builtin_amdgcn_cvt_pk_fp8_f32(v.x * gg[4 * q], v.y * gg[4 * q + 1], 0, false);
      pk = __builtin_amdgcn_cvt_pk_fp8_f32(v.z * gg[4 * q + 2], v.w * gg[4 * q + 3], pk, true);
      o[q] = (uint32_t)pk;
    }
    *(uint4*)(dst + (size_t)r * 1024 + lane * 16) = make_uint4(o[0], o[1], o[2], o[3]);
  }
}

DI void transpose_tile(const float* __restrict__ W, int N, const float* __restrict__ gain, u16* __restrict__ Wt, int nt, int kt, float* tile) {
  const int t = tidx();
  const int k0 = kt * 64, n0 = nt * 64;
#pragma unroll
  for (int i = 0; i < 16; ++i) {
    int kk = i * 4 + (t >> 6), nn = t & 63;
    float v = 0.f;
    if (n0 + nn < N) v = W[(size_t)(k0 + kk) * N + n0 + nn] * (gain ? gain[k0 + kk] : 1.f);
    tile[kk * 65 + nn] = v;
  }
  __syncthreads();
#pragma unroll
  for (int i = 0; i < 16; ++i) {
    int nn = i * 4 + (t >> 6), kk = t & 63;
    if (n0 + nn < N) Wt[(size_t)(n0 + nn) * 1024 + k0 + kk] = f2bf(tile[kk * 65 + nn]);
  }
  __syncthreads();
}

DI void weight_transposes(const Params& p, char* smem, unsigned mask, int bid, int nb) {
  char* ws = p.ws;
  const int cnt_all[6] = {57 * 16, 256, 256, 512, 256, 256};
  int cnt[6], total = 0;
  for (int i = 0; i < 6; ++i) { cnt[i] = ((mask >> i) & 1u) ? cnt_all[i] : 0; total += cnt[i]; }
  for (int job = bid; job < total; job += nb) {
    int j = job, w = 0;
    while (j >= cnt[w]) { j -= cnt[w]; ++w; }
    const float* W; const float* gain; u16* dst; int N;
    switch (w) {
      case 0: W = p.w_in; gain = p.norm_mix; dst = (u16*)(ws + OFF_WIN); N = INC; break;
      case 1: W = p.w_out; gain = nullptr; dst = (u16*)(ws + OFF_WOUT); N = 1024; break;
      case 2: W = p.w_xq; gain = p.norm_x; dst = (u16*)(ws + OFF_WXQ); N = 1024; break;
      case 3: W = p.w_xkv; gain = p.norm_mem; dst = (u16*)(ws + OFF_WXKV); N = 2048; break;
      case 4: W = p.w_xo; gain = nullptr; dst = (u16*)(ws + OFF_WXO); N = 1024; break;
      default: W = p.w_pq; gain = p.norm_ffn; dst = (u16*)(ws + OFF_WPQ); N = 1024; break;
    }
    transpose_tile(W, N, gain, dst, j >> 4, j & 15, (float*)smem);
  }
}
DI void keys_convert(const Params& p, int bid, int nb) {
  u16* kd = (u16*)(p.ws + OFF_KEYS);
  for (int i = bid * 256 + tidx(); i < 131072; i += nb * 256) kd[i] = f2bf(p.peer_keys[i]);
}

DI void phase_prep(const Params& p, char* smem) {
  char* ws = p.ws;
  const bool defer = gridDim.x >= 256;
  weight_transposes(p, smem, defer ? 0x09u : 0x3Fu, blockIdx.x, gridDim.x);
  rowconv(p.x, (u16*)(ws + OFF_XB), nullptr, (float*)(ws + OFF_RSTD0), T_TOK);
  rowconv(p.mem, (u16*)(ws + OFF_MEMB), nullptr, (float*)(ws + OFF_RSTDM), 1024);
  if (!defer) {
    rowconv8(p.expert_u, (unsigned char*)(ws + OFF_EU), p.norm_ffn, EU_SCALE, 16384, blockIdx.x, gridDim.x);
    rowconv8(p.expert_v, (unsigned char*)(ws + OFF_EV), nullptr, EV_SCALE, 16384, blockIdx.x, gridDim.x);
    keys_convert(p, blockIdx.x, gridDim.x);
  }
}

typedef unsigned u32x4 __attribute__((ext_vector_type(4)));
DI void gload16(u32x4& dst, const void* p) { asm volatile("global_load_dwordx4 %0, %1, off" : "=&v"(dst) : "v"(p) : "memory"); }
DI void gwait8_all(u32x4& a0, u32x4& a1, u32x4& a2, u32x4& a3, u32x4& b0, u32x4& b1, u32x4& b2, u32x4& b3) {
  asm volatile("s_waitcnt vmcnt(0)" : "+v"(a0), "+v"(a1), "+v"(a2), "+v"(a3), "+v"(b0), "+v"(b1), "+v"(b2), "+v"(b3) : : "memory");
}
DI void gwait8_keep8(u32x4& a0, u32x4& a1, u32x4& a2, u32x4& a3, u32x4& b0, u32x4& b1, u32x4& b2, u32x4& b3) {
  asm volatile("s_waitcnt vmcnt(8)" : "+v"(a0), "+v"(a1), "+v"(a2), "+v"(a3), "+v"(b0), "+v"(b1), "+v"(b2), "+v"(b3) : : "memory");
}

DI void gemm_main(const u16* __restrict__ A, const u16* __restrict__ Bt, int m0, int n0, char* smem, f32x16 (&acc)[2][2]) {
  const int tid = tidx(), lane = tid & 63, wave = tid >> 6;
  const int wm = wave >> 1, wn = wave & 1;
  u16* As = (u16*)smem;
  u16* Bs = (u16*)(smem + 36864);
  const int srow = tid >> 3, scol = (tid & 7) * 8;
  const u16* Ap = A + (size_t)(m0 + srow) * 1024 + scol;
  const u16* Bp = Bt + (size_t)(n0 + srow) * 1024 + scol;
  u32x4 r0a[4], r0b[4], r1a[4], r1b[4];
#pragma unroll
  for (int mi = 0; mi < 2; ++mi)
#pragma unroll
    for (int ni = 0; ni < 2; ++ni)
#pragma unroll
      for (int i = 0; i < 16; ++i) acc[mi][ni][i] = 0.f;
#define ISSUE(ra_, rb_, k_) { _Pragma("unroll") for (int i = 0; i < 4; ++i) { gload16(ra_[i], Ap + (size_t)i * 32 * 1024 + (k_) * 64); gload16(rb_[i], Bp + (size_t)i * 32 * 1024 + (k_) * 64); } }
#define STORE(ra_, rb_, buf_) { u16* as2 = As + (buf_) * 128 * 72; u16* bs2 = Bs + (buf_) * 128 * 72; \
    _Pragma("unroll") for (int i = 0; i < 4; ++i) { *(u32x4*)(as2 + (srow + 32 * i) * 72 + scol) = ra_[i]; *(u32x4*)(bs2 + (srow + 32 * i) * 72 + scol) = rb_[i]; } }
  auto compute = [&](int cur) {
    const u16* as = As + cur * 128 * 72;
    const u16* bs = Bs + cur * 128 * 72;
#pragma unroll
    for (int ks = 0; ks < 4; ++ks) {
      bf16x8 a[2], b[2];
#pragma unroll
      for (int mi = 0; mi < 2; ++mi) a[mi] = *(const bf16x8*)(as + (64 * wm + 32 * mi + (lane & 31)) * 72 + 16 * ks + 8 * (lane >> 5));
#pragma unroll
      for (int ni = 0; ni < 2; ++ni) b[ni] = *(const bf16x8*)(bs + (64 * wn + 32 * ni + (lane & 31)) * 72 + 16 * ks + 8 * (lane >> 5));
#pragma unroll
      for (int mi = 0; mi < 2; ++mi)
#pragma unroll
        for (int ni = 0; ni < 2; ++ni) acc[mi][ni] = MFMA32(b[ni], a[mi], acc[mi][ni]);
    }
  };
  ISSUE(r0a, r0b, 0)
  ISSUE(r1a, r1b, 1)
  gwait8_keep8(r0a[0], r0a[1], r0a[2], r0a[3], r0b[0], r0b[1], r0b[2], r0b[3]);
  STORE(r0a, r0b, 0)
  __syncthreads();
#pragma unroll 1
  for (int kk = 0; kk < 16; kk += 2) {
    const int k2 = (kk + 2 < 16) ? kk + 2 : 15, k3 = (kk + 3 < 16) ? kk + 3 : 15;
    ISSUE(r0a, r0b, k2)
    compute(0);
    gwait8_keep8(r1a[0], r1a[1], r1a[2], r1a[3], r1b[0], r1b[1], r1b[2], r1b[3]);
    STORE(r1a, r1b, 1)
    __syncthreads();
    ISSUE(r1a, r1b, k3)
    compute(1);
    gwait8_keep8(r0a[0], r0a[1], r0a[2], r0a[3], r0b[0], r0b[1], r0b[2], r0b[3]);
    STORE(r0a, r0b, 0)
    __syncthreads();
  }
  gwait8_all(r1a[0], r1a[1], r1a[2], r1a[3], r1b[0], r1b[1], r1b[2], r1b[3]);
#undef ISSUE
#undef STORE
}

DI bool tile_map(int it, int MT, int NT, int& mt, int& nt) {
  const int nb = gridDim.x >> 3;
  if ((gridDim.x & 7) != 0) {
    const int tile = blockIdx.x + it * gridDim.x;
    if (tile >= MT * NT) return false;
    mt = tile / NT; nt = tile % NT;
    return true;
  }
  const int vx = blockIdx.x & 7, lb = blockIdx.x >> 3;
  const int per = (MT >> 3) * NT;
  const int q = it * nb + lb;
  if (q >= per) return false;
  const int grp = q / (8 * NT), r = q % (8 * NT);
  mt = vx * (MT >> 3) + grp * 8 + (r & 7);
  nt = r >> 3;
  return true;
}

DI float* rs_ptr(char* smem) { return (float*)(smem + 73728); }
DI float* sq_ptr(char* smem) { return (float*)(smem + 73728 + 512); }

DI void kv_gemm(const Params& p, char* smem, int bid, int nb);
DI void phase_proj(const Params& p, char* smem) {
  char* ws = p.ws;
  const int tid = tidx(), lane = tid & 63, wave = tid >> 6, wm = wave >> 1, wn = wave & 1, hh = lane >> 5;
  float* rs = rs_ptr(smem);
  u16* proj = (u16*)(ws + OFF_PROJ);
  float* ba = (float*)(ws + OFF_BA);
  for (int it = 0;; ++it) {
    int mt, nt;
    if (!tile_map(it, 256, 29, mt, nt)) break;
    const int m0 = mt * 128, n0 = nt * 128;
    f32x16 acc[2][2];
    gemm_main((const u16*)(ws + OFF_XB), (const u16*)(ws + OFF_WIN), m0, n0, smem, acc);
    if (tid < 128) rs[tid] = ((const float*)(ws + OFF_RSTD0))[m0 + tid];
    __syncthreads();
#pragma unroll
    for (int mi = 0; mi < 2; ++mi) {
      const int rl = 64 * wm + 32 * mi + (lane & 31);
      const float sc = rs[rl];
      const size_t row = (size_t)(m0 + rl);
#pragma unroll
      for (int ni = 0; ni < 2; ++ni)
#pragma unroll
        for (int q = 0; q < 4; ++q) {
          const int col = n0 + 64 * wn + 32 * ni + 8 * q + 4 * hh;
          const float v0 = acc[mi][ni][4 * q] * sc, v1 = acc[mi][ni][4 * q + 1] * sc, v2 = acc[mi][ni][4 * q + 2] * sc, v3 = acc[mi][ni][4 * q + 3] * sc;
          if (col < 3584) *(uint2*)(proj + row * INC + col) = make_uint2(pack2(v0, v1), pack2(v2, v3));
          else if (col < INC) *(float4*)(ba + row * 8 + (col - 3584)) = make_float4(v0, v1, v2, v3);
        }
    }
    __syncthreads();
  }
  if (gridDim.x < 256) kv_gemm(p, smem, blockIdx.x, gridDim.x);
}

DI void kv_gemm(const Params& p, char* smem, int bid, int nb) {
  char* ws = p.ws;
  const int tid = tidx(), lane = tid & 63, wave = tid >> 6, wm = wave >> 1, wn = wave & 1, hh = lane >> 5;
  float* rs = rs_ptr(smem);
  u16* kx = (u16*)(ws + OFF_KX);
  u16* vt = (u16*)(ws + OFF_VT);
  for (int t2 = bid; t2 < 128; t2 += nb) {
    const int mt = t2 >> 4, nt = t2 & 15, m0 = mt * 128, n0 = nt * 128;
    f32x16 acc[2][2];
    gemm_main((const u16*)(ws + OFF_MEMB), (const u16*)(ws + OFF_WXKV), m0, n0, smem, acc);
    if (tid < 128) rs[tid] = ((const float*)(ws + OFF_RSTDM))[m0 + tid];
    __syncthreads();
#pragma unroll
    for (int mi = 0; mi < 2; ++mi) {
      const int rl = 64 * wm + 32 * mi + (lane & 31);
      const float sc = rs[rl];
      const int row = m0 + rl, b = row >> 8, mm = row & 255;
#pragma unroll
      for (int ni = 0; ni < 2; ++ni)
#pragma unroll
        for (int q = 0; q < 4; ++q) {
          const int col = n0 + 64 * wn + 32 * ni + 8 * q + 4 * hh;
          const float v0 = acc[mi][ni][4 * q] * sc, v1 = acc[mi][ni][4 * q + 1] * sc, v2 = acc[mi][ni][4 * q + 2] * sc, v3 = acc[mi][ni][4 * q + 3] * sc;
          if (col < 1024) {
            const int head = col >> 8, d = col & 255;
            *(uint2*)(kx + ((size_t)((b * 4 + head) * 256 + mm)) * 256 + d) = make_uint2(pack2(v0, v1), pack2(v2, v3));
          } else {
            const int c2 = col - 1024, head = c2 >> 8, d = c2 & 255;
            u16* vp = vt + ((size_t)((b * 4 + head) * 256 + d)) * 256 + mm;
            vp[0] = f2bf(v0); vp[256] = f2bf(v1); vp[512] = f2bf(v2); vp[768] = f2bf(v3);
          }
        }
    }
    __syncthreads();
  }
}

DI void phase_resid(const u16* A, const u16* Bt, const float* resid, float* hout, u16* hb, float* ssq, char* smem) {
  const int tid = tidx(), lane = tid & 63, wave = tid >> 6, wm = wave >> 1, wn = wave & 1, hh = lane >> 5;
  float* sq = sq_ptr(smem);
  for (int it = 0;; ++it) {
    int mt, nt;
    if (!tile_map(it, 256, 8, mt, nt)) break;
    const int m0 = mt * 128, n0 = nt * 128;
    f32x16 acc[2][2];
    gemm_main(A, Bt, m0, n0, smem, acc);
    if (tid < 128) sq[tid] = 0.f;
    __syncthreads();
#pragma unroll
    for (int mi = 0; mi < 2; ++mi) {
      const int rl = 64 * wm + 32 * mi + (lane & 31);
      const size_t row = (size_t)(m0 + rl);
      float s2 = 0.f;
#pragma unroll
      for (int ni = 0; ni < 2; ++ni)
#pragma unroll
        for (int q = 0; q < 4; ++q) {
          const int col = n0 + 64 * wn + 32 * ni + 8 * q + 4 * hh;
          const float4 r = *(const float4*)(resid + row * 1024 + col);
          const float h0 = r.x + acc[mi][ni][4 * q], h1 = r.y + acc[mi][ni][4 * q + 1], h2 = r.z + acc[mi][ni][4 * q + 2], h3 = r.w + acc[mi][ni][4 * q + 3];
          *(float4*)(hout + row * 1024 + col) = make_float4(h0, h1, h2, h3);
          *(uint2*)(hb + row * 1024 + col) = make_uint2(pack2(h0, h1), pack2(h2, h3));
          s2 += h0 * h0 + h1 * h1 + h2 * h2 + h3 * h3;
        }
      atomicAdd(&sq[rl], s2);
    }
    __syncthreads();
    if (tid < 128) ssq[(size_t)(m0 + tid) * 8 + nt] = sq[tid];
    __syncthreads();
  }
}

DI void phase_scaled(const u16* A, const u16* Bt, const float* ssq, u16* out, char* smem) {
  const int tid = tidx(), lane = tid & 63, wave = tid >> 6, wm = wave >> 1, wn = wave & 1, hh = lane >> 5;
  float* rs = rs_ptr(smem);
  for (int it = 0;; ++it) {
    int mt, nt;
    if (!tile_map(it, 256, 8, mt, nt)) break;
    const int m0 = mt * 128, n0 = nt * 128;
    f32x16 acc[2][2];
    gemm_main(A, Bt, m0, n0, smem, acc);
    if (tid < 128) {
      const float4* sp = (const float4*)(ssq + (size_t)(m0 + tid) * 8);
      float4 s0 = sp[0], s1 = sp[1];
      rs[tid] = rsqrtf((s0.x + s0.y + s0.z + s0.w + s1.x + s1.y + s1.z + s1.w) * (1.f / 1024.f) + EPS);
    }
    __syncthreads();
#pragma unroll
    for (int mi = 0; mi < 2; ++mi) {
      const int rl = 64 * wm + 32 * mi + (lane & 31);
      const float sc = rs[rl];
#pragma unroll
      for (int ni = 0; ni < 2; ++ni)
#pragma unroll
        for (int q = 0; q < 4; ++q) {
          const int col = n0 + 64 * wn + 32 * ni + 8 * q + 4 * hh;
          *(uint2*)(out + (size_t)(m0 + rl) * 1024 + col) =
              make_uint2(pack2(acc[mi][ni][4 * q] * sc, acc[mi][ni][4 * q + 1] * sc), pack2(acc[mi][ni][4 * q + 2] * sc, acc[mi][ni][4 * q + 3] * sc));
        }
    }
    __syncthreads();
  }
}

DI void chunk_job(const Params& p, int cj, char* smem) {
  char* ws = p.ws;
  const int tid = tidx(), lane = tid & 63, wave = tid >> 6;
  const int bh = cj >> 7, n = cj & 127, b = bh >> 2, h = bh & 3;
  const int t0 = b * SEQ + n * 64;
  u16* Kb  = (u16*)smem;
  u16* Qb  = (u16*)(smem + 17408);
  u16* Vt  = (u16*)(smem + 34816);
  u16* KGt = (u16*)(smem + 53248);
  float* gc = (float*)(smem + 71680);
  float* bt = gc + 64;
  float* As = (float*)(smem + 17408);
  u16* Tb = (u16*)smem;
  const u16* proj = (const u16*)(ws + OFF_PROJ);
  u16* QD = (u16*)p.out;
  u16* KD = (u16*)((char*)p.out + 32 * MiB);
  u16* UU = (u16*)((char*)p.out + 64 * MiB);
  u16* WW = (u16*)((char*)p.out + 96 * MiB);
  u16* IN = (u16*)(ws + OFF_XB);
  float* GL = (float*)(ws + OFF_GL);

  if (wave == 0) {
    const float* ba = (const float*)(ws + OFF_BA) + (size_t)(t0 + lane) * 8;
    const float bl = ba[h], al = ba[4 + h] + p.dn_dt_bias[h];
    const float sp = fmaxf(al, 0.f) + log1pf(expf(-fabsf(al)));
    float g = -expf(p.dn_a_log[h]) * sp;
#pragma unroll
    for (int o = 1; o < 64; o <<= 1) { float v = __shfl_up(g, o); if (lane >= o) g += v; }
    gc[lane] = g;
    bt[lane] = 1.f / (1.f + expf(-bl));
    if (lane == 63) GL[cj] = expf(g);
  }
  __syncthreads();

  {
    const int cgp = tid & 15, ts = tid >> 4;
    const float glast = gc[63];
    float eg[4], ed[4], be[4];
#pragma unroll
    for (int tt = 0; tt < 4; ++tt) { const float gv = gc[4 * ts + tt]; eg[tt] = expf(gv); ed[tt] = expf(glast - gv); be[tt] = bt[4 * ts + tt]; }
#pragma unroll 1
    for (int part = 0; part < 3; ++part) {
      const int cc = part * 512 + h * 128 + cgp * 8;
      const int cb = 1536 + cc;
      float xin[7][8];
#pragma unroll
      for (int r = 0; r < 7; ++r) {
        const int sp = n * 64 + 4 * ts - 3 + r;
        if (sp >= 0) { uint4 raw = *(const uint4*)(proj + (size_t)(t0 + 4 * ts - 3 + r) * INC + cb); unpack8(raw, xin[r]); }
        else {
#pragma unroll
          for (int c = 0; c < 8; ++c) xin[r][c] = 0.f;
        }
      }
      float o[4][8];
#pragma unroll
      for (int tt = 0; tt < 4; ++tt)
#pragma unroll
        for (int c = 0; c < 8; ++c) o[tt][c] = 0.f;
#pragma unroll
      for (int j = 0; j < 4; ++j) {
        const float4 w0 = *(const float4*)(p.dn_conv_w + j * 1536 + cc), w1 = *(const float4*)(p.dn_conv_w + j * 1536 + cc + 4);
        const float wj[8] = {w0.x, w0.y, w0.z, w0.w, w1.x, w1.y, w1.z, w1.w};
#pragma unroll
        for (int tt = 0; tt < 4; ++tt)
#pragma unroll
          for (int c = 0; c < 8; ++c) o[tt][c] += wj[c] * xin[tt + j][c];
      }
#pragma unroll
      for (int tt = 0; tt < 4; ++tt)
#pragma unroll
        for (int c = 0; c < 8; ++c) o[tt][c] = silu_f(o[tt][c]);
      if (part < 2) {
#pragma unroll
        for (int tt = 0; tt < 4; ++tt) {
          float ss = 0.f;
#pragma unroll
          for (int c = 0; c < 8; ++c) ss += o[tt][c] * o[tt][c];
          ss += __shfl_xor(ss, 1); ss += __shfl_xor(ss, 2); ss += __shfl_xor(ss, 4); ss += __shfl_xor(ss, 8);
          const float rn = rsqrtf(ss + EPS) * (part == 0 ? 0.08838834764831845f : 1.f);
#pragma unroll
          for (int c = 0; c < 8; ++c) o[tt][c] *= rn;
        }
      }
      if (part == 0) {
#pragma unroll
        for (int tt = 0; tt < 4; ++tt) {
          const int tok = 4 * ts + tt;
          *(uint4*)(Qb + tok * 136 + cgp * 8) = pack8(o[tt]);
          float qd[8];
#pragma unroll
          for (int c = 0; c < 8; ++c) qd[c] = o[tt][c] * eg[tt];
          *(uint4*)(QD + ((size_t)cj * 64 + tok) * 128 + cgp * 8) = pack8(qd);
        }
      } else if (part == 1) {
#pragma unroll
        for (int tt = 0; tt < 4; ++tt) *(uint4*)(Kb + (4 * ts + tt) * 136 + cgp * 8) = pack8(o[tt]);
#pragma unroll
        for (int c = 0; c < 8; ++c) {
          const int d = cgp * 8 + c;
          *(uint2*)(KGt + d * 72 + 4 * ts) = make_uint2(pack2(o[0][c] * be[0] * eg[0], o[1][c] * be[1] * eg[1]), pack2(o[2][c] * be[2] * eg[2], o[3][c] * be[3] * eg[3]));
          *(uint2*)(KD + ((size_t)cj * 128 + d) * 64 + 4 * ts) = make_uint2(pack2(o[0][c] * ed[0], o[1][c] * ed[1]), pack2(o[2][c] * ed[2], o[3][c] * ed[3]));
        }
      } else {
#pragma unroll
        for (int c = 0; c < 8; ++c) {
          const int d = cgp * 8 + c;
          *(uint2*)(Vt + d * 72 + 4 * ts) = make_uint2(pack2(o[0][c] * be[0], o[1][c] * be[1]), pack2(o[2][c] * be[2], o[3][c] * be[3]));
        }
      }
    }
  }
  __syncthreads();

  {
    const int wi = wave >> 1, wj = wave & 1, hh = lane >> 5;
    f32x16 aK, aQ;
#pragma unroll
    for (int i = 0; i < 16; ++i) { aK[i] = 0.f; aQ[i] = 0.f; }
    if (wi >= wj) {
#pragma unroll
      for (int ks = 0; ks < 8; ++ks) {
        const bf16x8 fk = *(const bf16x8*)(Kb + (32 * wi + (lane & 31)) * 136 + 16 * ks + 8 * hh);
        const bf16x8 fq = *(const bf16x8*)(Qb + (32 * wi + (lane & 31)) * 136 + 16 * ks + 8 * hh);
        const bf16x8 fb = *(const bf16x8*)(Kb + (32 * wj + (lane & 31)) * 136 + 16 * ks + 8 * hh);
        aK = MFMA32(fk, fb, aK);
        aQ = MFMA32(fq, fb, aQ);
      }
    }
    __syncthreads();
    const int j = 32 * wj + (lane & 31);
    const float gj = gc[j];
#pragma unroll
    for (int ii = 0; ii < 16; ++ii) {
      const int i = 32 * wi + crow32(ii, hh);
      const float dec = (i >= j) ? expf(gc[i] - gj) : 0.f;
      As[i * 68 + j] = (i > j) ? aK[ii] * bt[i] * dec : 0.f;
      IN[((size_t)cj * 64 + i) * 64 + j] = f2bf((i >= j) ? aQ[ii] * dec : 0.f);
    }
  }
  __syncthreads();

  if (wave == 0) {
    float xcol[64];
#pragma unroll
    for (int i = 0; i < 64; ++i) {
      int lv = lane;
      asm volatile("" : "+v"(lv));
      float s = (i == lv) ? 1.f : 0.f;
#pragma unroll
      for (int j4 = 0; j4 < (i + 3) / 4; ++j4) {
        const float4 a4 = *(const float4*)(As + i * 68 + 4 * j4);
        if (4 * j4 + 0 < i) s -= a4.x * xcol[4 * j4 + 0];
        if (4 * j4 + 1 < i) s -= a4.y * xcol[4 * j4 + 1];
        if (4 * j4 + 2 < i) s -= a4.z * xcol[4 * j4 + 2];
        if (4 * j4 + 3 < i) s -= a4.w * xcol[4 * j4 + 3];
      }
      xcol[i] = s;
      asm volatile("" ::: "memory");
    }
#pragma unroll
    for (int i = 0; i < 64; ++i) Tb[i * 72 + lane] = f2bf(xcol[i]);
  }
  __syncthreads();

  {
    const int hh = lane >> 5;
    f32x16 aU[2], aW[2];
#pragma unroll
    for (int mi = 0; mi < 2; ++mi)
#pragma unroll
      for (int i = 0; i < 16; ++i) { aU[mi][i] = 0.f; aW[mi][i] = 0.f; }
#pragma unroll
    for (int ks = 0; ks < 4; ++ks) {
      const bf16x8 bv = *(const bf16x8*)(Vt + (32 * wave + (lane & 31)) * 72 + 16 * ks + 8 * hh);
      const bf16x8 bk = *(const bf16x8*)(KGt + (32 * wave + (lane & 31)) * 72 + 16 * ks + 8 * hh);
#pragma unroll
      for (int mi = 0; mi < 2; ++mi) {
        const bf16x8 a = *(const bf16x8*)(Tb + (32 * mi + (lane & 31)) * 72 + 16 * ks + 8 * hh);
        aU[mi] = MFMA32(a, bv, aU[mi]);
        aW[mi] = MFMA32(a, bk, aW[mi]);
      }
    }
    const int d = 32 * wave + (lane & 31);
#pragma unroll
    for (int mi = 0; mi < 2; ++mi)
#pragma unroll
      for (int ii = 0; ii < 16; ++ii) {
        const int i = 32 * mi + crow32(ii, hh);
        UU[((size_t)cj * 64 + i) * 128 + d] = f2bf(aU[mi][ii]);
        WW[((size_t)cj * 64 + i) * 128 + d] = f2bf(aW[mi][ii]);
      }
  }
  __syncthreads();
}

DI void conv_items(const Params& p, int bid, int nb) {
  char* ws = p.ws;
  const u16* proj = (const u16*)(ws + OFF_PROJ);
  u16* ymix = (u16*)(ws + OFF_YMIX);
  for (int item = bid * 256 + tidx(); item < T_TOK * 64; item += nb * 256) {
    const int t = item >> 6, c0 = (item & 63) * 8;
    const int s = t & (SEQ - 1);
    float accv[8];
#pragma unroll
    for (int c = 0; c < 8; ++c) accv[c] = 0.f;
#pragma unroll
    for (int k = 0; k < 3; ++k) {
      if (s - 2 + k >= 0) {
        const size_t row = (size_t)(t - 2 + k) * INC;
        float cg8[8], hc8[8];
        unpack8(*(const uint4*)(proj + row + 512 + c0), cg8);
        unpack8(*(const uint4*)(proj + row + 1024 + c0), hc8);
        const float4 w0 = *(const float4*)(p.conv_w + k * 512 + c0), w1 = *(const float4*)(p.conv_w + k * 512 + c0 + 4);
        const float wk[8] = {w0.x, w0.y, w0.z, w0.w, w1.x, w1.y, w1.z, w1.w};
#pragma unroll
        for (int c = 0; c < 8; ++c) accv[c] += wk[c] * cg8[c] * hc8[c];
      }
    }
    float bg[8];
    unpack8(*(const uint4*)(proj + (size_t)t * INC + c0), bg);
#pragma unroll
    for (int c = 0; c < 8; ++c) accv[c] *= bg[c];
    *(uint4*)(ymix + (size_t)t * 1024 + c0) = pack8(accv);
  }
}

DI void phase_chunks(const Params& p, char* smem) {
  char* ws = p.ws;
  for (int cj = blockIdx.x; cj < 2048; cj += gridDim.x) chunk_job(p, cj, smem);
  if (gridDim.x < 256) conv_items(p, blockIdx.x, gridDim.x);
}

struct ScanFrag {
  bf16x8 wf[4], qf[4], inf[2], kf[2][2];
  float uf[4];
  float gl;
};

DI void phase_scan(const Params& p, char* smem) {
  char* ws = p.ws;
  if (blockIdx.x >= 128) {
    if (gridDim.x >= 256) {
      const int bid = blockIdx.x - 128, nb = gridDim.x - 128;
      conv_items(p, bid, nb);
      kv_gemm(p, smem, bid, nb);
      weight_transposes(p, smem, 0x36u, bid, nb);
      keys_convert(p, bid, nb);
      rowconv8(p.expert_u, (unsigned char*)(ws + OFF_EU), p.norm_ffn, EU_SCALE, 16384, bid, nb);
      rowconv8(p.expert_v, (unsigned char*)(ws + OFF_EV), nullptr, EV_SCALE, 16384, bid, nb);
    }
    return;
  }
  const int tid = tidx(), lane = tid & 63, w = tid >> 6, m = lane & 15, g = lane >> 4;
  const int bid = blockIdx.x;
  const int bh = (bid & 7) + 8 * ((bid >> 3) & 1), sl = bid >> 4;
  const int b = bh >> 2, h = bh & 3, e0 = sl * 16;
  u16* ST = (u16*)smem;
  u16* VT = (u16*)(smem + 4352);
  const u16* QD = (const u16*)p.out;
  const u16* KD = (const u16*)((const char*)p.out + 32 * MiB);
  const u16* UU = (const u16*)((const char*)p.out + 64 * MiB);
  const u16* WW = (const u16*)((const char*)p.out + 96 * MiB);
  const u16* IN = (const u16*)(ws + OFF_XB);
  const float* GL = (const float*)(ws + OFF_GL);
  u16* ymix = (u16*)(ws + OFF_YMIX);

  for (int i = tid; i < 16 * 136 / 2; i += 256) ((uint32_t*)ST)[i] = 0u;
  f32x4 Sacc[2];
#pragma unroll
  for (int mt = 0; mt < 2; ++mt)
#pragma unroll
    for (int j = 0; j < 4; ++j) Sacc[mt][j] = 0.f;

  auto load = [&](int c, ScanFrag& f) {
    const u16* wp = WW + ((size_t)c * 64 + 16 * w + m) * 128 + 8 * g;
    const u16* qp = QD + ((size_t)c * 64 + 16 * w + m) * 128 + 8 * g;
#pragma unroll
    for (int ks = 0; ks < 4; ++ks) { f.wf[ks] = *(const bf16x8*)(wp + 32 * ks); f.qf[ks] = *(const bf16x8*)(qp + 32 * ks); }
    const u16* ip = IN + ((size_t)c * 64 + 16 * w + m) * 64 + 8 * g;
#pragma unroll
    for (int ks = 0; ks < 2; ++ks) f.inf[ks] = *(const bf16x8*)(ip + 32 * ks);
#pragma unroll
    for (int mt = 0; mt < 2; ++mt)
#pragma unroll
      for (int ks = 0; ks < 2; ++ks) f.kf[mt][ks] = *(const bf16x8*)(KD + ((size_t)c * 128 + 32 * w + 16 * mt + m) * 64 + 32 * ks + 8 * g);
#pragma unroll
    for (int j = 0; j < 4; ++j) f.uf[j] = bf2f(UU[((size_t)c * 64 + 16 * w + 4 * g + j) * 128 + e0 + m]);
    f.gl = GL[c];
  };

  const int c0 = bh * 128;
  const int t0 = b * SEQ;
  ScanFrag cur, nxt;
  load(c0, cur);
  nxt = cur;
  __syncthreads();
  for (int n = 0; n < 128; ++n) {
    if (n + 1 < 128) load(c0 + n + 1, nxt);
    f32x4 av = {0.f, 0.f, 0.f, 0.f}, aq = {0.f, 0.f, 0.f, 0.f};
#pragma unroll
    for (int ks = 0; ks < 4; ++ks) {
      const bf16x8 sf = *(const bf16x8*)(ST + m * 136 + 32 * ks + 8 * g);
      av = MFMA16(cur.wf[ks], sf, av);
      aq = MFMA16(cur.qf[ks], sf, aq);
    }
    float vn[4];
#pragma unroll
    for (int j = 0; j < 4; ++j) vn[j] = cur.uf[j] - av[j];
    *(uint2*)(VT + m * 72 + 16 * w + 4 * g) = make_uint2(pack2(vn[0], vn[1]), pack2(vn[2], vn[3]));
    __syncthreads();
    bf16x8 vf[2];
#pragma unroll
    for (int ks = 0; ks < 2; ++ks) vf[ks] = *(const bf16x8*)(VT + m * 72 + 32 * ks + 8 * g);
#pragma unroll
    for (int ks = 0; ks < 2; ++ks) aq = MFMA16(cur.inf[ks], vf[ks], aq);
#pragma unroll
    for (int j = 0; j < 4; ++j)
      ymix[(size_t)(t0 + n * 64 + 16 * w + 4 * g + j) * 1024 + 512 + h * 128 + e0 + m] = f2bf(aq[j]);
#pragma unroll
    for (int mt = 0; mt < 2; ++mt) {
#pragma unroll
      for (int j = 0; j < 4; ++j) Sacc[mt][j] *= cur.gl;
#pragma unroll
      for (int ks = 0; ks < 2; ++ks) Sacc[mt] = MFMA16(cur.kf[mt][ks], vf[ks], Sacc[mt]);
      *(uint2*)(ST + m * 136 + 32 * w + 16 * mt + 4 * g) = make_uint2(pack2(Sacc[mt][0], Sacc[mt][1]), pack2(Sacc[mt][2], Sacc[mt][3]));
    }
    __syncthreads();
    cur = nxt;
  }
}

DI void phase_gate(const Params& p) {
  char* ws = p.ws;
  const u16* proj = (const u16*)(ws + OFF_PROJ);
  u16* ymix = (u16*)(ws + OFF_YMIX);
  for (int item = blockIdx.x * 256 + tidx(); item < T_TOK * 64; item += gridDim.x * 256) {
    const int t = item >> 6, hh = (item >> 4) & 3, part = item & 15;
    u16* op = ymix + (size_t)t * 1024 + 512 + hh * 128 + part * 8;
    float o[8], z[8];
    unpack8(*(const uint4*)op, o);
    unpack8(*(const uint4*)(proj + (size_t)t * INC + 3072 + hh * 128 + part * 8), z);
    float ss = 0.f;
#pragma unroll
    for (int c = 0; c < 8; ++c) ss += o[c] * o[c];
    ss += __shfl_xor(ss, 1); ss += __shfl_xor(ss, 2); ss += __shfl_xor(ss, 4); ss += __shfl_xor(ss, 8);
    const float rn = rsqrtf(ss * (1.f / 128.f) + EPS);
    const float4 g0 = *(const float4*)(p.dn_norm + part * 8), g1 = *(const float4*)(p.dn_norm + part * 8 + 4);
    const float gg[8] = {g0.x, g0.y, g0.z, g0.w, g1.x, g1.y, g1.z, g1.w};
#pragma unroll
    for (int c = 0; c < 8; ++c) o[c] = o[c] * rn * gg[c] * silu_f(z[c]);
    *(uint4*)op = pack8(o);
  }
}

DI void phase_attn(const Params& p, char* smem) {
  char* ws = p.ws;
  const int tid = tidx(), lane = tid & 63, wave = tid >> 6, m = lane & 15, g = lane >> 4;
  const u16* QX = (const u16*)(ws + OFF_QX);
  const u16* KX = (const u16*)(ws + OFF_KX);
  const u16* VTp = (const u16*)(ws + OFF_VT);
  u16* OX = (u16*)(ws + OFF_OX);
  u16* Kc = (u16*)smem;
  u16* Vc = (u16*)(smem + 34816);
  for (int job = blockIdx.x; job < 2048; job += gridDim.x) {
    const int head = job & 3, qt = (job >> 2) & 127, b = job >> 9;
    const size_t qrow = (size_t)b * SEQ + qt * 64 + wave * 16;
    bf16x8 qf[8];
#pragma unroll
    for (int ks = 0; ks < 8; ++ks) qf[ks] = *(const bf16x8*)(QX + (qrow + m) * 1024 + head * 256 + 32 * ks + 8 * g);
    const u16* kb = KX + (size_t)(b * 4 + head) * 65536;
    const u16* vb = VTp + (size_t)(b * 4 + head) * 65536;
    const u16* ksrc = kb + (size_t)(tid >> 5) * 256 + (tid & 31) * 8;
    const u16* vsrc = vb + (size_t)(tid >> 3) * 256 + (tid & 7) * 8;
    u16* kdst = Kc + (tid >> 5) * 264 + (tid & 31) * 8;
    u16* vdst = Vc + (tid >> 3) * 72 + (tid & 7) * 8;

    u32x4 st[8];
#define ATT_ISSUE_K(c_) { _Pragma("unroll") for (int i = 0; i < 8; ++i) gload16(st[i], ksrc + (size_t)((c_) * 64 + i * 8) * 256); }
#define ATT_ISSUE_V(c_) { _Pragma("unroll") for (int i = 0; i < 8; ++i) gload16(st[i], vsrc + (size_t)(i * 32) * 256 + (c_) * 64); }
#define ATT_LAND_K() { gwait8_all(st[0], st[1], st[2], st[3], st[4], st[5], st[6], st[7]); \
                       _Pragma("unroll") for (int i = 0; i < 8; ++i) *(u32x4*)(kdst + i * 8 * 264) = st[i]; }
#define ATT_LAND_V() { gwait8_all(st[0], st[1], st[2], st[3], st[4], st[5], st[6], st[7]); \
                       _Pragma("unroll") for (int i = 0; i < 8; ++i) *(u32x4*)(vdst + i * 32 * 72) = st[i]; }
    f32x4 s[16];
#pragma unroll
    for (int mt = 0; mt < 16; ++mt) s[mt] = {0.f, 0.f, 0.f, 0.f};
    ATT_ISSUE_K(0)
#pragma unroll
    for (int kc = 0; kc < 4; ++kc) {
      ATT_LAND_K()
      if (kc < 3) ATT_ISSUE_K(kc + 1) else ATT_ISSUE_V(0)
      __syncthreads();
      const u16* kbase = Kc + m * 264 + 8 * g;
      asm volatile("" : "+v"(kbase));
#pragma unroll
      for (int mt2 = 0; mt2 < 4; ++mt2)
#pragma unroll
        for (int ks = 0; ks < 8; ++ks) {
          const bf16x8 a = *(const bf16x8*)(kbase + 16 * mt2 * 264 + 32 * ks);
          s[kc * 4 + mt2] = MFMA16(a, qf[ks], s[kc * 4 + mt2]);
          if (ks == 7) asm volatile("" ::: "memory");
        }
      __syncthreads();
    }
    float mx = -1e30f;
#pragma unroll
    for (int mt = 0; mt < 16; ++mt)
#pragma unroll
      for (int j = 0; j < 4; ++j) { s[mt][j] *= 0.0625f; mx = fmaxf(mx, s[mt][j]); }
    mx = fmaxf(mx, __shfl_xor(mx, 16)); mx = fmaxf(mx, __shfl_xor(mx, 32));
    float sum = 0.f;
#pragma unroll
    for (int mt = 0; mt < 16; ++mt)
#pragma unroll
      for (int j = 0; j < 4; ++j) { s[mt][j] = __expf(s[mt][j] - mx); sum += s[mt][j]; }
    sum += __shfl_xor(sum, 16); sum += __shfl_xor(sum, 32);
    const float inv = 1.f / sum;
    bf16x8 pf[8];
#pragma unroll
    for (int k2 = 0; k2 < 8; ++k2) {
      uint4 u = make_uint4(pack2(s[2 * k2][0], s[2 * k2][1]), pack2(s[2 * k2][2], s[2 * k2][3]),
                           pack2(s[2 * k2 + 1][0], s[2 * k2 + 1][1]), pack2(s[2 * k2 + 1][2], s[2 * k2 + 1][3]));
      pf[k2] = __builtin_bit_cast(bf16x8, u);
    }
    float invr[4];
#pragma unroll
    for (int j = 0; j < 4; ++j) invr[j] = __shfl(inv, 4 * g + j);
    f32x4 o[16];
#pragma unroll
    for (int nt = 0; nt < 16; ++nt) o[nt] = {0.f, 0.f, 0.f, 0.f};
#pragma unroll
    for (int vc = 0; vc < 4; ++vc) {
      ATT_LAND_V()
      if (vc < 3) ATT_ISSUE_V(vc + 1)
      __syncthreads();
      const u16* vbase = Vc + m * 72 + 4 * g;
      asm volatile("" : "+v"(vbase));
#pragma unroll
      for (int nt = 0; nt < 16; ++nt) {
#pragma unroll
        for (int k2l = 0; k2l < 2; ++k2l) {
          const uint2 lo = *(const uint2*)(vbase + 16 * nt * 72 + 32 * k2l);
          const uint2 hi = *(const uint2*)(vbase + 16 * nt * 72 + 32 * k2l + 16);
          const uint4 u = make_uint4(lo.x, lo.y, hi.x, hi.y);
          o[nt] = MFMA16(pf[2 * vc + k2l], __builtin_bit_cast(bf16x8, u), o[nt]);
        }
        if ((nt & 3) == 3) asm volatile("" ::: "memory");
      }
      __syncthreads();
    }
#undef ATT_ISSUE_K
#undef ATT_ISSUE_V
#undef ATT_LAND_K
#undef ATT_LAND_V
#pragma unroll
    for (int j = 0; j < 4; ++j) {
      u16* ob = OX + (qrow + 4 * g + j) * 1024 + head * 256 + m;
      asm volatile("" : "+v"(ob));
#pragma unroll
      for (int nt = 0; nt < 16; ++nt) ob[16 * nt] = f2bf(o[nt][j] * invr[j]);
    }
  }
}

DI uint32_t ordf(float f) { uint32_t u = __float_as_uint(f); return u ^ ((uint32_t)((int32_t)u >> 31) | 0x80000000u); }
DI float unordf(uint32_t k) { return __uint_as_float(k ^ ((~(uint32_t)((int32_t)k >> 31)) | 0x80000000u)); }
DI void ins32(uint32_t (&top)[16], uint32_t x) {
#pragma unroll
  for (int i = 0; i < 16; ++i) { const uint32_t hi = max(top[i], x); x = min(top[i], x); top[i] = hi; }
}
DI void ins64(uint32_t (&tk)[16], uint32_t (&tv)[16], uint32_t xk, uint32_t xv) {
#pragma unroll
  for (int i = 0; i < 16; ++i) {
    const bool gt = xk > tk[i];
    const uint32_t nk = gt ? xk : tk[i], nv = gt ? xv : tv[i];
    xk = gt ? tk[i] : xk; xv = gt ? tv[i] : xv;
    tk[i] = nk; tv[i] = nv;
  }
}

DI void sort16_desc(uint32_t (&v)[16]) {
#pragma unroll
  for (int k = 2; k <= 16; k <<= 1)
#pragma unroll
    for (int j = k >> 1; j > 0; j >>= 1)
#pragma unroll
      for (int i = 0; i < 16; ++i) {
        const int l = i ^ j;
        if (l > i) {
          const uint32_t hi = max(v[i], v[l]), lo = min(v[i], v[l]);
          if ((i & k) == 0) { v[i] = hi; v[l] = lo; } else { v[i] = lo; v[l] = hi; }
        }
      }
}
DI void merge16_desc(uint32_t (&a)[16], const uint32_t (&b)[16]) {
#pragma unroll
  for (int i = 0; i < 16; ++i) a[i] = max(a[i], b[15 - i]);
#pragma unroll
  for (int st = 8; st >= 1; st >>= 1)
#pragma unroll
    for (int i = 0; i < 16; ++i)
      if ((i & st) == 0) { const uint32_t hi = max(a[i], a[i + st]), lo = min(a[i], a[i + st]); a[i] = hi; a[i + st] = lo; }
}

__device__ constexpr int PAIR_I[50] = {0,0,0,0,0,0,0,0,0,0,0,0,0,0,0,0,1,1,1,1,1,1,1,1,2,2,2,2,2,3,3,3,3,4,4,4,5,5,6,6,7,7,8,9,10,11,12,13,14,15};
__device__ constexpr int PAIR_J[50] = {0,1,2,3,4,5,6,7,8,9,10,11,12,13,14,15,0,1,2,3,4,5,6,7,0,1,2,3,4,0,1,2,3,0,1,2,0,1,0,1,0,1,0,0,0,0,0,0,0,0};

DI void phase_topk(const Params& p) {
  char* ws = p.ws;
  const int lane = tidx() & 63, l31 = lane & 31, hh = lane >> 5;
  const uint32_t hh4 = (uint32_t)hh << 2;
  const u16* PQ = (const u16*)(ws + OFF_PQ);
  const u16* KEYS = (const u16*)(ws + OFF_KEYS);
  int* SELI = (int*)(ws + OFF_SELI);
  float* SELG = (float*)(ws + OFF_SELG);
  const int gw = blockIdx.x * 4 + (tidx() >> 6), nw = gridDim.x * 4;
  for (int job = gw; job < 1024 * 8; job += nw) {
    const int hd = job & 7, tt = job >> 3;
    const size_t tok = (size_t)tt * 32 + l31;
    uint32_t top[2][16];
#pragma unroll
    for (int pp = 0; pp < 2; ++pp) {
      bf16x8 qf[4];
#pragma unroll
      for (int ks = 0; ks < 4; ++ks) qf[ks] = *(const bf16x8*)(PQ + tok * 1024 + hd * 128 + pp * 64 + 16 * ks + 8 * hh);
      f32x16 acc[4];
#pragma unroll
      for (int mt = 0; mt < 4; ++mt) {
#pragma unroll
        for (int i = 0; i < 16; ++i) acc[mt][i] = 0.f;
#pragma unroll
        for (int ks = 0; ks < 4; ++ks) {
          const bf16x8 a = *(const bf16x8*)(KEYS + (size_t)((hd * 2 + pp) * 128 + 32 * mt + l31) * 64 + 16 * ks + 8 * hh);
          acc[mt] = MFMA32(a, qf[ks], acc[mt]);
        }
      }
      uint32_t lst[4][16];
#pragma unroll
      for (int mt = 0; mt < 4; ++mt) {
#pragma unroll
        for (int i = 0; i < 16; ++i) {
          const uint32_t kc = (uint32_t)(127 - (32 * mt + (i & 3) + 8 * (i >> 2)));
          lst[mt][i] = ((ordf(acc[mt][i]) & 0xFFFFFF80u) | kc) ^ hh4;
        }
        sort16_desc(lst[mt]);
      }
      merge16_desc(lst[0], lst[1]);
      merge16_desc(lst[2], lst[3]);
      merge16_desc(lst[0], lst[2]);
#pragma unroll
      for (int i = 0; i < 16; ++i) top[pp][i] = lst[0][i];
      uint32_t c[16];
#pragma unroll
      for (int i = 0; i < 16; ++i) c[i] = max(top[pp][i], (uint32_t)__shfl_xor((int)top[pp][15 - i], 32));
#pragma unroll
      for (int st = 8; st >= 1; st >>= 1)
#pragma unroll
        for (int i = 0; i < 16; ++i)
          if ((i & st) == 0) { const uint32_t hi = max(c[i], c[i + st]), lo = min(c[i], c[i + st]); c[i] = hi; c[i + st] = lo; }
#pragma unroll
      for (int i = 0; i < 16; ++i) top[pp][i] = c[i];
    }
    uint32_t tk[16], tv[16];
#pragma unroll
    for (int i = 0; i < 16; ++i) { tk[i] = 0u; tv[i] = 0u; }
#pragma unroll
    for (int q = 0; q < 25; ++q) {
      const int ia = PAIR_I[2 * q], ja = PAIR_J[2 * q], ib = PAIR_I[2 * q + 1], jb = PAIR_J[2 * q + 1];
      const uint32_t k1 = hh ? top[0][ib] : top[0][ia];
      const uint32_t k2 = hh ? top[1][jb] : top[1][ja];
      const float xs = unordf(k1 & 0xFFFFFF80u) + unordf(k2 & 0xFFFFFF80u);
      const uint32_t xv = (127u - (k1 & 127u)) * 128u + (127u - (k2 & 127u));
      ins64(tk, tv, ordf(xs), xv);
    }
    {
      uint32_t ck[16], cv[16];
#pragma unroll
      for (int i = 0; i < 16; ++i) {
        const uint32_t ok = (uint32_t)__shfl_xor((int)tk[15 - i], 32), ov = (uint32_t)__shfl_xor((int)tv[15 - i], 32);
        const bool gt = ok > tk[i];
        ck[i] = gt ? ok : tk[i]; cv[i] = gt ? ov : tv[i];
      }
#pragma unroll
      for (int i = 0; i < 16; ++i) { tk[i] = ck[i]; tv[i] = cv[i]; }
    }
    float e[16], sum = 0.f;
    uint32_t mk = tk[0];
#pragma unroll
    for (int i = 1; i < 16; ++i) mk = max(mk, tk[i]);
    const float mx = unordf(mk);
#pragma unroll
    for (int i = 0; i < 16; ++i) { e[i] = __expf(unordf(tk[i]) - mx); sum += e[i]; }
    const float inv = 1.f / sum;
    int* ip = SELI + (tok * 8 + hd) * 16;
    float* gp = SELG + (tok * 8 + hd) * 16;
    if (hh == 0) {
      *(uint4*)ip = make_uint4(tv[0], tv[1], tv[2], tv[3]);
      *(uint4*)(ip + 4) = make_uint4(tv[4], tv[5], tv[6], tv[7]);
      *(uint4*)(ip + 8) = make_uint4(tv[8], tv[9], tv[10], tv[11]);
      *(uint4*)(ip + 12) = make_uint4(tv[12], tv[13], tv[14], tv[15]);
      *(float4*)gp = make_float4(e[0] * inv, e[1] * inv, e[2] * inv, e[3] * inv);
      *(float4*)(gp + 4) = make_float4(e[4] * inv, e[5] * inv, e[6] * inv, e[7] * inv);
      *(float4*)(gp + 8) = make_float4(e[8] * inv, e[9] * inv, e[10] * inv, e[11] * inv);
      *(float4*)(gp + 12) = make_float4(e[12] * inv, e[13] * inv, e[14] * inv, e[15] * inv);
    }
  }
}

DI bf16x8 fp8x8_to_bf16(uint32_t d0, uint32_t d1) {
  const bf16x2v c0 = __builtin_amdgcn_cvt_scalef32_pk_bf16_fp8((int)d0, 1.0f, false);
  const bf16x2v c1 = __builtin_amdgcn_cvt_scalef32_pk_bf16_fp8((int)d0, 1.0f, true);
  const bf16x2v c2 = __builtin_amdgcn_cvt_scalef32_pk_bf16_fp8((int)d1, 1.0f, false);
  const bf16x2v c3 = __builtin_amdgcn_cvt_scalef32_pk_bf16_fp8((int)d1, 1.0f, true);
  const uint4 u = make_uint4(__builtin_bit_cast(uint32_t, c0), __builtin_bit_cast(uint32_t, c1), __builtin_bit_cast(uint32_t, c2), __builtin_bit_cast(uint32_t, c3));
  return __builtin_bit_cast(bf16x8, u);
}

DI void phase_peer(const Params& p, char* smem, float* dst) {
  char* ws = p.ws;
  const int tid = tidx(), lane = tid & 63, wave = tid >> 6, m = lane & 15, g = lane >> 4;
  const u16* HB = (const u16*)(ws + OFF_XB);
  const unsigned char* EU = (const unsigned char*)(ws + OFF_EU);
  const unsigned char* EV = (const unsigned char*)(ws + OFF_EV);
  const int* SELI = (const int*)(ws + OFF_SELI);
  const float* SELG = (const float*)(ws + OFF_SELG);
  const float* SSQ = (const float*)(ws + OFF_SSQ2);
  float* coef = (float*)(smem + wave * 1024);
  int* idxs = (int*)(smem + wave * 1024 + 512);
  for (int tile = blockIdx.x; tile < T_TOK / 4; tile += gridDim.x) {
    const size_t t = (size_t)tile * 4 + wave;
    const float4 q0 = *(const float4*)(SSQ + t * 8), q1 = *(const float4*)(SSQ + t * 8 + 4);
    const float rstd = rsqrtf((q0.x + q0.y + q0.z + q0.w + q1.x + q1.y + q1.z + q1.w) * (1.f / 1024.f) + EPS) * (1.f / EU_SCALE);
    int myidx[8];
#pragma unroll
    for (int grp = 0; grp < 8; ++grp) myidx[grp] = SELI[t * 128 + grp * 16 + m];
    f32x4 acc[8];
#pragma unroll
    for (int grp = 0; grp < 8; ++grp) acc[grp] = {0.f, 0.f, 0.f, 0.f};
    for (int kb2 = 0; kb2 < 8; ++kb2) {
      bf16x8 xf[4];
#pragma unroll
      for (int j = 0; j < 4; ++j) xf[j] = *(const bf16x8*)(HB + t * 1024 + kb2 * 128 + g * 32 + 8 * j);
      uint4 raw0[8], raw1[8];
#pragma unroll
      for (int grp = 0; grp < 8; ++grp) {
        const unsigned char* up = EU + (size_t)myidx[grp] * 1024 + kb2 * 128 + g * 32;
        raw0[grp] = *(const uint4*)up;
        raw1[grp] = *(const uint4*)(up + 16);
      }
#pragma unroll
      for (int grp = 0; grp < 8; ++grp) {
        acc[grp] = MFMA16(fp8x8_to_bf16(raw0[grp].x, raw0[grp].y), xf[0], acc[grp]);
        acc[grp] = MFMA16(fp8x8_to_bf16(raw0[grp].z, raw0[grp].w), xf[1], acc[grp]);
        acc[grp] = MFMA16(fp8x8_to_bf16(raw1[grp].x, raw1[grp].y), xf[2], acc[grp]);
        acc[grp] = MFMA16(fp8x8_to_bf16(raw1[grp].z, raw1[grp].w), xf[3], acc[grp]);
      }
    }
    if (g == 0) {
#pragma unroll
      for (int grp = 0; grp < 8; ++grp) idxs[grp * 16 + m] = myidx[grp];
    }
    if (m == 0) {
#pragma unroll
      for (int grp = 0; grp < 8; ++grp)
#pragma unroll
        for (int j = 0; j < 4; ++j) {
          const int e = grp * 16 + 4 * g + j;
          const float a = acc[grp][j] * rstd;
          const float ge = 0.5f * a * (1.f + erff(a * 0.7071067811865475f));
          coef[e] = SELG[t * 128 + e] * ge * (1.f / EV_SCALE);
        }
    }
    __syncthreads();
    f32x2 y[8];
#pragma unroll
    for (int i = 0; i < 8; ++i) y[i] = {0.f, 0.f};
#pragma unroll 8
    for (int e = 0; e < 128; ++e) {
      const float c = coef[e];
      const f32x2 c2 = {c, c};
      const uint4 r = *(const uint4*)(EV + (size_t)idxs[e] * 1024 + lane * 16);
      y[0] += c2 * __builtin_amdgcn_cvt_pk_f32_fp8((int)r.x, false);
      y[1] += c2 * __builtin_amdgcn_cvt_pk_f32_fp8((int)r.x, true);
      y[2] += c2 * __builtin_amdgcn_cvt_pk_f32_fp8((int)r.y, false);
      y[3] += c2 * __builtin_amdgcn_cvt_pk_f32_fp8((int)r.y, true);
      y[4] += c2 * __builtin_amdgcn_cvt_pk_f32_fp8((int)r.z, false);
      y[5] += c2 * __builtin_amdgcn_cvt_pk_f32_fp8((int)r.z, true);
      y[6] += c2 * __builtin_amdgcn_cvt_pk_f32_fp8((int)r.w, false);
      y[7] += c2 * __builtin_amdgcn_cvt_pk_f32_fp8((int)r.w, true);
    }
    const float* hp = p.out + t * 1024 + lane * 16;
    float* dp = dst + t * 1024 + lane * 16;
    float hv[16];
#pragma unroll
    for (int q = 0; q < 4; ++q) { const float4 h4 = *(const float4*)(hp + 4 * q); hv[4 * q] = h4.x; hv[4 * q + 1] = h4.y; hv[4 * q + 2] = h4.z; hv[4 * q + 3] = h4.w; }
    float ss = 0.f;
#pragma unroll
    for (int i = 0; i < 8; ++i) { hv[2 * i] += y[i][0]; hv[2 * i + 1] += y[i][1]; }
#pragma unroll
    for (int i = 0; i < 16; ++i) ss += hv[i] * hv[i];
    ss = wave_sum(ss);
    const float rn = rsqrtf(ss * (1.f / 1024.f) + EPS);
#pragma unroll
    for (int q = 0; q < 4; ++q) {
      const float4 n4 = *(const float4*)(p.norm_final + lane * 16 + 4 * q);
      *(float4*)(dp + 4 * q) = make_float4(hv[4 * q] * rn * n4.x, hv[4 * q + 1] * rn * n4.y, hv[4 * q + 2] * rn * n4.z, hv[4 * q + 3] * rn * n4.w);
    }
    __syncthreads();
  }
}

#define XB_TMO      128
#define XB_XCNT(j)  (256  + 64 * (j))
#define XB_XSUB(j)  (1280 + 64 * (j))
#define XB_XGEN(j)  (2304 + 64 * (j))
#define XB_TOP      3328
#define XB_TOPGEN   3392
#define XCD_BAR_WORDS 3456
#define XB_SPIN_CAP (1u << 22)
#define LAS __attribute__((address_space(3)))
DI unsigned xb_ld(unsigned* p)              { return __hip_atomic_load(p, __ATOMIC_RELAXED, __HIP_MEMORY_SCOPE_AGENT); }
DI unsigned xb_add(unsigned* p, unsigned v) { return __hip_atomic_fetch_add(p, v, __ATOMIC_RELAXED, __HIP_MEMORY_SCOPE_AGENT); }
DI unsigned xb_xcc_id() { return (unsigned)__builtin_amdgcn_s_getreg((3 << 11) | 20) & 0xFu; }
#define XB_SPIN(cond, bar) do { unsigned _sp = 0; while (cond) { __builtin_amdgcn_s_sleep(1); \
    if ((++_sp & 255u) == 0u) { if (xb_ld(&(bar)[XB_TMO])) break; if (_sp > XB_SPIN_CAP) { atomicAdd(&(bar)[XB_TMO], 1u); break; } } } } while (0)
struct XcdBarrier { unsigned* bar; unsigned x; volatile LAS unsigned* st; };
DI XcdBarrier xcd_barrier_post(unsigned* bar, volatile LAS unsigned* st) {
  XcdBarrier b; b.bar = bar; b.x = xb_xcc_id(); b.st = st;
  if (__builtin_amdgcn_workitem_id_x() == 0) (void)xb_add(&bar[XB_XCNT(b.x)], 1u);
  return b;
}
DI void xcd_barrier_complete(unsigned* bar, unsigned x, unsigned& nloc, unsigned& nx) {
  const unsigned G = gridDim.x * gridDim.y * gridDim.z;
  unsigned sum, cnt, mine, sp = 0u;
  for (;;) {
    sum = 0u; cnt = 0u; mine = 0u;
#pragma unroll
    for (unsigned j = 0; j < 16; ++j) { const unsigned c = xb_ld(&bar[XB_XCNT(j)]); sum += c; cnt += (c > 0u) ? 1u : 0u; mine = (j == x) ? c : mine; }
    if (sum == G) break;
    __builtin_amdgcn_s_sleep(1);
    if ((++sp & 255u) == 0u) { if (xb_ld(&bar[XB_TMO])) break; if (sp > XB_SPIN_CAP) { atomicAdd(&bar[XB_TMO], 1u); break; } }
  }
  nloc = mine > 0u ? mine : 1u; nx = cnt > 0u ? cnt : 1u;
}
DI void xcd_barrier(const XcdBarrier& b) {
  asm volatile("s_waitcnt vmcnt(0)" ::: "memory");
  __syncthreads();
  if (__builtin_amdgcn_workitem_id_x() == 0) {
    unsigned* bar = b.bar;
    __builtin_amdgcn_s_waitcnt(0);
    unsigned nloc = b.st[0], nx = b.st[1];
    if (nloc == 0u) { xcd_barrier_complete(bar, b.x, nloc, nx); b.st[0] = nloc; b.st[1] = nx; }
    const unsigned old = xb_add(&bar[XB_XSUB(b.x)], 1u);
    const unsigned gen = old / nloc;
    if (old + 1u == (gen + 1u) * nloc) {
      __builtin_amdgcn_fence(__ATOMIC_RELEASE, "agent");
      asm volatile("s_waitcnt vmcnt(0)" ::: "memory");
      const unsigned og = xb_add(&bar[XB_TOP], 1u);
      const unsigned tg = og / nx;
      if (og + 1u == (tg + 1u) * nx) xb_add(&bar[XB_TOPGEN], 1u);
      else XB_SPIN(xb_ld(&bar[XB_TOPGEN]) == tg, bar);
      __builtin_amdgcn_fence(__ATOMIC_ACQUIRE, "agent");
      xb_add(&bar[XB_XGEN(b.x)], 1u);
      asm volatile("s_waitcnt vmcnt(0)" ::: "memory");
    } else {
      XB_SPIN(xb_ld(&bar[XB_XGEN(b.x)]) == gen, bar);
      __builtin_amdgcn_fence(__ATOMIC_ACQUIRE, "agent");
      asm volatile("s_waitcnt vmcnt(0)" ::: "memory");
    }
  }
  __syncthreads();
}

__global__ void __launch_bounds__(256, 2) fwd_kernel(Params p_in, int ph_lo, int ph_hi) {
  extern __shared__ __attribute__((aligned(16))) char smem[];
  char* ws0 = p_in.ws;
#ifndef DOUBLE_MASK
#define DOUBLE_MASK 0
#endif
  const bool multi = (ph_hi - ph_lo) > 1;
  XcdBarrier xb;
  if (multi) {
    volatile LAS unsigned* st = (volatile LAS unsigned*)(smem + SMEM_BYTES - 16);
    if (__builtin_amdgcn_workitem_id_x() == 0) { st[0] = 0u; st[1] = 0u; }
    __syncthreads();
    xb = xcd_barrier_post((unsigned*)(ws0 + OFF_BAR), st);
  }
  if (ph_lo < -1000) cg::this_grid().sync();
#if defined(__HIP_DEVICE_COMPILE__)
#define LOAD_PARAMS(dst_) { const __attribute__((address_space(4))) char* kp_ = (const __attribute__((address_space(4))) char*)__builtin_amdgcn_kernarg_segment_ptr(); \
                            asm volatile("" : "+s"(kp_)); __builtin_memcpy(&(dst_), kp_, sizeof(Params)); }
#else
#define LOAD_PARAMS(dst_) { dst_ = p_in; }
#endif
#define RUN_PHASE(k, call) if (ph_lo <= (k) && (k) < ph_hi) { \
    _Pragma("unroll 1") for (int rep = ((DOUBLE_MASK >> (k)) & 1); rep >= 0; --rep) { \
      Params pl; LOAD_PARAMS(pl); const Params& p = pl; char* ws = p.ws; (void)ws; \
      call; if (rep > 0 || (k) + 1 < ph_hi) xcd_barrier(xb); } }
  RUN_PHASE(0, phase_prep(p, smem))
  RUN_PHASE(1, phase_proj(p, smem))
  RUN_PHASE(2, phase_chunks(p, smem))
  RUN_PHASE(3, phase_scan(p, smem))
  RUN_PHASE(4, phase_gate(p))
  RUN_PHASE(5, phase_resid((const u16*)(ws + OFF_YMIX), (const u16*)(ws + OFF_WOUT), p.x, p.out, (u16*)(ws + OFF_XB), (float*)(ws + OFF_SSQ1), smem))
  RUN_PHASE(6, phase_scaled((const u16*)(ws + OFF_XB), (const u16*)(ws + OFF_WXQ), (const float*)(ws + OFF_SSQ1), (u16*)(ws + OFF_QX), smem))
  RUN_PHASE(7, phase_attn(p, smem))
  RUN_PHASE(8, phase_resid((const u16*)(ws + OFF_OX), (const u16*)(ws + OFF_WXO), p.out, p.out, (u16*)(ws + OFF_XB), (float*)(ws + OFF_SSQ2), smem))
  RUN_PHASE(9, phase_scaled((const u16*)(ws + OFF_XB), (const u16*)(ws + OFF_WPQ), (const float*)(ws + OFF_SSQ2), (u16*)(ws + OFF_PQ), smem))
  RUN_PHASE(10, phase_topk(p))
  if (ph_lo <= 11 && 11 < ph_hi) {
    Params pl; LOAD_PARAMS(pl); const Params& p = pl;
#if (DOUBLE_MASK >> 11) & 1
    phase_peer(p, smem, (float*)(p.ws + OFF_PROJ)); xcd_barrier(xb);
#endif
    phase_peer(p, smem, p.out);
  }
}

extern "C" void kernel_launch(void* const* d_in, const int* in_sizes, int n_in, void* d_out, int out_size, void* d_ws, size_t ws_size,
                              hipStream_t stream) {
  static int grid = 0;
  if (grid == 0) {
    if (n_in != 21 || out_size != T_TOK * DM || ws_size < WS_END) {
      fprintf(stderr, "kernel_launch: unexpected shapes (n_in %d out %d ws %zu need %zu)\n", n_in, out_size, ws_size, (size_t)WS_END);
      grid = -1;
      return;
    }
    int dev = 0, cus = 0, per_cu = 0;
    hipGetDevice(&dev);
    hipDeviceGetAttribute(&cus, hipDeviceAttributeMultiprocessorCount, dev);
    hipFuncSetAttribute((const void*)fwd_kernel, hipFuncAttributeMaxDynamicSharedMemorySize, SMEM_BYTES);
    hipOccupancyMaxActiveBlocksPerMultiprocessor(&per_cu, (const void*)fwd_kernel, 256, SMEM_BYTES);
    if (per_cu < 1) per_cu = 1;
    if (per_cu > 2) per_cu = 2;
    grid = cus * per_cu;
    if (grid < 128) { fprintf(stderr, "kernel_launch: grid %d too small\n", grid); grid = -1; return; }
  }
  if (grid < 0) return;
  Params p{};
  const float** pp = (const float**)&p;
  for (int i = 0; i < 21; ++i) pp[i] = (const float*)d_in[i];
  p.out = (float*)d_out;
  p.ws = (char*)d_ws;
#if ONE_LAUNCH
  hipMemsetAsync((char*)d_ws + OFF_BAR, 0, BAR_BYTES, stream);
  int lo = 0, hi = NPH;
  void* args[] = {&p, &lo, &hi};
  hipError_t e = hipLaunchCooperativeKernel((const void*)fwd_kernel, dim3(grid), dim3(256), args, SMEM_BYTES, stream);
  if (e != hipSuccess) fprintf(stderr, "cooperative launch failed: %s (grid %d)\n", hipGetErrorString(e), grid);
#else
  for (int ph = 0; ph < NPH; ++ph) hipLaunchKernelGGL(fwd_kernel, dim3(grid), dim3(256), SMEM_BYTES, stream, p, ph, ph + 1);
#endif
}
```

```cpp
#include <hip/hip_runtime.h>
#include <hip/hip_cooperative_groups.h>
#include <stdint.h>
#include <stdio.h>
namespace cg = cooperative_groups;

typedef unsigned short u16;
using bf16x8 = __attribute__((ext_vector_type(8))) short;
using f32x4  = __attribute__((ext_vector_type(4))) float;
using f32x16 = __attribute__((ext_vector_type(16))) float;
using f32x2  = __attribute__((ext_vector_type(2))) float;
using bf16x2v = __attribute__((ext_vector_type(2))) __bf16;

#define DI __device__ __forceinline__
#define MFMA32(a, b, c) __builtin_amdgcn_mfma_f32_32x32x16_bf16((a), (b), (c), 0, 0, 0)
#define MFMA16(a, b, c) __builtin_amdgcn_mfma_f32_16x16x32_bf16((a), (b), (c), 0, 0, 0)

#ifndef ONE_LAUNCH
#define ONE_LAUNCH 1
#endif

constexpr int T_TOK = 32768;
constexpr int SEQ = 8192;
constexpr int DM = 1024;
constexpr int INC = 3592;
constexpr int NPH = 12;
constexpr float EPS = 1e-6f;
constexpr float EU_SCALE = 64.f, EV_SCALE = 8.f;

constexpr size_t MiB = 1024ull * 1024ull;
constexpr size_t OFF_WIN  = 0;
constexpr size_t OFF_WOUT = OFF_WIN + 3712ull * 1024 * 2;
constexpr size_t OFF_WXQ  = OFF_WOUT + 2 * MiB;
constexpr size_t OFF_WXKV = OFF_WXQ + 2 * MiB;
constexpr size_t OFF_WXO  = OFF_WXKV + 4 * MiB;
constexpr size_t OFF_WPQ  = OFF_WXO + 2 * MiB;
constexpr size_t OFF_KEYS = OFF_WPQ + 2 * MiB;
constexpr size_t OFF_EU   = OFF_KEYS + 262144;
constexpr size_t OFF_EV   = OFF_EU + 32 * MiB;
constexpr size_t OFF_XB   = OFF_EV + 32 * MiB;
constexpr size_t OFF_MEMB = OFF_XB + 64 * MiB;
constexpr size_t OFF_KX   = OFF_MEMB + 2 * MiB;
constexpr size_t OFF_VT   = OFF_KX + 2 * MiB;
constexpr size_t OFF_RSTD0 = OFF_VT + 2 * MiB;
constexpr size_t OFF_RSTDM = OFF_RSTD0 + 131072;
constexpr size_t OFF_SSQ1 = OFF_RSTDM + 4096;
constexpr size_t OFF_SSQ2 = OFF_SSQ1 + 1 * MiB;
constexpr size_t OFF_BA   = OFF_SSQ2 + 1 * MiB;
constexpr size_t OFF_GL   = OFF_BA + 1 * MiB;
constexpr size_t OFF_YMIX = OFF_GL + 8192;
constexpr size_t OFF_PROJ = OFF_YMIX + 64 * MiB;
constexpr size_t PROJ_BYTES = (size_t)T_TOK * INC * 2;
constexpr size_t OFF_BAR  = OFF_PROJ + PROJ_BYTES;
constexpr size_t BAR_BYTES = 16384;
constexpr size_t OFF_TS   = OFF_BAR + BAR_BYTES;
constexpr size_t WS_END   = OFF_TS + 4096;
constexpr size_t OFF_QX   = OFF_PROJ;
constexpr size_t OFF_OX   = OFF_PROJ + 64 * MiB;
constexpr size_t OFF_PQ   = OFF_PROJ + 128 * MiB;
constexpr size_t OFF_SELI = OFF_PROJ + 192 * MiB;
constexpr size_t OFF_SELG = OFF_PROJ + 208 * MiB;

constexpr int SMEM_BYTES = 75776;

struct Params {
  const float *x, *mem, *norm_mix, *w_in, *conv_w, *dn_conv_w, *dn_a_log, *dn_dt_bias, *dn_norm, *w_out,
      *norm_x, *norm_mem, *w_xq, *w_xkv, *w_xo, *norm_ffn, *w_pq, *peer_keys, *expert_u, *expert_v, *norm_final;
  float* out;
  char* ws;
};

DI int tidx() { int t = (int)__builtin_amdgcn_workitem_id_x(); asm volatile("" : "+v"(t)); return t; }
DI u16 f2bf(float x) { return __builtin_bit_cast(u16, (__bf16)x); }
DI float bf2f(u16 v) { return __uint_as_float(((uint32_t)v) << 16); }
DI uint32_t pack2(float a, float b) { const bf16x2v v = {(__bf16)a, (__bf16)b}; return __builtin_bit_cast(uint32_t, v); }
DI float bflo(uint32_t u) { return __uint_as_float(u << 16); }
DI float bfhi(uint32_t u) { return __uint_as_float(u & 0xffff0000u); }
DI int crow32(int i, int h) { return (i & 3) + 8 * (i >> 2) + 4 * h; }
DI float silu_f(float v) { return v / (1.f + __expf(-v)); }
DI float wave_sum(float v) {
#pragma unroll
  for (int o = 32; o >= 1; o >>= 1) v += __shfl_xor(v, o);
  return v;
}
DI void unpack8(const uint4& r, float* f) {
  f[0] = bflo(r.x); f[1] = bfhi(r.x); f[2] = bflo(r.y); f[3] = bfhi(r.y);
  f[4] = bflo(r.z); f[5] = bfhi(r.z); f[6] = bflo(r.w); f[7] = bfhi(r.w);
}
DI uint4 pack8(const float* f) { return make_uint4(pack2(f[0], f[1]), pack2(f[2], f[3]), pack2(f[4], f[5]), pack2(f[6], f[7])); }

DI void rowconv(const float* __restrict__ src, u16* __restrict__ dst, const float* __restrict__ gain, float* __restrict__ rstd, int rows) {
  const int lane = tidx() & 63;
  const int gw = blockIdx.x * 4 + (tidx() >> 6), nw = gridDim.x * 4;
  for (int r = gw; r < rows; r += nw) {
    const float4* s = (const float4*)(src + (size_t)r * 1024);
    float4 a0 = s[lane * 2], a1 = s[lane * 2 + 1], b0 = s[128 + lane * 2], b1 = s[128 + lane * 2 + 1];
    float f[16] = {a0.x, a0.y, a0.z, a0.w, a1.x, a1.y, a1.z, a1.w, b0.x, b0.y, b0.z, b0.w, b1.x, b1.y, b1.z, b1.w};
    if (rstd) {
      float ss = 0.f;
#pragma unroll
      for (int i = 0; i < 16; ++i) ss += f[i] * f[i];
      ss = wave_sum(ss);
      if (lane == 0) rstd[r] = rsqrtf(ss * (1.f / 1024.f) + EPS);
    }
    if (gain) {
      const float4* gp = (const float4*)gain;
      float4 g0 = gp[lane * 2], g1 = gp[lane * 2 + 1], g2 = gp[128 + lane * 2], g3 = gp[128 + lane * 2 + 1];
      float gg[16] = {g0.x, g0.y, g0.z, g0.w, g1.x, g1.y, g1.z, g1.w, g2.x, g2.y, g2.z, g2.w, g3.x, g3.y, g3.z, g3.w};
#pragma unroll
      for (int i = 0; i < 16; ++i) f[i] *= gg[i];
    }
    *(uint4*)(dst + (size_t)r * 1024 + lane * 8) = pack8(f);
    *(uint4*)(dst + (size_t)r * 1024 + 512 + lane * 8) = pack8(f + 8);
  }
}


DI void rowconv8(const float* __restrict__ src, unsigned char* __restrict__ dst, const float* __restrict__ gain, float scale, int rows, int bid, int nb) {
  const int lane = tidx() & 63;
  const int gw = bid * 4 + (tidx() >> 6), nw = nb * 4;
  float gg[16];
#pragma unroll
  for (int i = 0; i < 16; ++i) gg[i] = scale;
  if (gain) {
    const float4* gp = (const float4*)(gain + lane * 16);
#pragma unroll
    for (int q = 0; q < 4; ++q) { const float4 g4 = gp[q]; gg[4 * q] *= g4.x; gg[4 * q + 1] *= g4.y; gg[4 * q + 2] *= g4.z; gg[4 * q + 3] *= g4.w; }
  }
  for (int r = gw; r < rows; r += nw) {
    const float4* s = (const float4*)(src + (size_t)r * 1024 + lane * 16);
    uint32_t o[4];
#pragma unroll
    for (int q = 0; q < 4; ++q) {
      const float4 v = s[q];
      int pk = __builtin_amdgcn_cvt_pk_fp8_f32(v.x * gg[4 * q], v.y * gg[4 * q + 1], 0, false);
      pk = __builtin_amdgcn_cvt_pk_fp8_f32(v.z * gg[4 * q + 2], v.w * gg[4 * q + 3], pk, true);
      o[q] = (uint32_t)pk;
    }
    *(uint4*)(dst + (size_t)r * 1024 + lane * 16) = make_uint4(o[0], o[1], o[2], o[3]);
  }
}

DI void transpose_tile(const float* __restrict__ W, int N, const float* __restrict__ gain, u16* __restrict__ Wt, int nt, int kt, float* tile) {
  const int t = tidx();
  const int k0 = kt * 64, n0 = nt * 64;
#pragma unroll
  for (int i = 0; i < 16; ++i) {
    int kk = i * 4 + (t >> 6), nn = t & 63;
    float v = 0.f;
    if (n0 + nn < N) v = W[(size_t)(k0 + kk) * N + n0 + nn] * (gain ? gain[k0 + kk] : 1.f);
    tile[kk * 65 + nn] = v;
  }
  __syncthreads();
#pragma unroll
  for (int i = 0; i < 16; ++i) {
    int nn = i * 4 + (t >> 6), kk = t & 63;
    if (n0 + nn < N) Wt[(size_t)(n0 + nn) * 1024 + k0 + kk] = f2bf(tile[kk * 65 + nn]);
  }
  __syncthreads();
}

DI void weight_transposes(const Params& p, char* smem, unsigned mask, int bid, int nb) {
  char* ws = p.ws;
  const int cnt_all[6] = {57 * 16, 256, 256, 512, 256, 256};
  int cnt[6], total = 0;
  for (int i = 0; i < 6; ++i) { cnt[i] = ((mask >> i) & 1u) ? cnt_all[i] : 0; total += cnt[i]; }
  for (int job = bid; job < total; job += nb) {
    int j = job, w = 0;
    while (j >= cnt[w]) { j -= cnt[w]; ++w; }
    const float* W; const float* gain; u16* dst; int N;
    switch (w) {
      case 0: W = p.w_in; gain = p.norm_mix; dst = (u16*)(ws + OFF_WIN); N = INC; break;
      case 1: W = p.w_out; gain = nullptr; dst = (u16*)(ws + OFF_WOUT); N = 1024; break;
      case 2: W = p.w_xq; gain = p.norm_x; dst = (u16*)(ws + OFF_WXQ); N = 1024; break;
      case 3: W = p.w_xkv; gain = p.norm_mem; dst = (u16*)(ws + OFF_WXKV); N = 2048; break;
      case 4: W = p.w_xo; gain = nullptr; dst = (u16*)(ws + OFF_WXO); N = 1024; break;
      default: W = p.w_pq; gain = p.norm_ffn; dst = (u16*)(ws + OFF_WPQ); N = 1024; break;
    }
    transpose_tile(W, N, gain, dst, j >> 4, j & 15, (float*)smem);
  }
}
DI void keys_convert(const Params& p, int bid, int nb) {
  u16* kd = (u16*)(p.ws + OFF_KEYS);
  for (int i = bid * 256 + tidx(); i < 131072; i += nb * 256) kd[i] = f2bf(p.peer_keys[i]);
}

DI void phase_prep(const Params& p, char* smem) {
  char* ws = p.ws;
  const bool defer = gridDim.x >= 256;
  weight_transposes(p, smem, defer ? 0x09u : 0x3Fu, blockIdx.x, gridDim.x);
  rowconv(p.x, (u16*)(ws + OFF_XB), nullptr, (float*)(ws + OFF_RSTD0), T_TOK);
  rowconv(p.mem, (u16*)(ws + OFF_MEMB), nullptr, (float*)(ws + OFF_RSTDM), 1024);
  if (!defer) {
    rowconv8(p.expert_u, (unsigned char*)(ws + OFF_EU), p.norm_ffn, EU_SCALE, 16384, blockIdx.x, gridDim.x);
    rowconv8(p.expert_v, (unsigned char*)(ws + OFF_EV), nullptr, EV_SCALE, 16384, blockIdx.x, gridDim.x);
    keys_convert(p, blockIdx.x, gridDim.x);
  }
}

typedef unsigned u32x4 __attribute__((ext_vector_type(4)));
DI void gload16(u32x4& dst, const void* p) { asm volatile("global_load_dwordx4 %0, %1, off" : "=&v"(dst) : "v"(p) : "memory"); }
DI void gwait8_all(u32x4& a0, u32x4& a1, u32x4& a2, u32x4& a3, u32x4& b0, u32x4& b1, u32x4& b2, u32x4& b3) {
  asm volatile("s_waitcnt vmcnt(0)" : "+v"(a0), "+v"(a1), "+v"(a2), "+v"(a3), "+v"(b0), "+v"(b1), "+v"(b2), "+v"(b3) : : "memory");
}
DI void gwait8_keep8(u32x4& a0, u32x4& a1, u32x4& a2, u32x4& a3, u32x4& b0, u32x4& b1, u32x4& b2, u32x4& b3) {
  asm volatile("s_waitcnt vmcnt(8)" : "+v"(a0), "+v"(a1), "+v"(a2), "+v"(a3), "+v"(b0), "+v"(b1), "+v"(b2), "+v"(b3) : : "memory");
}

DI void gemm_main(const u16* __restrict__ A, const u16* __restrict__ Bt, int m0, int n0, char* smem, f32x16 (&acc)[2][2]) {
  const int tid = tidx(), lane = tid & 63, wave = tid >> 6;
  const int wm = wave >> 1, wn = wave & 1;
  u16* As = (u16*)smem;
  u16* Bs = (u16*)(smem + 36864);
  const int srow = tid >> 3, scol = (tid & 7) * 8;
  const u16* Ap = A + (size_t)(m0 + srow) * 1024 + scol;
  const u16* Bp = Bt + (size_t)(n0 + srow) * 1024 + scol;
  u32x4 r0a[4], r0b[4], r1a[4], r1b[4];
#pragma unroll
  for (int mi = 0; mi < 2; ++mi)
#pragma unroll
    for (int ni = 0; ni < 2; ++ni)
#pragma unroll
      for (int i = 0; i < 16; ++i) acc[mi][ni][i] = 0.f;
#define ISSUE(ra_, rb_, k_) { _Pragma("unroll") for (int i = 0; i < 4; ++i) { gload16(ra_[i], Ap + (size_t)i * 32 * 1024 + (k_) * 64); gload16(rb_[i], Bp + (size_t)i * 32 * 1024 + (k_) * 64); } }
#define STORE(ra_, rb_, buf_) { u16* as2 = As + (buf_) * 128 * 72; u16* bs2 = Bs + (buf_) * 128 * 72; \
    _Pragma("unroll") for (int i = 0; i < 4; ++i) { *(u32x4*)(as2 + (srow + 32 * i) * 72 + scol) = ra_[i]; *(u32x4*)(bs2 + (srow + 32 * i) * 72 + scol) = rb_[i]; } }
  auto compute = [&](int cur) {
    const u16* as = As + cur * 128 * 72;
    const u16* bs = Bs + cur * 128 * 72;
#pragma unroll
    for (int ks = 0; ks < 4; ++ks) {
      bf16x8 a[2], b[2];
#pragma unroll
      for (int mi = 0; mi < 2; ++mi) a[mi] = *(const bf16x8*)(as + (64 * wm + 32 * mi + (lane & 31)) * 72 + 16 * ks + 8 * (lane >> 5));
#pragma unroll
      for (int ni = 0; ni < 2; ++ni) b[ni] = *(const bf16x8*)(bs + (64 * wn + 32 * ni + (lane & 31)) * 72 + 16 * ks + 8 * (lane >> 5));
#pragma unroll
      for (int mi = 0; mi < 2; ++mi)
#pragma unroll
        for (int ni = 0; ni < 2; ++ni) acc[mi][ni] = MFMA32(b[ni], a[mi], acc[mi][ni]);
    }
  };
  ISSUE(r0a, r0b, 0)
  ISSUE(r1a, r1b, 1)
  gwait8_keep8(r0a[0], r0a[1], r0a[2], r0a[3], r0b[0], r0b[1], r0b[2], r0b[3]);
  STORE(r0a, r0b, 0)
  __syncthreads();
#pragma unroll 1
  for (int kk = 0; kk < 16; kk += 2) {
    const int k2 = (kk + 2 < 16) ? kk + 2 : 15, k3 = (kk + 3 < 16) ? kk + 3 : 15;
    ISSUE(r0a, r0b, k2)
    compute(0);
    gwait8_keep8(r1a[0], r1a[1], r1a[2], r1a[3], r1b[0], r1b[1], r1b[2], r1b[3]);
    STORE(r1a, r1b, 1)
    __syncthreads();
    ISSUE(r1a, r1b, k3)
    compute(1);
    gwait8_keep8(r0a[0], r0a[1], r0a[2], r0a[3], r0b[0], r0b[1], r0b[2], r0b[3]);
    STORE(r0a, r0b, 0)
    __syncthreads();
  }
  gwait8_all(r1a[0], r1a[1], r1a[2], r1a[3], r1b[0], r1b[1], r1b[2], r1b[3]);
#undef ISSUE
#undef STORE
}

DI bool tile_map(int it, int MT, int NT, int& mt, int& nt) {
  const int nb = gridDim.x >> 3;
  if ((gridDim.x & 7) != 0) {
    const int tile = blockIdx.x + it * gridDim.x;
    if (tile >= MT * NT) return false;
    mt = tile / NT; nt = tile % NT;
    return true;
  }
  const int vx = blockIdx.x & 7, lb = blockIdx.x >> 3;
  const int per = (MT >> 3) * NT;
  const int q = it * nb + lb;
  if (q >= per) return false;
  const int grp = q / (8 * NT), r = q % (8 * NT);
  mt = vx * (MT >> 3) + grp * 8 + (r & 7);
  nt = r >> 3;
  return true;
}

DI float* rs_ptr(char* smem) { return (float*)(smem + 73728); }
DI float* sq_ptr(char* smem) { return (float*)(smem + 73728 + 512); }

DI void kv_gemm(const Params& p, char* smem, int bid, int nb);
DI void phase_proj(const Params& p, char* smem) {
  char* ws = p.ws;
  const int tid = tidx(), lane = tid & 63, wave = tid >> 6, wm = wave >> 1, wn = wave & 1, hh = lane >> 5;
  float* rs = rs_ptr(smem);
  u16* proj = (u16*)(ws + OFF_PROJ);
  float* ba = (float*)(ws + OFF_BA);
  for (int it = 0;; ++it) {
    int mt, nt;
    if (!tile_map(it, 256, 29, mt, nt)) break;
    const int m0 = mt * 128, n0 = nt * 128;
    f32x16 acc[2][2];
    gemm_main((const u16*)(ws + OFF_XB), (const u16*)(ws + OFF_WIN), m0, n0, smem, acc);
    if (tid < 128) rs[tid] = ((const float*)(ws + OFF_RSTD0))[m0 + tid];
    __syncthreads();
#pragma unroll
    for (int mi = 0; mi < 2; ++mi) {
      const int rl = 64 * wm + 32 * mi + (lane & 31);
      const float sc = rs[rl];
      const size_t row = (size_t)(m0 + rl);
#pragma unroll
      for (int ni = 0; ni < 2; ++ni)
#pragma unroll
        for (int q = 0; q < 4; ++q) {
          const int col = n0 + 64 * wn + 32 * ni + 8 * q + 4 * hh;
          const float v0 = acc[mi][ni][4 * q] * sc, v1 = acc[mi][ni][4 * q + 1] * sc, v2 = acc[mi][ni][4 * q + 2] * sc, v3 = acc[mi][ni][4 * q + 3] * sc;
          if (col < 3584) *(uint2*)(proj + row * INC + col) = make_uint2(pack2(v0, v1), pack2(v2, v3));
          else if (col < INC) *(float4*)(ba + row * 8 + (col - 3584)) = make_float4(v0, v1, v2, v3);
        }
    }
    __syncthreads();
  }
  if (gridDim.x < 256) kv_gemm(p, smem, blockIdx.x, gridDim.x);
}

DI void kv_gemm(const Params& p, char* smem, int bid, int nb) {
  char* ws = p.ws;
  const int tid = tidx(), lane = tid & 63, wave = tid >> 6, wm = wave >> 1, wn = wave & 1, hh = lane >> 5;
  float* rs = rs_ptr(smem);
  u16* kx = (u16*)(ws + OFF_KX);
  u16* vt = (u16*)(ws + OFF_VT);
  for (int t2 = bid; t2 < 128; t2 += nb) {
    const int mt = t2 >> 4, nt = t2 & 15, m0 = mt * 128, n0 = nt * 128;
    f32x16 acc[2][2];
    gemm_main((const u16*)(ws + OFF_MEMB), (const u16*)(ws + OFF_WXKV), m0, n0, smem, acc);
    if (tid < 128) rs[tid] = ((const float*)(ws + OFF_RSTDM))[m0 + tid];
    __syncthreads();
#pragma unroll
    for (int mi = 0; mi < 2; ++mi) {
      const int rl = 64 * wm + 32 * mi + (lane & 31);
      const float sc = rs[rl];
      const int row = m0 + rl, b = row >> 8, mm = row & 255;
#pragma unroll
      for (int ni = 0; ni < 2; ++ni)
#pragma unroll
        for (int q = 0; q < 4; ++q) {
          const int col = n0 + 64 * wn + 32 * ni + 8 * q + 4 * hh;
          const float v0 = acc[mi][ni][4 * q] * sc, v1 = acc[mi][ni][4 * q + 1] * sc, v2 = acc[mi][ni][4 * q + 2] * sc, v3 = acc[mi][ni][4 * q + 3] * sc;
          if (col < 1024) {
            const int head = col >> 8, d = col & 255;
            *(uint2*)(kx + ((size_t)((b * 4 + head) * 256 + mm)) * 256 + d) = make_uint2(pack2(v0, v1), pack2(v2, v3));
          } else {
            const int c2 = col - 1024, head = c2 >> 8, d = c2 & 255;
            u16* vp = vt + ((size_t)((b * 4 + head) * 256 + d)) * 256 + mm;
            vp[0] = f2bf(v0); vp[256] = f2bf(v1); vp[512] = f2bf(v2); vp[768] = f2bf(v3);
          }
        }
    }
    __syncthreads();
  }
}

DI void phase_resid(const u16* A, const u16* Bt, const float* resid, float* hout, u16* hb, float* ssq, char* smem) {
  const int tid = tidx(), lane = tid & 63, wave = tid >> 6, wm = wave >> 1, wn = wave & 1, hh = lane >> 5;
  float* sq = sq_ptr(smem);
  for (int it = 0;; ++it) {
    int mt, nt;
    if (!tile_map(it, 256, 8, mt, nt)) break;
    const int m0 = mt * 128, n0 = nt * 128;
    f32x16 acc[2][2];
    gemm_main(A, Bt, m0, n0, smem, acc);
    if (tid < 128) sq[tid] = 0.f;
    __syncthreads();
#pragma unroll
    for (int mi = 0; mi < 2; ++mi) {
      const int rl = 64 * wm + 32 * mi + (lane & 31);
      const size_t row = (size_t)(m0 + rl);
      float s2 = 0.f;
#pragma unroll
      for (int ni = 0; ni < 2; ++ni)
#pragma unroll
        for (int q = 0; q < 4; ++q) {
          const int col = n0 + 64 * wn + 32 * ni + 8 * q + 4 * hh;
          const float4 r = *(const float4*)(resid + row * 1024 + col);
          const float h0 = r.x + acc[mi][ni][4 * q], h1 = r.y + acc[mi][ni][4 * q + 1], h2 = r.z + acc[mi][ni][4 * q + 2], h3 = r.w + acc[mi][ni][4 * q + 3];
          *(float4*)(hout + row * 1024 + col) = make_float4(h0, h1, h2, h3);
          *(uint2*)(hb + row * 1024 + col) = make_uint2(pack2(h0, h1), pack2(h2, h3));
          s2 += h0 * h0 + h1 * h1 + h2 * h2 + h3 * h3;
        }
      atomicAdd(&sq[rl], s2);
    }
    __syncthreads();
    if (tid < 128) ssq[(size_t)(m0 + tid) * 8 + nt] = sq[tid];
    __syncthreads();
  }
}

DI void phase_scaled(const u16* A, const u16* Bt, const float* ssq, u16* out, char* smem) {
  const int tid = tidx(), lane = tid & 63, wave = tid >> 6, wm = wave >> 1, wn = wave & 1, hh = lane >> 5;
  float* rs = rs_ptr(smem);
  for (int it = 0;; ++it) {
    int mt, nt;
    if (!tile_map(it, 256, 8, mt, nt)) break;
    const int m0 = mt * 128, n0 = nt * 128;
    f32x16 acc[2][2];
    gemm_main(A, Bt, m0, n0, smem, acc);
    if (tid < 128) {
      const float4* sp = (const float4*)(ssq + (size_t)(m0 + tid) * 8);
      float4 s0 = sp[0], s1 = sp[1];
      rs[tid] = rsqrtf((s0.x + s0.y + s0.z + s0.w + s1.x + s1.y + s1.z + s1.w) * (1.f / 1024.f) + EPS);
    }
    __syncthreads();
#pragma unroll
    for (int mi = 0; mi < 2; ++mi) {
      const int rl = 64 * wm + 32 * mi + (lane & 31);
      const float sc = rs[rl];
#pragma unroll
      for (int ni = 0; ni < 2; ++ni)
#pragma unroll
        for (int q = 0; q < 4; ++q) {
          const int col = n0 + 64 * wn + 32 * ni + 8 * q + 4 * hh;
          *(uint2*)(out + (size_t)(m0 + rl) * 1024 + col) =
              make_uint2(pack2(acc[mi][ni][4 * q] * sc, acc[mi][ni][4 * q + 1] * sc), pack2(acc[mi][ni][4 * q + 2] * sc, acc[mi][ni][4 * q + 3] * sc));
        }
    }
    __syncthreads();
  }
}

DI void chunk_job(const Params& p, int cj, char* smem) {
  char* ws = p.ws;
  const int tid = tidx(), lane = tid & 63, wave = tid >> 6;
  const int bh = cj >> 7, n = cj & 127, b = bh >> 2, h = bh & 3;
  const int t0 = b * SEQ + n * 64;
  u16* Kb  = (u16*)smem;
  u16* Qb  = (u16*)(smem + 17408);
  u16* Vt  = (u16*)(smem + 34816);
  u16* KGt = (u16*)(smem + 53248);
  float* gc = (float*)(smem + 71680);
  float* bt = gc + 64;
  float* As = (float*)(smem + 17408);
  u16* Tb = (u16*)smem;
  const u16* proj = (const u16*)(ws + OFF_PROJ);
  u16* QD = (u16*)p.out;
  u16* KD = (u16*)((char*)p.out + 32 * MiB);
  u16* UU = (u16*)((char*)p.out + 64 * MiB);
  u16* WW = (u16*)((char*)p.out + 96 * MiB);
  u16* IN = (u16*)(ws + OFF_XB);
  float* GL = (float*)(ws + OFF_GL);

  if (wave == 0) {
    const float* ba = (const float*)(ws + OFF_BA) + (size_t)(t0 + lane) * 8;
    const float bl = ba[h], al = ba[4 + h] + p.dn_dt_bias[h];
    const float sp = fmaxf(al, 0.f) + log1pf(expf(-fabsf(al)));
    float g = -expf(p.dn_a_log[h]) * sp;
#pragma unroll
    for (int o = 1; o < 64; o <<= 1) { float v = __shfl_up(g, o); if (lane >= o) g += v; }
    gc[lane] = g;
    bt[lane] = 1.f / (1.f + expf(-bl));
    if (lane == 63) GL[cj] = expf(g);
  }
  __syncthreads();

  {
    const int cgp = tid & 15, ts = tid >> 4;
    const float glast = gc[63];
    float eg[4], ed[4], be[4];
#pragma unroll
    for (int tt = 0; tt < 4; ++tt) { const float gv = gc[4 * ts + tt]; eg[tt] = expf(gv); ed[tt] = expf(glast - gv); be[tt] = bt[4 * ts + tt]; }
#pragma unroll 1
    for (int part = 0; part < 3; ++part) {
      const int cc = part * 512 + h * 128 + cgp * 8;
      const int cb = 1536 + cc;
      float xin[7][8];
#pragma unroll
      for (int r = 0; r < 7; ++r) {
        const int sp = n * 64 + 4 * ts - 3 + r;
        if (sp >= 0) { uint4 raw = *(const uint4*)(proj + (size_t)(t0 + 4 * ts - 3 + r) * INC + cb); unpack8(raw, xin[r]); }
        else {
#pragma unroll
          for (int c = 0; c < 8; ++c) xin[r][c] = 0.f;
        }
      }
      float o[4][8];
#pragma unroll
      for (int tt = 0; tt < 4; ++tt)
#pragma unroll
        for (int c = 0; c < 8; ++c) o[tt][c] = 0.f;
#pragma unroll
      for (int j = 0; j < 4; ++j) {
        const float4 w0 = *(const float4*)(p.dn_conv_w + j * 1536 + cc), w1 = *(const float4*)(p.dn_conv_w + j * 1536 + cc + 4);
        const float wj[8] = {w0.x, w0.y, w0.z, w0.w, w1.x, w1.y, w1.z, w1.w};
#pragma unroll
        for (int tt = 0; tt < 4; ++tt)
#pragma unroll
          for (int c = 0; c < 8; ++c) o[tt][c] += wj[c] * xin[tt + j][c];
      }
#pragma unroll
      for (int tt = 0; tt < 4; ++tt)
#pragma unroll
        for (int c = 0; c < 8; ++c) o[tt][c] = silu_f(o[tt][c]);
      if (part < 2) {
#pragma unroll
        for (int tt = 0; tt < 4; ++tt) {
          float ss = 0.f;
#pragma unroll
          for (int c = 0; c < 8; ++c) ss += o[tt][c] * o[tt][c];
          ss += __shfl_xor(ss, 1); ss += __shfl_xor(ss, 2); ss += __shfl_xor(ss, 4); ss += __shfl_xor(ss, 8);
          const float rn = rsqrtf(ss + EPS) * (part == 0 ? 0.08838834764831845f : 1.f);
#pragma unroll
          for (int c = 0; c < 8; ++c) o[tt][c] *= rn;
        }
      }
      if (part == 0) {
#pragma unroll
        for (int tt = 0; tt < 4; ++tt) {
          const int tok = 4 * ts + tt;
          *(uint4*)(Qb + tok * 136 + cgp * 8) = pack8(o[tt]);
          float qd[8];
#pragma unroll
          for (int c = 0; c < 8; ++c) qd[c] = o[tt][c] * eg[tt];
          *(uint4*)(QD + ((size_t)cj * 64 + tok) * 128 + cgp * 8) = pack8(qd);
        }
      } else if (part == 1) {
#pragma unroll
        for (int tt = 0; tt < 4; ++tt) *(uint4*)(Kb + (4 * ts + tt) * 136 + cgp * 8) = pack8(o[tt]);
#pragma unroll
        for (int c = 0; c < 8; ++c) {
          const int d = cgp * 8 + c;
          *(uint2*)(KGt + d * 72 + 4 * ts) = make_uint2(pack2(o[0][c] * be[0] * eg[0], o[1][c] * be[1] * eg[1]), pack2(o[2][c] * be[2] * eg[2], o[3][c] * be[3] * eg[3]));
          *(uint2*)(KD + ((size_t)cj * 128 + d) * 64 + 4 * ts) = make_uint2(pack2(o[0][c] * ed[0], o[1][c] * ed[1]), pack2(o[2][c] * ed[2], o[3][c] * ed[3]));
        }
      } else {
#pragma unroll
        for (int c = 0; c < 8; ++c) {
          const int d = cgp * 8 + c;
          *(uint2*)(Vt + d * 72 + 4 * ts) = make_uint2(pack2(o[0][c] * be[0], o[1][c] * be[1]), pack2(o[2][c] * be[2], o[3][c] * be[3]));
        }
      }
    }
  }
  __syncthreads();

  {
    const int wi = wave >> 1, wj = wave & 1, hh = lane >> 5;
    f32x16 aK, aQ;
#pragma unroll
    for (int i = 0; i < 16; ++i) { aK[i] = 0.f; aQ[i] = 0.f; }
    if (wi >= wj) {
#pragma unroll
      for (int ks = 0; ks < 8; ++ks) {
        const bf16x8 fk = *(const bf16x8*)(Kb + (32 * wi + (lane & 31)) * 136 + 16 * ks + 8 * hh);
        const bf16x8 fq = *(const bf16x8*)(Qb + (32 * wi + (lane & 31)) * 136 + 16 * ks + 8 * hh);
        const bf16x8 fb = *(const bf16x8*)(Kb + (32 * wj + (lane & 31)) * 136 + 16 * ks + 8 * hh);
        aK = MFMA32(fk, fb, aK);
        aQ = MFMA32(fq, fb, aQ);
      }
    }
    __syncthreads();
    const int j = 32 * wj + (lane & 31);
    const float gj = gc[j];
#pragma unroll
    for (int ii = 0; ii < 16; ++ii) {
      const int i = 32 * wi + crow32(ii, hh);
      const float dec = (i >= j) ? expf(gc[i] - gj) : 0.f;
      As[i * 68 + j] = (i > j) ? aK[ii] * bt[i] * dec : 0.f;
      IN[((size_t)cj * 64 + i) * 64 + j] = f2bf((i >= j) ? aQ[ii] * dec : 0.f);
    }
  }
  __syncthreads();

  if (wave == 0) {
    float xcol[64];
#pragma unroll
    for (int i = 0; i < 64; ++i) {
      int lv = lane;
      asm volatile("" : "+v"(lv));
      float s = (i == lv) ? 1.f : 0.f;
#pragma unroll
      for (int j4 = 0; j4 < (i + 3) / 4; ++j4) {
        const float4 a4 = *(const float4*)(As + i * 68 + 4 * j4);
        if (4 * j4 + 0 < i) s -= a4.x * xcol[4 * j4 + 0];
        if (4 * j4 + 1 < i) s -= a4.y * xcol[4 * j4 + 1];
        if (4 * j4 + 2 < i) s -= a4.z * xcol[4 * j4 + 2];
        if (4 * j4 + 3 < i) s -= a4.w * xcol[4 * j4 + 3];
      }
      xcol[i] = s;
      asm volatile("" ::: "memory");
    }
#pragma unroll
    for (int i = 0; i < 64; ++i) Tb[i * 72 + lane] = f2bf(xcol[i]);
  }
  __syncthreads();

  {
    const int hh = lane >> 5;
    f32x16 aU[2], aW[2];
#pragma unroll
    for (int mi = 0; mi < 2; ++mi)
#pragma unroll
      for (int i = 0; i < 16; ++i) { aU[mi][i] = 0.f; aW[mi][i] = 0.f; }
#pragma unroll
    for (int ks = 0; ks < 4; ++ks) {
      const bf16x8 bv = *(const bf16x8*)(Vt + (32 * wave + (lane & 31)) * 72 + 16 * ks + 8 * hh);
      const bf16x8 bk = *(const bf16x8*)(KGt + (32 * wave + (lane & 31)) * 72 + 16 * ks + 8 * hh);
#pragma unroll
      for (int mi = 0; mi < 2; ++mi) {
        const bf16x8 a = *(const bf16x8*)(Tb + (32 * mi + (lane & 31)) * 72 + 16 * ks + 8 * hh);
        aU[mi] = MFMA32(a, bv, aU[mi]);
        aW[mi] = MFMA32(a, bk, aW[mi]);
      }
    }
    const int d = 32 * wave + (lane & 31);
#pragma unroll
    for (int mi = 0; mi < 2; ++mi)
#pragma unroll
      for (int ii = 0; ii < 16; ++ii) {
        const int i = 32 * mi + crow32(ii, hh);
        UU[((size_t)cj * 64 + i) * 128 + d] = f2bf(aU[mi][ii]);
        WW[((size_t)cj * 64 + i) * 128 + d] = f2bf(aW[mi][ii]);
      }
  }
  __syncthreads();
}

DI void conv_items(const Params& p, int bid, int nb) {
  char* ws = p.ws;
  const u16* proj = (const u16*)(ws + OFF_PROJ);
  u16* ymix = (u16*)(ws + OFF_YMIX);
  for (int item = bid * 256 + tidx(); item < T_TOK * 64; item += nb * 256) {
    const int t = item >> 6, c0 = (item & 63) * 8;
    const int s = t & (SEQ - 1);
    float accv[8];
#pragma unroll
    for (int c = 0; c < 8; ++c) accv[c] = 0.f;
#pragma unroll
    for (int k = 0; k < 3; ++k) {
      if (s - 2 + k >= 0) {
        const size_t row = (size_t)(t - 2 + k) * INC;
        float cg8[8], hc8[8];
        unpack8(*(const uint4*)(proj + row + 512 + c0), cg8);
        unpack8(*(const uint4*)(proj + row + 1024 + c0), hc8);
        const float4 w0 = *(const float4*)(p.conv_w + k * 512 + c0), w1 = *(const float4*)(p.conv_w + k * 512 + c0 + 4);
        const float wk[8] = {w0.x, w0.y, w0.z, w0.w, w1.x, w1.y, w1.z, w1.w};
#pragma unroll
        for (int c = 0; c < 8; ++c) accv[c] += wk[c] * cg8[c] * hc8[c];
      }
    }
    float bg[8];
    unpack8(*(const uint4*)(proj + (size_t)t * INC + c0), bg);
#pragma unroll
    for (int c = 0; c < 8; ++c) accv[c] *= bg[c];
    *(uint4*)(ymix + (size_t)t * 1024 + c0) = pack8(accv);
  }
}

DI void phase_chunks(const Params& p, char* smem) {
  char* ws = p.ws;
  for (int cj = blockIdx.x; cj < 2048; cj += gridDim.x) chunk_job(p, cj, smem);
  if (gridDim.x < 256) conv_items(p, blockIdx.x, gridDim.x);
}

struct ScanFrag {
  bf16x8 wf[4], qf[4], inf[2], kf[2][2];
  float uf[4];
  float gl;
};

DI void phase_scan(const Params& p, char* smem) {
  char* ws = p.ws;
  if (blockIdx.x >= 128) {
    if (gridDim.x >= 256) {
      const int bid = blockIdx.x - 128, nb = gridDim.x - 128;
      conv_items(p, bid, nb);
      kv_gemm(p, smem, bid, nb);
      weight_transposes(p, smem, 0x36u, bid, nb);
      keys_convert(p, bid, nb);
      rowconv8(p.expert_u, (unsigned char*)(ws + OFF_EU), p.norm_ffn, EU_SCALE, 16384, bid, nb);
      rowconv8(p.expert_v, (unsigned char*)(ws + OFF_EV), nullptr, EV_SCALE, 16384, bid, nb);
    }
    return;
  }
  const int tid = tidx(), lane = tid & 63, w = tid >> 6, m = lane & 15, g = lane >> 4;
  const int bid = blockIdx.x;
  const int bh = (bid & 7) + 8 * ((bid >> 3) & 1), sl = bid >> 4;
  const int b = bh >> 2, h = bh & 3, e0 = sl * 16;
  u16* ST = (u16*)smem;
  u16* VT = (u16*)(smem + 4352);
  const u16* QD = (const u16*)p.out;
  const u16* KD = (const u16*)((const char*)p.out + 32 * MiB);
  const u16* UU = (const u16*)((const char*)p.out + 64 * MiB);
  const u16* WW = (const u16*)((const char*)p.out + 96 * MiB);
  const u16* IN = (const u16*)(ws + OFF_XB);
  const float* GL = (const float*)(ws + OFF_GL);
  u16* ymix = (u16*)(ws + OFF_YMIX);

  for (int i = tid; i < 16 * 136 / 2; i += 256) ((uint32_t*)ST)[i] = 0u;
  f32x4 Sacc[2];
#pragma unroll
  for (int mt = 0; mt < 2; ++mt)
#pragma unroll
    for (int j = 0; j < 4; ++j) Sacc[mt][j] = 0.f;

  auto load = [&](int c, ScanFrag& f) {
    const u16* wp = WW + ((size_t)c * 64 + 16 * w + m) * 128 + 8 * g;
    const u16* qp = QD + ((size_t)c * 64 + 16 * w + m) * 128 + 8 * g;
#pragma unroll
    for (int ks = 0; ks < 4; ++ks) { f.wf[ks] = *(const bf16x8*)(wp + 32 * ks); f.qf[ks] = *(const bf16x8*)(qp + 32 * ks); }
    const u16* ip = IN + ((size_t)c * 64 + 16 * w + m) * 64 + 8 * g;
#pragma unroll
    for (int ks = 0; ks < 2; ++ks) f.inf[ks] = *(const bf16x8*)(ip + 32 * ks);
#pragma unroll
    for (int mt = 0; mt < 2; ++mt)
#pragma unroll
      for (int ks = 0; ks < 2; ++ks) f.kf[mt][ks] = *(const bf16x8*)(KD + ((size_t)c * 128 + 32 * w + 16 * mt + m) * 64 + 32 * ks + 8 * g);
#pragma unroll
    for (int j = 0; j < 4; ++j) f.uf[j] = bf2f(UU[((size_t)c * 64 + 16 * w + 4 * g + j) * 128 + e0 + m]);
    f.gl = GL[c];
  };

  const int c0 = bh * 128;
  const int t0 = b * SEQ;
  ScanFrag cur, nxt;
  load(c0, cur);
  nxt = cur;
  __syncthreads();
  for (int n = 0; n < 128; ++n) {
    if (n + 1 < 128) load(c0 + n + 1, nxt);
    f32x4 av = {0.f, 0.f, 0.f, 0.f}, aq = {0.f, 0.f, 0.f, 0.f};
#pragma unroll
    for (int ks = 0; ks < 4; ++ks) {
      const bf16x8 sf = *(const bf16x8*)(ST + m * 136 + 32 * ks + 8 * g);
      av = MFMA16(cur.wf[ks], sf, av);
      aq = MFMA16(cur.qf[ks], sf, aq);
    }
    float vn[4];
#pragma unroll
    for (int j = 0; j < 4; ++j) vn[j] = cur.uf[j] - av[j];
    *(uint2*)(VT + m * 72 + 16 * w + 4 * g) = make_uint2(pack2(vn[0], vn[1]), pack2(vn[2], vn[3]));
    __syncthreads();
    bf16x8 vf[2];
#pragma unroll
    for (int ks = 0; ks < 2; ++ks) vf[ks] = *(const bf16x8*)(VT + m * 72 + 32 * ks + 8 * g);
#pragma unroll
    for (int ks = 0; ks < 2; ++ks) aq = MFMA16(cur.inf[ks], vf[ks], aq);
#pragma unroll
    for (int j = 0; j < 4; ++j)
      ymix[(size_t)(t0 + n * 64 + 16 * w + 4 * g + j) * 1024 + 512 + h * 128 + e0 + m] = f2bf(aq[j]);
#pragma unroll
    for (int mt = 0; mt < 2; ++mt) {
#pragma unroll
      for (int j = 0; j < 4; ++j) Sacc[mt][j] *= cur.gl;
#pragma unroll
      for (int ks = 0; ks < 2; ++ks) Sacc[mt] = MFMA16(cur.kf[mt][ks], vf[ks], Sacc[mt]);
      *(uint2*)(ST + m * 136 + 32 * w + 16 * mt + 4 * g) = make_uint2(pack2(Sacc[mt][0], Sacc[mt][1]), pack2(Sacc[mt][2], Sacc[mt][3]));
    }
    __syncthreads();
    cur = nxt;
  }
}

DI void phase_gate(const Params& p) {
  char* ws = p.ws;
  const u16* proj = (const u16*)(ws + OFF_PROJ);
  u16* ymix = (u16*)(ws + OFF_YMIX);
  for (int item = blockIdx.x * 256 + tidx(); item < T_TOK * 64; item += gridDim.x * 256) {
    const int t = item >> 6, hh = (item >> 4) & 3, part = item & 15;
    u16* op = ymix + (size_t)t * 1024 + 512 + hh * 128 + part * 8;
    float o[8], z[8];
    unpack8(*(const uint4*)op, o);
    unpack8(*(const uint4*)(proj + (size_t)t * INC + 3072 + hh * 128 + part * 8), z);
    float ss = 0.f;
#pragma unroll
    for (int c = 0; c < 8; ++c) ss += o[c] * o[c];
    ss += __shfl_xor(ss, 1); ss += __shfl_xor(ss, 2); ss += __shfl_xor(ss, 4); ss += __shfl_xor(ss, 8);
    const float rn = rsqrtf(ss * (1.f / 128.f) + EPS);
    const float4 g0 = *(const float4*)(p.dn_norm + part * 8), g1 = *(const float4*)(p.dn_norm + part * 8 + 4);
    const float gg[8] = {g0.x, g0.y, g0.z, g0.w, g1.x, g1.y, g1.z, g1.w};
#pragma unroll
    for (int c = 0; c < 8; ++c) o[c] = o[c] * rn * gg[c] * silu_f(z[c]);
    *(uint4*)op = pack8(o);
  }
}

DI void phase_attn(const Params& p, char* smem) {
  char* ws = p.ws;
  const int tid = tidx(), lane = tid & 63, wave = tid >> 6, m = lane & 15, g = lane >> 4;
  const u16* QX = (const u16*)(ws + OFF_QX);
  const u16* KX = (const u16*)(ws + OFF_KX);
  const u16* VTp = (const u16*)(ws + OFF_VT);
  u16* OX = (u16*)(ws + OFF_OX);
  u16* Kc = (u16*)smem;
  u16* Vc = (u16*)(smem + 34816);
  for (int job = blockIdx.x; job < 2048; job += gridDim.x) {
    const int head = job & 3, qt = (job >> 2) & 127, b = job >> 9;
    const size_t qrow = (size_t)b * SEQ + qt * 64 + wave * 16;
    bf16x8 qf[8];
#pragma unroll
    for (int ks = 0; ks < 8; ++ks) qf[ks] = *(const bf16x8*)(QX + (qrow + m) * 1024 + head * 256 + 32 * ks + 8 * g);
    const u16* kb = KX + (size_t)(b * 4 + head) * 65536;
    const u16* vb = VTp + (size_t)(b * 4 + head) * 65536;
    const u16* ksrc = kb + (size_t)(tid >> 5) * 256 + (tid & 31) * 8;
    const u16* vsrc = vb + (size_t)(tid >> 3) * 256 + (tid & 7) * 8;
    u16* kdst = Kc + (tid >> 5) * 264 + (tid & 31) * 8;
    u16* vdst = Vc + (tid >> 3) * 72 + (tid & 7) * 8;

    u32x4 st[8];
#define ATT_ISSUE_K(c_) { _Pragma("unroll") for (int i = 0; i < 8; ++i) gload16(st[i], ksrc + (size_t)((c_) * 64 + i * 8) * 256); }
#define ATT_ISSUE_V(c_) { _Pragma("unroll") for (int i = 0; i < 8; ++i) gload16(st[i], vsrc + (size_t)(i * 32) * 256 + (c_) * 64); }
#define ATT_LAND_K() { gwait8_all(st[0], st[1], st[2], st[3], st[4], st[5], st[6], st[7]); \
                       _Pragma("unroll") for (int i = 0; i < 8; ++i) *(u32x4*)(kdst + i * 8 * 264) = st[i]; }
#define ATT_LAND_V() { gwait8_all(st[0], st[1], st[2], st[3], st[4], st[5], st[6], st[7]); \
                       _Pragma("unroll") for (int i = 0; i < 8; ++i) *(u32x4*)(vdst + i * 32 * 72) = st[i]; }
    f32x4 s[16];
#pragma unroll
    for (int mt = 0; mt < 16; ++mt) s[mt] = {0.f, 0.f, 0.f, 0.f};
    ATT_ISSUE_K(0)
#pragma unroll
    for (int kc = 0; kc < 4; ++kc) {
      ATT_LAND_K()
      if (kc < 3) ATT_ISSUE_K(kc + 1) else ATT_ISSUE_V(0)
      __syncthreads();
      const u16* kbase = Kc + m * 264 + 8 * g;
      asm volatile("" : "+v"(kbase));
#pragma unroll
      for (int mt2 = 0; mt2 < 4; ++mt2)
#pragma unroll
        for (int ks = 0; ks < 8; ++ks) {
          const bf16x8 a = *(const bf16x8*)(kbase + 16 * mt2 * 264 + 32 * ks);
          s[kc * 4 + mt2] = MFMA16(a, qf[ks], s[kc * 4 + mt2]);
          if (ks == 7) asm volatile("" ::: "memory");
        }
      __syncthreads();
    }
    float mx = -1e30f;
#pragma unroll
    for (int mt = 0; mt < 16; ++mt)
#pragma unroll
      for (int j = 0; j < 4; ++j) { s[mt][j] *= 0.0625f; mx = fmaxf(mx, s[mt][j]); }
    mx = fmaxf(mx, __shfl_xor(mx, 16)); mx = fmaxf(mx, __shfl_xor(mx, 32));
    float sum = 0.f;
#pragma unroll
    for (int mt = 0; mt < 16; ++mt)
#pragma unroll
      for (int j = 0; j < 4; ++j) { s[mt][j] = __expf(s[mt][j] - mx); sum += s[mt][j]; }
    sum += __shfl_xor(sum, 16); sum += __shfl_xor(sum, 32);
    const float inv = 1.f / sum;
    bf16x8 pf[8];
#pragma unroll
    for (int k2 = 0; k2 < 8; ++k2) {
      uint4 u = make_uint4(pack2(s[2 * k2][0], s[2 * k2][1]), pack2(s[2 * k2][2], s[2 * k2][3]),
                           pack2(s[2 * k2 + 1][0], s[2 * k2 + 1][1]), pack2(s[2 * k2 + 1][2], s[2 * k2 + 1][3]));
      pf[k2] = __builtin_bit_cast(bf16x8, u);
    }
    float invr[4];
#pragma unroll
    for (int j = 0; j < 4; ++j) invr[j] = __shfl(inv, 4 * g + j);
    f32x4 o[16];
#pragma unroll
    for (int nt = 0; nt < 16; ++nt) o[nt] = {0.f, 0.f, 0.f, 0.f};
#pragma unroll
    for (int vc = 0; vc < 4; ++vc) {
      ATT_LAND_V()
      if (vc < 3) ATT_ISSUE_V(vc + 1)
      __syncthreads();
      const u16* vbase = Vc + m * 72 + 4 * g;
      asm volatile("" : "+v"(vbase));
#pragma unroll
      for (int nt = 0; nt < 16; ++nt) {
#pragma unroll
        for (int k2l = 0; k2l < 2; ++k2l) {
          const uint2 lo = *(const uint2*)(vbase + 16 * nt * 72 + 32 * k2l);
          const uint2 hi = *(const uint2*)(vbase + 16 * nt * 72 + 32 * k2l + 16);
          const uint4 u = make_uint4(lo.x, lo.y, hi.x, hi.y);
          o[nt] = MFMA16(pf[2 * vc + k2l], __builtin_bit_cast(bf16x8, u), o[nt]);
        }
        if ((nt & 3) == 3) asm volatile("" ::: "memory");
      }
      __syncthreads();
    }
#undef ATT_ISSUE_K
#undef ATT_ISSUE_V
#undef ATT_LAND_K
#undef ATT_LAND_V
#pragma unroll
    for (int j = 0; j < 4; ++j) {
      u16* ob = OX + (qrow + 4 * g + j) * 1024 + head * 256 + m;
      asm volatile("" : "+v"(ob));
#pragma unroll
      for (int nt = 0; nt < 16; ++nt) ob[16 * nt] = f2bf(o[nt][j] * invr[j]);
    }
  }
}

DI uint32_t ordf(float f) { uint32_t u = __float_as_uint(f); return u ^ ((uint32_t)((int32_t)u >> 31) | 0x80000000u); }
DI float unordf(uint32_t k) { return __uint_as_float(k ^ ((~(uint32_t)((int32_t)k >> 31)) | 0x80000000u)); }
DI void ins32(uint32_t (&top)[16], uint32_t x) {
#pragma unroll
  for (int i = 0; i < 16; ++i) { const uint32_t hi = max(top[i], x); x = min(top[i], x); top[i] = hi; }
}
DI void ins64(uint32_t (&tk)[16], uint32_t (&tv)[16], uint32_t xk, uint32_t xv) {
#pragma unroll
  for (int i = 0; i < 16; ++i) {
    const bool gt = xk > tk[i];
    const uint32_t nk = gt ? xk : tk[i], nv = gt ? xv : tv[i];
    xk = gt ? tk[i] : xk; xv = gt ? tv[i] : xv;
    tk[i] = nk; tv[i] = nv;
  }
}

DI void sort16_desc(uint32_t (&v)[16]) {
#pragma unroll
  for (int k = 2; k <= 16; k <<= 1)
#pragma unroll
    for (int j = k >> 1; j > 0; j >>= 1)
#pragma unroll
      for (int i = 0; i < 16; ++i) {
        const int l = i ^ j;
        if (l > i) {
          const uint32_t hi = max(v[i], v[l]), lo = min(v[i], v[l]);
          if ((i & k) == 0) { v[i] = hi; v[l] = lo; } else { v[i] = lo; v[l] = hi; }
        }
      }
}
DI void merge16_desc(uint32_t (&a)[16], const uint32_t (&b)[16]) {
#pragma unroll
  for (int i = 0; i < 16; ++i) a[i] = max(a[i], b[15 - i]);
#pragma unroll
  for (int st = 8; st >= 1; st >>= 1)
#pragma unroll
    for (int i = 0; i < 16; ++i)
      if ((i & st) == 0) { const uint32_t hi = max(a[i], a[i + st]), lo = min(a[i], a[i + st]); a[i] = hi; a[i + st] = lo; }
}

__device__ constexpr int PAIR_I[50] = {0,0,0,0,0,0,0,0,0,0,0,0,0,0,0,0,1,1,1,1,1,1,1,1,2,2,2,2,2,3,3,3,3,4,4,4,5,5,6,6,7,7,8,9,10,11,12,13,14,15};
__device__ constexpr int PAIR_J[50] = {0,1,2,3,4,5,6,7,8,9,10,11,12,13,14,15,0,1,2,3,4,5,6,7,0,1,2,3,4,0,1,2,3,0,1,2,0,1,0,1,0,1,0,0,0,0,0,0,0,0};

DI void topk_block(const u16* qrow0, int qstride, int hd, size_t tok0, const u16* KEYS, int* SELI, float* SELG) {
  const int lane = tidx() & 63, l31 = lane & 31, hh = lane >> 5;
  const uint32_t hh4 = (uint32_t)hh << 2;
  {
    const size_t tok = tok0 + l31;
    uint32_t top[2][16];
#pragma unroll
    for (int pp = 0; pp < 2; ++pp) {
      bf16x8 qf[4];
#pragma unroll
      for (int ks = 0; ks < 4; ++ks) qf[ks] = *(const bf16x8*)(qrow0 + (size_t)l31 * qstride + pp * 64 + 16 * ks + 8 * hh);
      f32x16 acc[4];
#pragma unroll
      for (int mt = 0; mt < 4; ++mt) {
#pragma unroll
        for (int i = 0; i < 16; ++i) acc[mt][i] = 0.f;
#pragma unroll
        for (int ks = 0; ks < 4; ++ks) {
          const bf16x8 a = *(const bf16x8*)(KEYS + (size_t)((hd * 2 + pp) * 128 + 32 * mt + l31) * 64 + 16 * ks + 8 * hh);
          acc[mt] = MFMA32(a, qf[ks], acc[mt]);
        }
      }
      uint32_t lst[4][16];
#pragma unroll
      for (int mt = 0; mt < 4; ++mt) {
#pragma unroll
        for (int i = 0; i < 16; ++i) {
          const uint32_t kc = (uint32_t)(127 - (32 * mt + (i & 3) + 8 * (i >> 2)));
          lst[mt][i] = ((ordf(acc[mt][i]) & 0xFFFFFF80u) | kc) ^ hh4;
        }
        sort16_desc(lst[mt]);
      }
      merge16_desc(lst[0], lst[1]);
      merge16_desc(lst[2], lst[3]);
      merge16_desc(lst[0], lst[2]);
#pragma unroll
      for (int i = 0; i < 16; ++i) top[pp][i] = lst[0][i];
      uint32_t c[16];
#pragma unroll
      for (int i = 0; i < 16; ++i) c[i] = max(top[pp][i], (uint32_t)__shfl_xor((int)top[pp][15 - i], 32));
#pragma unroll
      for (int st = 8; st >= 1; st >>= 1)
#pragma unroll
        for (int i = 0; i < 16; ++i)
          if ((i & st) == 0) { const uint32_t hi = max(c[i], c[i + st]), lo = min(c[i], c[i + st]); c[i] = hi; c[i + st] = lo; }
#pragma unroll
      for (int i = 0; i < 16; ++i) top[pp][i] = c[i];
    }
    uint32_t tk[16], tv[16];
#pragma unroll
    for (int i = 0; i < 16; ++i) { tk[i] = 0u; tv[i] = 0u; }
#pragma unroll
    for (int q = 0; q < 25; ++q) {
      const int ia = PAIR_I[2 * q], ja = PAIR_J[2 * q], ib = PAIR_I[2 * q + 1], jb = PAIR_J[2 * q + 1];
      const uint32_t k1 = hh ? top[0][ib] : top[0][ia];
      const uint32_t k2 = hh ? top[1][jb] : top[1][ja];
      const float xs = unordf(k1 & 0xFFFFFF80u) + unordf(k2 & 0xFFFFFF80u);
      const uint32_t xv = (127u - (k1 & 127u)) * 128u + (127u - (k2 & 127u));
      ins64(tk, tv, ordf(xs), xv);
    }
    {
      uint32_t ck[16], cv[16];
#pragma unroll
      for (int i = 0; i < 16; ++i) {
        const uint32_t ok = (uint32_t)__shfl_xor((int)tk[15 - i], 32), ov = (uint32_t)__shfl_xor((int)tv[15 - i], 32);
        const bool gt = ok > tk[i];
        ck[i] = gt ? ok : tk[i]; cv[i] = gt ? ov : tv[i];
      }
#pragma unroll
      for (int i = 0; i < 16; ++i) { tk[i] = ck[i]; tv[i] = cv[i]; }
    }
    float e[16], sum = 0.f;
    uint32_t mk = tk[0];
#pragma unroll
    for (int i = 1; i < 16; ++i) mk = max(mk, tk[i]);
    const float mx = unordf(mk);
#pragma unroll
    for (int i = 0; i < 16; ++i) { e[i] = __expf(unordf(tk[i]) - mx); sum += e[i]; }
    const float inv = 1.f / sum;
    int* ip = SELI + (tok * 8 + hd) * 16;
    float* gp = SELG + (tok * 8 + hd) * 16;
    if (hh == 0) {
      *(uint4*)ip = make_uint4(tv[0], tv[1], tv[2], tv[3]);
      *(uint4*)(ip + 4) = make_uint4(tv[4], tv[5], tv[6], tv[7]);
      *(uint4*)(ip + 8) = make_uint4(tv[8], tv[9], tv[10], tv[11]);
      *(uint4*)(ip + 12) = make_uint4(tv[12], tv[13], tv[14], tv[15]);
      *(float4*)gp = make_float4(e[0] * inv, e[1] * inv, e[2] * inv, e[3] * inv);
      *(float4*)(gp + 4) = make_float4(e[4] * inv, e[5] * inv, e[6] * inv, e[7] * inv);
      *(float4*)(gp + 8) = make_float4(e[8] * inv, e[9] * inv, e[10] * inv, e[11] * inv);
      *(float4*)(gp + 12) = make_float4(e[12] * inv, e[13] * inv, e[14] * inv, e[15] * inv);
    }
  }
}

DI void phase_pq_topk(const Params& p, char* smem) {
  char* ws = p.ws;
  const int tid = tidx(), lane = tid & 63, wave = tid >> 6, wm = wave >> 1, wn = wave & 1, hh = lane >> 5;
  float* rs = rs_ptr(smem);
  const float* ssq = (const float*)(ws + OFF_SSQ2);
  u16* Qs = (u16*)smem;
  for (int it = 0;; ++it) {
    int mt, nt;
    if (!tile_map(it, 256, 8, mt, nt)) break;
    const int m0 = mt * 128, n0 = nt * 128;
    f32x16 acc[2][2];
    gemm_main((const u16*)(ws + OFF_XB), (const u16*)(ws + OFF_WPQ), m0, n0, smem, acc);
    if (tid < 128) {
      const float4* sp = (const float4*)(ssq + (size_t)(m0 + tid) * 8);
      float4 s0 = sp[0], s1 = sp[1];
      rs[tid] = rsqrtf((s0.x + s0.y + s0.z + s0.w + s1.x + s1.y + s1.z + s1.w) * (1.f / 1024.f) + EPS);
    }
    __syncthreads();
#pragma unroll
    for (int mi = 0; mi < 2; ++mi) {
      const int rl = 64 * wm + 32 * mi + (lane & 31);
      const float sc = rs[rl];
#pragma unroll
      for (int ni = 0; ni < 2; ++ni)
#pragma unroll
        for (int q = 0; q < 4; ++q) {
          const int col = 64 * wn + 32 * ni + 8 * q + 4 * hh;
          *(uint2*)(Qs + rl * 136 + col) =
              make_uint2(pack2(acc[mi][ni][4 * q] * sc, acc[mi][ni][4 * q + 1] * sc), pack2(acc[mi][ni][4 * q + 2] * sc, acc[mi][ni][4 * q + 3] * sc));
        }
    }
    __syncthreads();
    topk_block(Qs + 32 * wave * 136, 136, nt, (size_t)m0 + 32 * wave, (const u16*)(ws + OFF_KEYS), (int*)(ws + OFF_SELI), (float*)(ws + OFF_SELG));
    __syncthreads();
  }
}

DI bf16x8 fp8x8_to_bf16(uint32_t d0, uint32_t d1) {
  const bf16x2v c0 = __builtin_amdgcn_cvt_scalef32_pk_bf16_fp8((int)d0, 1.0f, false);
  const bf16x2v c1 = __builtin_amdgcn_cvt_scalef32_pk_bf16_fp8((int)d0, 1.0f, true);
  const bf16x2v c2 = __builtin_amdgcn_cvt_scalef32_pk_bf16_fp8((int)d1, 1.0f, false);
  const bf16x2v c3 = __builtin_amdgcn_cvt_scalef32_pk_bf16_fp8((int)d1, 1.0f, true);
  const uint4 u = make_uint4(__builtin_bit_cast(uint32_t, c0), __builtin_bit_cast(uint32_t, c1), __builtin_bit_cast(uint32_t, c2), __builtin_bit_cast(uint32_t, c3));
  return __builtin_bit_cast(bf16x8, u);
}

DI void phase_peer(const Params& p, char* smem, float* dst) {
  char* ws = p.ws;
  const int tid = tidx(), lane = tid & 63, wave = tid >> 6, m = lane & 15, g = lane >> 4;
  const u16* HB = (const u16*)(ws + OFF_XB);
  const unsigned char* EU = (const unsigned char*)(ws + OFF_EU);
  const unsigned char* EV = (const unsigned char*)(ws + OFF_EV);
  const int* SELI = (const int*)(ws + OFF_SELI);
  const float* SELG = (const float*)(ws + OFF_SELG);
  const float* SSQ = (const float*)(ws + OFF_SSQ2);
  float* coef = (float*)(smem + wave * 1024);
  int* idxs = (int*)(smem + wave * 1024 + 512);
  for (int tile = blockIdx.x; tile < T_TOK / 4; tile += gridDim.x) {
    const size_t t = (size_t)tile * 4 + wave;
    const float4 q0 = *(const float4*)(SSQ + t * 8), q1 = *(const float4*)(SSQ + t * 8 + 4);
    const float rstd = rsqrtf((q0.x + q0.y + q0.z + q0.w + q1.x + q1.y + q1.z + q1.w) * (1.f / 1024.f) + EPS) * (1.f / EU_SCALE);
    int myidx[8];
#pragma unroll
    for (int grp = 0; grp < 8; ++grp) myidx[grp] = SELI[t * 128 + grp * 16 + m];
    f32x4 acc[8];
#pragma unroll
    for (int grp = 0; grp < 8; ++grp) acc[grp] = {0.f, 0.f, 0.f, 0.f};
    for (int kb2 = 0; kb2 < 8; ++kb2) {
      bf16x8 xf[4];
#pragma unroll
      for (int j = 0; j < 4; ++j) xf[j] = *(const bf16x8*)(HB + t * 1024 + kb2 * 128 + g * 32 + 8 * j);
      uint4 raw0[8], raw1[8];
#pragma unroll
      for (int grp = 0; grp < 8; ++grp) {
        const unsigned char* up = EU + (size_t)myidx[grp] * 1024 + kb2 * 128 + g * 32;
        raw0[grp] = *(const uint4*)up;
        raw1[grp] = *(const uint4*)(up + 16);
      }
#pragma unroll
      for (int grp = 0; grp < 8; ++grp) {
        acc[grp] = MFMA16(fp8x8_to_bf16(raw0[grp].x, raw0[grp].y), xf[0], acc[grp]);
        acc[grp] = MFMA16(fp8x8_to_bf16(raw0[grp].z, raw0[grp].w), xf[1], acc[grp]);
        acc[grp] = MFMA16(fp8x8_to_bf16(raw1[grp].x, raw1[grp].y), xf[2], acc[grp]);
        acc[grp] = MFMA16(fp8x8_to_bf16(raw1[grp].z, raw1[grp].w), xf[3], acc[grp]);
      }
    }
    if (g == 0) {
#pragma unroll
      for (int grp = 0; grp < 8; ++grp) idxs[grp * 16 + m] = myidx[grp];
    }
    if (m == 0) {
#pragma unroll
      for (int grp = 0; grp < 8; ++grp)
#pragma unroll
        for (int j = 0; j < 4; ++j) {
          const int e = grp * 16 + 4 * g + j;
          const float a = acc[grp][j] * rstd;
          const float ge = 0.5f * a * (1.f + erff(a * 0.7071067811865475f));
          coef[e] = SELG[t * 128 + e] * ge * (1.f / EV_SCALE);
        }
    }
    __syncthreads();
    f32x2 y[8];
#pragma unroll
    for (int i = 0; i < 8; ++i) y[i] = {0.f, 0.f};
#pragma unroll 8
    for (int e = 0; e < 128; ++e) {
      const float c = coef[e];
      const f32x2 c2 = {c, c};
      const uint4 r = *(const uint4*)(EV + (size_t)idxs[e] * 1024 + lane * 16);
      y[0] += c2 * __builtin_amdgcn_cvt_pk_f32_fp8((int)r.x, false);
      y[1] += c2 * __builtin_amdgcn_cvt_pk_f32_fp8((int)r.x, true);
      y[2] += c2 * __builtin_amdgcn_cvt_pk_f32_fp8((int)r.y, false);
      y[3] += c2 * __builtin_amdgcn_cvt_pk_f32_fp8((int)r.y, true);
      y[4] += c2 * __builtin_amdgcn_cvt_pk_f32_fp8((int)r.z, false);
      y[5] += c2 * __builtin_amdgcn_cvt_pk_f32_fp8((int)r.z, true);
      y[6] += c2 * __builtin_amdgcn_cvt_pk_f32_fp8((int)r.w, false);
      y[7] += c2 * __builtin_amdgcn_cvt_pk_f32_fp8((int)r.w, true);
    }
    const float* hp = p.out + t * 1024 + lane * 16;
    float* dp = dst + t * 1024 + lane * 16;
    float hv[16];
#pragma unroll
    for (int q = 0; q < 4; ++q) { const float4 h4 = *(const float4*)(hp + 4 * q); hv[4 * q] = h4.x; hv[4 * q + 1] = h4.y; hv[4 * q + 2] = h4.z; hv[4 * q + 3] = h4.w; }
    float ss = 0.f;
#pragma unroll
    for (int i = 0; i < 8; ++i) { hv[2 * i] += y[i][0]; hv[2 * i + 1] += y[i][1]; }
#pragma unroll
    for (int i = 0; i < 16; ++i) ss += hv[i] * hv[i];
    ss = wave_sum(ss);
    const float rn = rsqrtf(ss * (1.f / 1024.f) + EPS);
#pragma unroll
    for (int q = 0; q < 4; ++q) {
      const float4 n4 = *(const float4*)(p.norm_final + lane * 16 + 4 * q);
      *(float4*)(dp + 4 * q) = make_float4(hv[4 * q] * rn * n4.x, hv[4 * q + 1] * rn * n4.y, hv[4 * q + 2] * rn * n4.z, hv[4 * q + 3] * rn * n4.w);
    }
    __syncthreads();
  }
}

#define XB_TMO      128
#define XB_XCNT(j)  (256  + 64 * (j))
#define XB_XSUB(j)  (1280 + 64 * (j))
#define XB_XGEN(j)  (2304 + 64 * (j))
#define XB_TOP      3328
#define XB_TOPGEN   3392
#define XCD_BAR_WORDS 3456
#define XB_SPIN_CAP (1u << 22)
#define LAS __attribute__((address_space(3)))
DI unsigned xb_ld(unsigned* p)              { return __hip_atomic_load(p, __ATOMIC_RELAXED, __HIP_MEMORY_SCOPE_AGENT); }
DI unsigned xb_add(unsigned* p, unsigned v) { return __hip_atomic_fetch_add(p, v, __ATOMIC_RELAXED, __HIP_MEMORY_SCOPE_AGENT); }
DI unsigned xb_xcc_id() { return (unsigned)__builtin_amdgcn_s_getreg((3 << 11) | 20) & 0xFu; }
#define XB_SPIN(cond, bar) do { unsigned _sp = 0; while (cond) { __builtin_amdgcn_s_sleep(1); \
    if ((++_sp & 255u) == 0u) { if (xb_ld(&(bar)[XB_TMO])) break; if (_sp > XB_SPIN_CAP) { atomicAdd(&(bar)[XB_TMO], 1u); break; } } } } while (0)
struct XcdBarrier { unsigned* bar; unsigned x; volatile LAS unsigned* st; };
DI XcdBarrier xcd_barrier_post(unsigned* bar, volatile LAS unsigned* st) {
  XcdBarrier b; b.bar = bar; b.x = xb_xcc_id(); b.st = st;
  if (__builtin_amdgcn_workitem_id_x() == 0) (void)xb_add(&bar[XB_XCNT(b.x)], 1u);
  return b;
}
DI void xcd_barrier_complete(unsigned* bar, unsigned x, unsigned& nloc, unsigned& nx) {
  const unsigned G = gridDim.x * gridDim.y * gridDim.z;
  unsigned sum, cnt, mine, sp = 0u;
  for (;;) {
    sum = 0u; cnt = 0u; mine = 0u;
#pragma unroll
    for (unsigned j = 0; j < 16; ++j) { const unsigned c = xb_ld(&bar[XB_XCNT(j)]); sum += c; cnt += (c > 0u) ? 1u : 0u; mine = (j == x) ? c : mine; }
    if (sum == G) break;
    __builtin_amdgcn_s_sleep(1);
    if ((++sp & 255u) == 0u) { if (xb_ld(&bar[XB_TMO])) break; if (sp > XB_SPIN_CAP) { atomicAdd(&bar[XB_TMO], 1u); break; } }
  }
  nloc = mine > 0u ? mine : 1u; nx = cnt > 0u ? cnt : 1u;
}
DI void xcd_barrier(const XcdBarrier& b) {
  asm volatile("s_waitcnt vmcnt(0)" ::: "memory");
  __syncthreads();
  if (__builtin_amdgcn_workitem_id_x() == 0) {
    unsigned* bar = b.bar;
    __builtin_amdgcn_s_waitcnt(0);
    unsigned nloc = b.st[0], nx = b.st[1];
    if (nloc == 0u) { xcd_barrier_complete(bar, b.x, nloc, nx); b.st[0] = nloc; b.st[1] = nx; }
    const unsigned old = xb_add(&bar[XB_XSUB(b.x)], 1u);
    const unsigned gen = old / nloc;
    if (old + 1u == (gen + 1u) * nloc) {
      __builtin_amdgcn_fence(__ATOMIC_RELEASE, "agent");
      asm volatile("s_waitcnt vmcnt(0)" ::: "memory");
      const unsigned og = xb_add(&bar[XB_TOP], 1u);
      const unsigned tg = og / nx;
      if (og + 1u == (tg + 1u) * nx) xb_add(&bar[XB_TOPGEN], 1u);
      else XB_SPIN(xb_ld(&bar[XB_TOPGEN]) == tg, bar);
      __builtin_amdgcn_fence(__ATOMIC_ACQUIRE, "agent");
      xb_add(&bar[XB_XGEN(b.x)], 1u);
      asm volatile("s_waitcnt vmcnt(0)" ::: "memory");
    } else {
      XB_SPIN(xb_ld(&bar[XB_XGEN(b.x)]) == gen, bar);
      __builtin_amdgcn_fence(__ATOMIC_ACQUIRE, "agent");
      asm volatile("s_waitcnt vmcnt(0)" ::: "memory");
    }
  }
  __syncthreads();
}

__global__ void __launch_bounds__(256, 2) fwd_kernel(Params p_in, int ph_lo, int ph_hi) {
  extern __shared__ __attribute__((aligned(16))) char smem[];
  char* ws0 = p_in.ws;
#ifndef DOUBLE_MASK
#define DOUBLE_MASK 0
#endif
  const bool multi = (ph_hi - ph_lo) > 1;
  XcdBarrier xb;
  if (multi) {
    volatile LAS unsigned* st = (volatile LAS unsigned*)(smem + SMEM_BYTES - 16);
    if (__builtin_amdgcn_workitem_id_x() == 0) { st[0] = 0u; st[1] = 0u; }
    __syncthreads();
    xb = xcd_barrier_post((unsigned*)(ws0 + OFF_BAR), st);
  }
  if (ph_lo < -1000) cg::this_grid().sync();
#if defined(__HIP_DEVICE_COMPILE__)
#define LOAD_PARAMS(dst_) { const __attribute__((address_space(4))) char* kp_ = (const __attribute__((address_space(4))) char*)__builtin_amdgcn_kernarg_segment_ptr(); \
                            asm volatile("" : "+s"(kp_)); __builtin_memcpy(&(dst_), kp_, sizeof(Params)); }
#else
#define LOAD_PARAMS(dst_) { dst_ = p_in; }
#endif
#define RUN_PHASE(k, call) if (ph_lo <= (k) && (k) < ph_hi) { \
    _Pragma("unroll 1") for (int rep = ((DOUBLE_MASK >> (k)) & 1); rep >= 0; --rep) { \
      Params pl; LOAD_PARAMS(pl); const Params& p = pl; char* ws = p.ws; (void)ws; \
      call; if (rep > 0 || (k) + 1 < ph_hi) xcd_barrier(xb); } }
  RUN_PHASE(0, phase_prep(p, smem))
  RUN_PHASE(1, phase_proj(p, smem))
  RUN_PHASE(2, phase_chunks(p, smem))
  RUN_PHASE(3, phase_scan(p, smem))
  RUN_PHASE(4, phase_gate(p))
  RUN_PHASE(5, phase_resid((const u16*)(ws + OFF_YMIX), (const u16*)(ws + OFF_WOUT), p.x, p.out, (u16*)(ws + OFF_XB), (float*)(ws + OFF_SSQ1), smem))
  RUN_PHASE(6, phase_scaled((const u16*)(ws + OFF_XB), (const u16*)(ws + OFF_WXQ), (const float*)(ws + OFF_SSQ1), (u16*)(ws + OFF_QX), smem))
  RUN_PHASE(7, phase_attn(p, smem))
  RUN_PHASE(8, phase_resid((const u16*)(ws + OFF_OX), (const u16*)(ws + OFF_WXO), p.out, p.out, (u16*)(ws + OFF_XB), (float*)(ws + OFF_SSQ2), smem))
  RUN_PHASE(9, phase_pq_topk(p, smem))
  if (ph_lo <= 11 && 11 < ph_hi) {
    Params pl; LOAD_PARAMS(pl); const Params& p = pl;
#if (DOUBLE_MASK >> 11) & 1
    phase_peer(p, smem, (float*)(p.ws + OFF_PROJ)); xcd_barrier(xb);
#endif
    phase_peer(p, smem, p.out);
  }
}

extern "C" void kernel_launch(void* const* d_in, const int* in_sizes, int n_in, void* d_out, int out_size, void* d_ws, size_t ws_size,
                              hipStream_t stream) {
  static int grid = 0;
  if (grid == 0) {
    if (n_in != 21 || out_size != T_TOK * DM || ws_size < WS_END) {
      fprintf(stderr, "kernel_launch: unexpected shapes (n_in %d out %d ws %zu need %zu)\n", n_in, out_size, ws_size, (size_t)WS_END);
      grid = -1;
      return;
    }
    int dev = 0, cus = 0, per_cu = 0;
    hipGetDevice(&dev);
    hipDeviceGetAttribute(&cus, hipDeviceAttributeMultiprocessorCount, dev);
    hipFuncSetAttribute((const void*)fwd_kernel, hipFuncAttributeMaxDynamicSharedMemorySize, SMEM_BYTES);
    hipOccupancyMaxActiveBlocksPerMultiprocessor(&per_cu, (const void*)fwd_kernel, 256, SMEM_BYTES);
    if (per_cu < 1) per_cu = 1;
    if (per_cu > 2) per_cu = 2;
    grid = cus * per_cu;
    if (grid < 128) { fprintf(stderr, "kernel_launch: grid %d too small\n", grid); grid = -1; return; }
  }
  if (grid < 0) return;
  Params p{};
  const float** pp = (const float**)&p;
  for (int i = 0; i < 21; ++i) pp[i] = (const float*)d_in[i];
  p.out = (float*)d_out;
  p.ws = (char*)d_ws;
#if ONE_LAUNCH
  hipMemsetAsync((char*)d_ws + OFF_BAR, 0, BAR_BYTES, stream);
  int lo = 0, hi = NPH;
  void* args[] = {&p, &lo, &hi};
  hipError_t e = hipLaunchCooperativeKernel((const void*)fwd_kernel, dim3(grid), dim3(256), args, SMEM_BYTES, stream);
  if (e != hipSuccess) fprintf(stderr, "cooperative launch failed: %s (grid %d)\n", hipGetErrorString(e), grid);
#else
  for (int ph = 0; ph < NPH; ++ph) hipLaunchKernelGGL(fwd_kernel, dim3(grid), dim3(256), SMEM_BYTES, stream, p, ph, ph + 1);
#endif
}
```

```cpp
#include <hip/hip_runtime.h>
#include <hip/hip_cooperative_groups.h>
#include <stdint.h>
#include <stdio.h>
namespace cg = cooperative_groups;

typedef unsigned short u16;
using bf16x8 = __attribute__((ext_vector_type(8))) short;
using f32x4  = __attribute__((ext_vector_type(4))) float;
using f32x16 = __attribute__((ext_vector_type(16))) float;
using f32x2  = __attribute__((ext_vector_type(2))) float;
using bf16x2v = __attribute__((ext_vector_type(2))) __bf16;

#define DI __device__ __forceinline__
#define MFMA32(a, b, c) __builtin_amdgcn_mfma_f32_32x32x16_bf16((a), (b), (c), 0, 0, 0)
#define MFMA16(a, b, c) __builtin_amdgcn_mfma_f32_16x16x32_bf16((a), (b), (c), 0, 0, 0)

#ifndef ONE_LAUNCH
#define ONE_LAUNCH 1
#endif

constexpr int T_TOK = 32768;
constexpr int SEQ = 8192;
constexpr int DM = 1024;
constexpr int INC = 3592;
constexpr int NPH = 12;
constexpr float EPS = 1e-6f;
constexpr float EU_SCALE = 64.f, EV_SCALE = 8.f;

constexpr size_t MiB = 1024ull * 1024ull;
constexpr size_t OFF_WIN  = 0;
constexpr size_t OFF_WOUT = OFF_WIN + 3712ull * 1024 * 2;
constexpr size_t OFF_WXQ  = OFF_WOUT + 2 * MiB;
constexpr size_t OFF_WXKV = OFF_WXQ + 2 * MiB;
constexpr size_t OFF_WXO  = OFF_WXKV + 4 * MiB;
constexpr size_t OFF_WPQ  = OFF_WXO + 2 * MiB;
constexpr size_t OFF_KEYS = OFF_WPQ + 2 * MiB;
constexpr size_t OFF_EU   = OFF_KEYS + 262144;
constexpr size_t OFF_EV   = OFF_EU + 32 * MiB;
constexpr size_t OFF_XB   = OFF_EV + 32 * MiB;
constexpr size_t OFF_MEMB = OFF_XB + 64 * MiB;
constexpr size_t OFF_KX   = OFF_MEMB + 2 * MiB;
constexpr size_t OFF_VT   = OFF_KX + 2 * MiB;
constexpr size_t OFF_RSTD0 = OFF_VT + 2 * MiB;
constexpr size_t OFF_RSTDM = OFF_RSTD0 + 131072;
constexpr size_t OFF_SSQ1 = OFF_RSTDM + 4096;
constexpr size_t OFF_SSQ2 = OFF_SSQ1 + 1 * MiB;
constexpr size_t OFF_BA   = OFF_SSQ2 + 1 * MiB;
constexpr size_t OFF_GL   = OFF_BA + 1 * MiB;
constexpr size_t OFF_YMIX = OFF_GL + 8192;
constexpr size_t OFF_PROJ = OFF_YMIX + 64 * MiB;
constexpr size_t PROJ_BYTES = (size_t)T_TOK * INC * 2;
constexpr size_t OFF_BAR  = OFF_PROJ + PROJ_BYTES;
constexpr size_t BAR_BYTES = 16384;
constexpr size_t OFF_TS   = OFF_BAR + BAR_BYTES;
constexpr size_t WS_END   = OFF_TS + 4096;
constexpr size_t OFF_QX   = OFF_PROJ;
constexpr size_t OFF_OX   = OFF_PROJ + 64 * MiB;
constexpr size_t OFF_PQ   = OFF_PROJ + 128 * MiB;
constexpr size_t OFF_SELI = OFF_PROJ + 192 * MiB;
constexpr size_t OFF_SELG = OFF_PROJ + 208 * MiB;

constexpr int SMEM_BYTES = 75776;

struct Params {
  const float *x, *mem, *norm_mix, *w_in, *conv_w, *dn_conv_w, *dn_a_log, *dn_dt_bias, *dn_norm, *w_out,
      *norm_x, *norm_mem, *w_xq, *w_xkv, *w_xo, *norm_ffn, *w_pq, *peer_keys, *expert_u, *expert_v, *norm_final;
  float* out;
  char* ws;
};

DI int tidx() { int t = (int)__builtin_amdgcn_workitem_id_x(); asm volatile("" : "+v"(t)); return t; }
DI u16 f2bf(float x) { return __builtin_bit_cast(u16, (__bf16)x); }
DI float bf2f(u16 v) { return __uint_as_float(((uint32_t)v) << 16); }
DI uint32_t pack2(float a, float b) { const bf16x2v v = {(__bf16)a, (__bf16)b}; return __builtin_bit_cast(uint32_t, v); }
DI float bflo(uint32_t u) { return __uint_as_float(u << 16); }
DI float bfhi(uint32_t u) { return __uint_as_float(u & 0xffff0000u); }
DI int crow32(int i, int h) { return (i & 3) + 8 * (i >> 2) + 4 * h; }
DI float silu_f(float v) { return v / (1.f + __expf(-v)); }
DI float wave_sum(float v) {
#pragma unroll
  for (int o = 32; o >= 1; o >>= 1) v += __shfl_xor(v, o);
  return v;
}
DI void unpack8(const uint4& r, float* f) {
  f[0] = bflo(r.x); f[1] = bfhi(r.x); f[2] = bflo(r.y); f[3] = bfhi(r.y);
  f[4] = bflo(r.z); f[5] = bfhi(r.z); f[6] = bflo(r.w); f[7] = bfhi(r.w);
}
DI uint4 pack8(const float* f) { return make_uint4(pack2(f[0], f[1]), pack2(f[2], f[3]), pack2(f[4], f[5]), pack2(f[6], f[7])); }

DI void rowconv(const float* __restrict__ src, u16* __restrict__ dst, const float* __restrict__ gain, float* __restrict__ rstd, int rows) {
  const int lane = tidx() & 63;
  const int gw = blockIdx.x * 4 + (tidx() >> 6), nw = gridDim.x * 4;
  for (int r = gw; r < rows; r += nw) {
    const float4* s = (const float4*)(src + (size_t)r * 1024);
    float4 a0 = s[lane * 2], a1 = s[lane * 2 + 1], b0 = s[128 + lane * 2], b1 = s[128 + lane * 2 + 1];
    float f[16] = {a0.x, a0.y, a0.z, a0.w, a1.x, a1.y, a1.z, a1.w, b0.x, b0.y, b0.z, b0.w, b1.x, b1.y, b1.z, b1.w};
    if (rstd) {
      float ss = 0.f;
#pragma unroll
      for (int i = 0; i < 16; ++i) ss += f[i] * f[i];
      ss = wave_sum(ss);
      if (lane == 0) rstd[r] = rsqrtf(ss * (1.f / 1024.f) + EPS);
    }
    if (gain) {
      const float4* gp = (const float4*)gain;
      float4 g0 = gp[lane * 2], g1 = gp[lane * 2 + 1], g2 = gp[128 + lane * 2], g3 = gp[128 + lane * 2 + 1];
      float gg[16] = {g0.x, g0.y, g0.z, g0.w, g1.x, g1.y, g1.z, g1.w, g2.x, g2.y, g2.z, g2.w, g3.x, g3.y, g3.z, g3.w};
#pragma unroll
      for (int i = 0; i < 16; ++i) f[i] *= gg[i];
    }
    *(uint4*)(dst + (size_t)r * 1024 + lane * 8) = pack8(f);
    *(uint4*)(dst + (size_t)r * 1024 + 512 + lane * 8) = pack8(f + 8);
  }
}


DI void rowconv8(const float* __restrict__ src, unsigned char* __restrict__ dst, const float* __restrict__ gain, float scale, int rows, int bid, int nb) {
  const int lane = tidx() & 63;
  const int gw = bid * 4 + (tidx() >> 6), nw = nb * 4;
  float gg[16];
#pragma unroll
  for (int i = 0; i < 16; ++i) gg[i] = scale;
  if (gain) {
    const float4* gp = (const float4*)(gain + lane * 16);
#pragma unroll
    for (int q = 0; q < 4; ++q) { const float4 g4 = gp[q]; gg[4 * q] *= g4.x; gg[4 * q + 1] *= g4.y; gg[4 * q + 2] *= g4.z; gg[4 * q + 3] *= g4.w; }
  }
  for (int r = gw; r < rows; r += nw) {
    const float4* s = (const float4*)(src + (size_t)r * 1024 + lane * 16);
    uint32_t o[4];
#pragma unroll
    for (int q = 0; q < 4; ++q) {
      const float4 v = s[q];
      int pk = __builtin_amdgcn_cvt_pk_fp8_f32(v.x * gg[4 * q], v.y * gg[4 * q + 1], 0, false);
      pk = __builtin_amdgcn_cvt_pk_fp8_f32(v.z * gg[4 * q + 2], v.w * gg[4 * q + 3], pk, true);
      o[q] = (uint32_t)pk;
    }
    *(uint4*)(dst + (size_t)r * 1024 + lane * 16) = make_uint4(o[0], o[1], o[2], o[3]);
  }
}

DI void transpose_tile(const float* __restrict__ W, int N, const float* __restrict__ gain, u16* __restrict__ Wt, int nt, int kt, float* tile) {
  const int t = tidx();
  const int k0 = kt * 64, n0 = nt * 64;
#pragma unroll
  for (int i = 0; i < 16; ++i) {
    int kk = i * 4 + (t >> 6), nn = t & 63;
    float v = 0.f;
    if (n0 + nn < N) v = W[(size_t)(k0 + kk) * N + n0 + nn] * (gain ? gain[k0 + kk] : 1.f);
    tile[kk * 65 + nn] = v;
  }
  __syncthreads();
#pragma unroll
  for (int i = 0; i < 16; ++i) {
    int nn = i * 4 + (t >> 6), kk = t & 63;
    if (n0 + nn < N) Wt[(size_t)(n0 + nn) * 1024 + k0 + kk] = f2bf(tile[kk * 65 + nn]);
  }
  __syncthreads();
}

DI void weight_transposes(const Params& p, char* smem, unsigned mask, int bid, int nb) {
  char* ws = p.ws;
  const int cnt_all[6] = {57 * 16, 256, 256, 512, 256, 256};
  int cnt[6], total = 0;
  for (int i = 0; i < 6; ++i) { cnt[i] = ((mask >> i) & 1u) ? cnt_all[i] : 0; total += cnt[i]; }
  for (int job = bid; job < total; job += nb) {
    int j = job, w = 0;
    while (j >= cnt[w]) { j -= cnt[w]; ++w; }
    const float* W; const float* gain; u16* dst; int N;
    switch (w) {
      case 0: W = p.w_in; gain = p.norm_mix; dst = (u16*)(ws + OFF_WIN); N = INC; break;
      case 1: W = p.w_out; gain = nullptr; dst = (u16*)(ws + OFF_WOUT); N = 1024; break;
      case 2: W = p.w_xq; gain = p.norm_x; dst = (u16*)(ws + OFF_WXQ); N = 1024; break;
      case 3: W = p.w_xkv; gain = p.norm_mem; dst = (u16*)(ws + OFF_WXKV); N = 2048; break;
      case 4: W = p.w_xo; gain = nullptr; dst = (u16*)(ws + OFF_WXO); N = 1024; break;
      default: W = p.w_pq; gain = p.norm_ffn; dst = (u16*)(ws + OFF_WPQ); N = 1024; break;
    }
    transpose_tile(W, N, gain, dst, j >> 4, j & 15, (float*)smem);
  }
}
DI void keys_convert(const Params& p, int bid, int nb) {
  u16* kd = (u16*)(p.ws + OFF_KEYS);
  for (int i = bid * 256 + tidx(); i < 131072; i += nb * 256) kd[i] = f2bf(p.peer_keys[i]);
}

DI void phase_prep(const Params& p, char* smem) {
  char* ws = p.ws;
  const bool defer = gridDim.x >= 256;
  weight_transposes(p, smem, defer ? 0x09u : 0x3Fu, blockIdx.x, gridDim.x);
  rowconv(p.x, (u16*)(ws + OFF_XB), nullptr, (float*)(ws + OFF_RSTD0), T_TOK);
  rowconv(p.mem, (u16*)(ws + OFF_MEMB), nullptr, (float*)(ws + OFF_RSTDM), 1024);
  if (!defer) {
    rowconv8(p.expert_u, (unsigned char*)(ws + OFF_EU), p.norm_ffn, EU_SCALE, 16384, blockIdx.x, gridDim.x);
    rowconv8(p.expert_v, (unsigned char*)(ws + OFF_EV), nullptr, EV_SCALE, 16384, blockIdx.x, gridDim.x);
    keys_convert(p, blockIdx.x, gridDim.x);
  }
}

typedef unsigned u32x4 __attribute__((ext_vector_type(4)));
DI void gload16(u32x4& dst, const void* p) { asm volatile("global_load_dwordx4 %0, %1, off" : "=&v"(dst) : "v"(p) : "memory"); }
DI void gwait8_all(u32x4& a0, u32x4& a1, u32x4& a2, u32x4& a3, u32x4& b0, u32x4& b1, u32x4& b2, u32x4& b3) {
  asm volatile("s_waitcnt vmcnt(0)" : "+v"(a0), "+v"(a1), "+v"(a2), "+v"(a3), "+v"(b0), "+v"(b1), "+v"(b2), "+v"(b3) : : "memory");
}
DI void gwait8_keep8(u32x4& a0, u32x4& a1, u32x4& a2, u32x4& a3, u32x4& b0, u32x4& b1, u32x4& b2, u32x4& b3) {
  asm volatile("s_waitcnt vmcnt(8)" : "+v"(a0), "+v"(a1), "+v"(a2), "+v"(a3), "+v"(b0), "+v"(b1), "+v"(b2), "+v"(b3) : : "memory");
}

DI void gemm_main(const u16* __restrict__ A, const u16* __restrict__ Bt, int m0, int n0, char* smem, f32x16 (&acc)[2][2]) {
  const int tid = tidx(), lane = tid & 63, wave = tid >> 6;
  const int wm = wave >> 1, wn = wave & 1;
  u16* As = (u16*)smem;
  u16* Bs = (u16*)(smem + 36864);
  const int srow = tid >> 3, scol = (tid & 7) * 8;
  const u16* Ap = A + (size_t)(m0 + srow) * 1024 + scol;
  const u16* Bp = Bt + (size_t)(n0 + srow) * 1024 + scol;
  u32x4 r0a[4], r0b[4], r1a[4], r1b[4];
#pragma unroll
  for (int mi = 0; mi < 2; ++mi)
#pragma unroll
    for (int ni = 0; ni < 2; ++ni)
#pragma unroll
      for (int i = 0; i < 16; ++i) acc[mi][ni][i] = 0.f;
#define ISSUE(ra_, rb_, k_) { _Pragma("unroll") for (int i = 0; i < 4; ++i) { gload16(ra_[i], Ap + (size_t)i * 32 * 1024 + (k_) * 64); gload16(rb_[i], Bp + (size_t)i * 32 * 1024 + (k_) * 64); } }
#define STORE(ra_, rb_, buf_) { u16* as2 = As + (buf_) * 128 * 72; u16* bs2 = Bs + (buf_) * 128 * 72; \
    _Pragma("unroll") for (int i = 0; i < 4; ++i) { *(u32x4*)(as2 + (srow + 32 * i) * 72 + scol) = ra_[i]; *(u32x4*)(bs2 + (srow + 32 * i) * 72 + scol) = rb_[i]; } }
  auto compute = [&](int cur) {
    const u16* as = As + cur * 128 * 72;
    const u16* bs = Bs + cur * 128 * 72;
#pragma unroll
    for (int ks = 0; ks < 4; ++ks) {
      bf16x8 a[2], b[2];
#pragma unroll
      for (int mi = 0; mi < 2; ++mi) a[mi] = *(const bf16x8*)(as + (64 * wm + 32 * mi + (lane & 31)) * 72 + 16 * ks + 8 * (lane >> 5));
#pragma unroll
      for (int ni = 0; ni < 2; ++ni) b[ni] = *(const bf16x8*)(bs + (64 * wn + 32 * ni + (lane & 31)) * 72 + 16 * ks + 8 * (lane >> 5));
#pragma unroll
      for (int mi = 0; mi < 2; ++mi)
#pragma unroll
        for (int ni = 0; ni < 2; ++ni) acc[mi][ni] = MFMA32(b[ni], a[mi], acc[mi][ni]);
    }
  };
  ISSUE(r0a, r0b, 0)
  ISSUE(r1a, r1b, 1)
  gwait8_keep8(r0a[0], r0a[1], r0a[2], r0a[3], r0b[0], r0b[1], r0b[2], r0b[3]);
  STORE(r0a, r0b, 0)
  __syncthreads();
#pragma unroll 1
  for (int kk = 0; kk < 16; kk += 2) {
    const int k2 = (kk + 2 < 16) ? kk + 2 : 15, k3 = (kk + 3 < 16) ? kk + 3 : 15;
    ISSUE(r0a, r0b, k2)
    compute(0);
    gwait8_keep8(r1a[0], r1a[1], r1a[2], r1a[3], r1b[0], r1b[1], r1b[2], r1b[3]);
    STORE(r1a, r1b, 1)
    __syncthreads();
    ISSUE(r1a, r1b, k3)
    compute(1);
    gwait8_keep8(r0a[0], r0a[1], r0a[2], r0a[3], r0b[0], r0b[1], r0b[2], r0b[3]);
    STORE(r0a, r0b, 0)
    __syncthreads();
  }
  gwait8_all(r1a[0], r1a[1], r1a[2], r1a[3], r1b[0], r1b[1], r1b[2], r1b[3]);
#undef ISSUE
#undef STORE
}

DI bool tile_map(int it, int MT, int NT, int& mt, int& nt) {
  const int nb = gridDim.x >> 3;
  if ((gridDim.x & 7) != 0) {
    const int tile = blockIdx.x + it * gridDim.x;
    if (tile >= MT * NT) return false;
    mt = tile / NT; nt = tile % NT;
    return true;
  }
  const int vx = blockIdx.x & 7, lb = blockIdx.x >> 3;
  const int per = (MT >> 3) * NT;
  const int q = it * nb + lb;
  if (q >= per) return false;
  const int grp = q / (8 * NT), r = q % (8 * NT);
  mt = vx * (MT >> 3) + grp * 8 + (r & 7);
  nt = r >> 3;
  return true;
}

DI float* rs_ptr(char* smem) { return (float*)(smem + 73728); }
DI float* sq_ptr(char* smem) { return (float*)(smem + 73728 + 512); }

DI void kv_gemm(const Params& p, char* smem, int bid, int nb);
DI void phase_proj(const Params& p, char* smem) {
  char* ws = p.ws;
  const int tid = tidx(), lane = tid & 63, wave = tid >> 6, wm = wave >> 1, wn = wave & 1, hh = lane >> 5;
  float* rs = rs_ptr(smem);
  u16* proj = (u16*)(ws + OFF_PROJ);
  float* ba = (float*)(ws + OFF_BA);
  for (int it = 0;; ++it) {
    int mt, nt;
    if (!tile_map(it, 256, 29, mt, nt)) break;
    const int m0 = mt * 128, n0 = nt * 128;
    f32x16 acc[2][2];
    gemm_main((const u16*)(ws + OFF_XB), (const u16*)(ws + OFF_WIN), m0, n0, smem, acc);
    if (tid < 128) rs[tid] = ((const float*)(ws + OFF_RSTD0))[m0 + tid];
    __syncthreads();
#pragma unroll
    for (int mi = 0; mi < 2; ++mi) {
      const int rl = 64 * wm + 32 * mi + (lane & 31);
      const float sc = rs[rl];
      const size_t row = (size_t)(m0 + rl);
#pragma unroll
      for (int ni = 0; ni < 2; ++ni)
#pragma unroll
        for (int q = 0; q < 4; ++q) {
          const int col = n0 + 64 * wn + 32 * ni + 8 * q + 4 * hh;
          const float v0 = acc[mi][ni][4 * q] * sc, v1 = acc[mi][ni][4 * q + 1] * sc, v2 = acc[mi][ni][4 * q + 2] * sc, v3 = acc[mi][ni][4 * q + 3] * sc;
          if (col < 3584) *(uint2*)(proj + row * INC + col) = make_uint2(pack2(v0, v1), pack2(v2, v3));
          else if (col < INC) *(float4*)(ba + row * 8 + (col - 3584)) = make_float4(v0, v1, v2, v3);
        }
    }
    __syncthreads();
  }
  if (gridDim.x < 256) kv_gemm(p, smem, blockIdx.x, gridDim.x);
}

DI void kv_gemm(const Params& p, char* smem, int bid, int nb) {
  char* ws = p.ws;
  const int tid = tidx(), lane = tid & 63, wave = tid >> 6, wm = wave >> 1, wn = wave & 1, hh = lane >> 5;
  float* rs = rs_ptr(smem);
  u16* kx = (u16*)(ws + OFF_KX);
  u16* vt = (u16*)(ws + OFF_VT);
  for (int t2 = bid; t2 < 128; t2 += nb) {
    const int mt = t2 >> 4, nt = t2 & 15, m0 = mt * 128, n0 = nt * 128;
    f32x16 acc[2][2];
    gemm_main((const u16*)(ws + OFF_MEMB), (const u16*)(ws + OFF_WXKV), m0, n0, smem, acc);
    if (tid < 128) rs[tid] = ((const float*)(ws + OFF_RSTDM))[m0 + tid];
    __syncthreads();
#pragma unroll
    for (int mi = 0; mi < 2; ++mi) {
      const int rl = 64 * wm + 32 * mi + (lane & 31);
      const float sc = rs[rl];
      const int row = m0 + rl, b = row >> 8, mm = row & 255;
#pragma unroll
      for (int ni = 0; ni < 2; ++ni)
#pragma unroll
        for (int q = 0; q < 4; ++q) {
          const int col = n0 + 64 * wn + 32 * ni + 8 * q + 4 * hh;
          const float v0 = acc[mi][ni][4 * q] * sc, v1 = acc[mi][ni][4 * q + 1] * sc, v2 = acc[mi][ni][4 * q + 2] * sc, v3 = acc[mi][ni][4 * q + 3] * sc;
          if (col < 1024) {
            const int head = col >> 8, d = col & 255;
            *(uint2*)(kx + ((size_t)((b * 4 + head) * 256 + mm)) * 256 + d) = make_uint2(pack2(v0, v1), pack2(v2, v3));
          } else {
            const int c2 = col - 1024, head = c2 >> 8, d = c2 & 255;
            u16* vp = vt + ((size_t)((b * 4 + head) * 256 + d)) * 256 + mm;
            vp[0] = f2bf(v0); vp[256] = f2bf(v1); vp[512] = f2bf(v2); vp[768] = f2bf(v3);
          }
        }
    }
    __syncthreads();
  }
}

DI void phase_resid(const u16* A, const u16* Bt, const float* resid_f32, u16* hb, float* ssq, char* smem) {
  const int tid = tidx(), lane = tid & 63, wave = tid >> 6, wm = wave >> 1, wn = wave & 1, hh = lane >> 5;
  float* sq = sq_ptr(smem);
  for (int it = 0;; ++it) {
    int mt, nt;
    if (!tile_map(it, 256, 8, mt, nt)) break;
    const int m0 = mt * 128, n0 = nt * 128;
    f32x16 acc[2][2];
    gemm_main(A, Bt, m0, n0, smem, acc);
    if (tid < 128) sq[tid] = 0.f;
    __syncthreads();
#pragma unroll
    for (int mi = 0; mi < 2; ++mi) {
      const int rl = 64 * wm + 32 * mi + (lane & 31);
      const size_t row = (size_t)(m0 + rl);
      float s2 = 0.f;
#pragma unroll
      for (int ni = 0; ni < 2; ++ni)
#pragma unroll
        for (int q = 0; q < 4; ++q) {
          const int col = n0 + 64 * wn + 32 * ni + 8 * q + 4 * hh;
          float r0, r1, r2, r3;
          if (resid_f32) {
            const float4 r = *(const float4*)(resid_f32 + row * 1024 + col);
            r0 = r.x; r1 = r.y; r2 = r.z; r3 = r.w;
          } else {
            const uint2 r = *(const uint2*)(hb + row * 1024 + col);
            r0 = bflo(r.x); r1 = bfhi(r.x); r2 = bflo(r.y); r3 = bfhi(r.y);
          }
          const float h0 = r0 + acc[mi][ni][4 * q], h1 = r1 + acc[mi][ni][4 * q + 1], h2 = r2 + acc[mi][ni][4 * q + 2], h3 = r3 + acc[mi][ni][4 * q + 3];
          *(uint2*)(hb + row * 1024 + col) = make_uint2(pack2(h0, h1), pack2(h2, h3));
          s2 += h0 * h0 + h1 * h1 + h2 * h2 + h3 * h3;
        }
      atomicAdd(&sq[rl], s2);
    }
    __syncthreads();
    if (tid < 128) ssq[(size_t)(m0 + tid) * 8 + nt] = sq[tid];
    __syncthreads();
  }
}

DI void phase_scaled(const u16* A, const u16* Bt, const float* ssq, u16* out, char* smem) {
  const int tid = tidx(), lane = tid & 63, wave = tid >> 6, wm = wave >> 1, wn = wave & 1, hh = lane >> 5;
  float* rs = rs_ptr(smem);
  for (int it = 0;; ++it) {
    int mt, nt;
    if (!tile_map(it, 256, 8, mt, nt)) break;
    const int m0 = mt * 128, n0 = nt * 128;
    f32x16 acc[2][2];
    gemm_main(A, Bt, m0, n0, smem, acc);
    if (tid < 128) {
      const float4* sp = (const float4*)(ssq + (size_t)(m0 + tid) * 8);
      float4 s0 = sp[0], s1 = sp[1];
      rs[tid] = rsqrtf((s0.x + s0.y + s0.z + s0.w + s1.x + s1.y + s1.z + s1.w) * (1.f / 1024.f) + EPS);
    }
    __syncthreads();
#pragma unroll
    for (int mi = 0; mi < 2; ++mi) {
      const int rl = 64 * wm + 32 * mi + (lane & 31);
      const float sc = rs[rl];
#pragma unroll
      for (int ni = 0; ni < 2; ++ni)
#pragma unroll
        for (int q = 0; q < 4; ++q) {
          const int col = n0 + 64 * wn + 32 * ni + 8 * q + 4 * hh;
          *(uint2*)(out + (size_t)(m0 + rl) * 1024 + col) =
              make_uint2(pack2(acc[mi][ni][4 * q] * sc, acc[mi][ni][4 * q + 1] * sc), pack2(acc[mi][ni][4 * q + 2] * sc, acc[mi][ni][4 * q + 3] * sc));
        }
    }
    __syncthreads();
  }
}

DI void chunk_job(const Params& p, int cj, char* smem) {
  char* ws = p.ws;
  const int tid = tidx(), lane = tid & 63, wave = tid >> 6;
  const int bh = cj >> 7, n = cj & 127, b = bh >> 2, h = bh & 3;
  const int t0 = b * SEQ + n * 64;
  u16* Kb  = (u16*)smem;
  u16* Qb  = (u16*)(smem + 17408);
  u16* Vt  = (u16*)(smem + 34816);
  u16* KGt = (u16*)(smem + 53248);
  float* gc = (float*)(smem + 71680);
  float* bt = gc + 64;
  float* As = (float*)(smem + 17408);
  u16* Tb = (u16*)smem;
  const u16* proj = (const u16*)(ws + OFF_PROJ);
  u16* QD = (u16*)p.out;
  u16* KD = (u16*)((char*)p.out + 32 * MiB);
  u16* UU = (u16*)((char*)p.out + 64 * MiB);
  u16* WW = (u16*)((char*)p.out + 96 * MiB);
  u16* IN = (u16*)(ws + OFF_XB);
  float* GL = (float*)(ws + OFF_GL);

  if (wave == 0) {
    const float* ba = (const float*)(ws + OFF_BA) + (size_t)(t0 + lane) * 8;
    const float bl = ba[h], al = ba[4 + h] + p.dn_dt_bias[h];
    const float sp = fmaxf(al, 0.f) + log1pf(expf(-fabsf(al)));
    float g = -expf(p.dn_a_log[h]) * sp;
#pragma unroll
    for (int o = 1; o < 64; o <<= 1) { float v = __shfl_up(g, o); if (lane >= o) g += v; }
    gc[lane] = g;
    bt[lane] = 1.f / (1.f + expf(-bl));
    if (lane == 63) GL[cj] = expf(g);
  }
  __syncthreads();

  {
    const int cgp = tid & 15, ts = tid >> 4;
    const float glast = gc[63];
    float eg[4], ed[4], be[4];
#pragma unroll
    for (int tt = 0; tt < 4; ++tt) { const float gv = gc[4 * ts + tt]; eg[tt] = expf(gv); ed[tt] = expf(glast - gv); be[tt] = bt[4 * ts + tt]; }
#pragma unroll 1
    for (int part = 0; part < 3; ++part) {
      const int cc = part * 512 + h * 128 + cgp * 8;
      const int cb = 1536 + cc;
      float xin[7][8];
#pragma unroll
      for (int r = 0; r < 7; ++r) {
        const int sp = n * 64 + 4 * ts - 3 + r;
        if (sp >= 0) { uint4 raw = *(const uint4*)(proj + (size_t)(t0 + 4 * ts - 3 + r) * INC + cb); unpack8(raw, xin[r]); }
        else {
#pragma unroll
          for (int c = 0; c < 8; ++c) xin[r][c] = 0.f;
        }
      }
      float o[4][8];
#pragma unroll
      for (int tt = 0; tt < 4; ++tt)
#pragma unroll
        for (int c = 0; c < 8; ++c) o[tt][c] = 0.f;
#pragma unroll
      for (int j = 0; j < 4; ++j) {
        const float4 w0 = *(const float4*)(p.dn_conv_w + j * 1536 + cc), w1 = *(const float4*)(p.dn_conv_w + j * 1536 + cc + 4);
        const float wj[8] = {w0.x, w0.y, w0.z, w0.w, w1.x, w1.y, w1.z, w1.w};
#pragma unroll
        for (int tt = 0; tt < 4; ++tt)
#pragma unroll
          for (int c = 0; c < 8; ++c) o[tt][c] += wj[c] * xin[tt + j][c];
      }
#pragma unroll
      for (int tt = 0; tt < 4; ++tt)
#pragma unroll
        for (int c = 0; c < 8; ++c) o[tt][c] = silu_f(o[tt][c]);
      if (part < 2) {
#pragma unroll
        for (int tt = 0; tt < 4; ++tt) {
          float ss = 0.f;
#pragma unroll
          for (int c = 0; c < 8; ++c) ss += o[tt][c] * o[tt][c];
          ss += __shfl_xor(ss, 1); ss += __shfl_xor(ss, 2); ss += __shfl_xor(ss, 4); ss += __shfl_xor(ss, 8);
          const float rn = rsqrtf(ss + EPS) * (part == 0 ? 0.08838834764831845f : 1.f);
#pragma unroll
          for (int c = 0; c < 8; ++c) o[tt][c] *= rn;
        }
      }
      if (part == 0) {
#pragma unroll
        for (int tt = 0; tt < 4; ++tt) {
          const int tok = 4 * ts + tt;
          *(uint4*)(Qb + tok * 136 + cgp * 8) = pack8(o[tt]);
          float qd[8];
#pragma unroll
          for (int c = 0; c < 8; ++c) qd[c] = o[tt][c] * eg[tt];
          *(uint4*)(QD + ((size_t)cj * 64 + tok) * 128 + cgp * 8) = pack8(qd);
        }
      } else if (part == 1) {
#pragma unroll
        for (int tt = 0; tt < 4; ++tt) *(uint4*)(Kb + (4 * ts + tt) * 136 + cgp * 8) = pack8(o[tt]);
#pragma unroll
        for (int c = 0; c < 8; ++c) {
          const int d = cgp * 8 + c;
          *(uint2*)(KGt + d * 72 + 4 * ts) = make_uint2(pack2(o[0][c] * be[0] * eg[0], o[1][c] * be[1] * eg[1]), pack2(o[2][c] * be[2] * eg[2], o[3][c] * be[3] * eg[3]));
          *(uint2*)(KD + ((size_t)cj * 128 + d) * 64 + 4 * ts) = make_uint2(pack2(o[0][c] * ed[0], o[1][c] * ed[1]), pack2(o[2][c] * ed[2], o[3][c] * ed[3]));
        }
      } else {
#pragma unroll
        for (int c = 0; c < 8; ++c) {
          const int d = cgp * 8 + c;
          *(uint2*)(Vt + d * 72 + 4 * ts) = make_uint2(pack2(o[0][c] * be[0], o[1][c] * be[1]), pack2(o[2][c] * be[2], o[3][c] * be[3]));
        }
      }
    }
  }
  __syncthreads();

  {
    const int wi = wave >> 1, wj = wave & 1, hh = lane >> 5;
    f32x16 aK, aQ;
#pragma unroll
    for (int i = 0; i < 16; ++i) { aK[i] = 0.f; aQ[i] = 0.f; }
    if (wi >= wj) {
#pragma unroll
      for (int ks = 0; ks < 8; ++ks) {
        const bf16x8 fk = *(const bf16x8*)(Kb + (32 * wi + (lane & 31)) * 136 + 16 * ks + 8 * hh);
        const bf16x8 fq = *(const bf16x8*)(Qb + (32 * wi + (lane & 31)) * 136 + 16 * ks + 8 * hh);
        const bf16x8 fb = *(const bf16x8*)(Kb + (32 * wj + (lane & 31)) * 136 + 16 * ks + 8 * hh);
        aK = MFMA32(fk, fb, aK);
        aQ = MFMA32(fq, fb, aQ);
      }
    }
    __syncthreads();
    const int j = 32 * wj + (lane & 31);
    const float gj = gc[j];
#pragma unroll
    for (int ii = 0; ii < 16; ++ii) {
      const int i = 32 * wi + crow32(ii, hh);
      const float dec = (i >= j) ? expf(gc[i] - gj) : 0.f;
      As[i * 68 + j] = (i > j) ? aK[ii] * bt[i] * dec : 0.f;
      IN[((size_t)cj * 64 + i) * 64 + j] = f2bf((i >= j) ? aQ[ii] * dec : 0.f);
    }
  }
  __syncthreads();

  if (wave == 0) {
    float xcol[64];
#pragma unroll
    for (int i = 0; i < 64; ++i) {
      int lv = lane;
      asm volatile("" : "+v"(lv));
      float s = (i == lv) ? 1.f : 0.f;
#pragma unroll
      for (int j4 = 0; j4 < (i + 3) / 4; ++j4) {
        const float4 a4 = *(const float4*)(As + i * 68 + 4 * j4);
        if (4 * j4 + 0 < i) s -= a4.x * xcol[4 * j4 + 0];
        if (4 * j4 + 1 < i) s -= a4.y * xcol[4 * j4 + 1];
        if (4 * j4 + 2 < i) s -= a4.z * xcol[4 * j4 + 2];
        if (4 * j4 + 3 < i) s -= a4.w * xcol[4 * j4 + 3];
      }
      xcol[i] = s;
      asm volatile("" ::: "memory");
    }
#pragma unroll
    for (int i = 0; i < 64; ++i) Tb[i * 72 + lane] = f2bf(xcol[i]);
  }
  __syncthreads();

  {
    const int hh = lane >> 5;
    f32x16 aU[2], aW[2];
#pragma unroll
    for (int mi = 0; mi < 2; ++mi)
#pragma unroll
      for (int i = 0; i < 16; ++i) { aU[mi][i] = 0.f; aW[mi][i] = 0.f; }
#pragma unroll
    for (int ks = 0; ks < 4; ++ks) {
      const bf16x8 bv = *(const bf16x8*)(Vt + (32 * wave + (lane & 31)) * 72 + 16 * ks + 8 * hh);
      const bf16x8 bk = *(const bf16x8*)(KGt + (32 * wave + (lane & 31)) * 72 + 16 * ks + 8 * hh);
#pragma unroll
      for (int mi = 0; mi < 2; ++mi) {
        const bf16x8 a = *(const bf16x8*)(Tb + (32 * mi + (lane & 31)) * 72 + 16 * ks + 8 * hh);
        aU[mi] = MFMA32(a, bv, aU[mi]);
        aW[mi] = MFMA32(a, bk, aW[mi]);
      }
    }
    const int d = 32 * wave + (lane & 31);
#pragma unroll
    for (int mi = 0; mi < 2; ++mi)
#pragma unroll
      for (int ii = 0; ii < 16; ++ii) {
        const int i = 32 * mi + crow32(ii, hh);
        UU[((size_t)cj * 64 + i) * 128 + d] = f2bf(aU[mi][ii]);
        WW[((size_t)cj * 64 + i) * 128 + d] = f2bf(aW[mi][ii]);
      }
  }
  __syncthreads();
}

DI void conv_items(const Params& p, int bid, int nb) {
  char* ws = p.ws;
  const u16* proj = (const u16*)(ws + OFF_PROJ);
  u16* ymix = (u16*)(ws + OFF_YMIX);
  for (int item = bid * 256 + tidx(); item < T_TOK * 64; item += nb * 256) {
    const int t = item >> 6, c0 = (item & 63) * 8;
    const int s = t & (SEQ - 1);
    float accv[8];
#pragma unroll
    for (int c = 0; c < 8; ++c) accv[c] = 0.f;
#pragma unroll
    for (int k = 0; k < 3; ++k) {
      if (s - 2 + k >= 0) {
        const size_t row = (size_t)(t - 2 + k) * INC;
        float cg8[8], hc8[8];
        unpack8(*(const uint4*)(proj + row + 512 + c0), cg8);
        unpack8(*(const uint4*)(proj + row + 1024 + c0), hc8);
        const float4 w0 = *(const float4*)(p.conv_w + k * 512 + c0), w1 = *(const float4*)(p.conv_w + k * 512 + c0 + 4);
        const float wk[8] = {w0.x, w0.y, w0.z, w0.w, w1.x, w1.y, w1.z, w1.w};
#pragma unroll
        for (int c = 0; c < 8; ++c) accv[c] += wk[c] * cg8[c] * hc8[c];
      }
    }
    float bg[8];
    unpack8(*(const uint4*)(proj + (size_t)t * INC + c0), bg);
#pragma unroll
    for (int c = 0; c < 8; ++c) accv[c] *= bg[c];
    *(uint4*)(ymix + (size_t)t * 1024 + c0) = pack8(accv);
  }
}

DI void phase_chunks(const Params& p, char* smem) {
  char* ws = p.ws;
  for (int cj = blockIdx.x; cj < 2048; cj += gridDim.x) chunk_job(p, cj, smem);
  if (gridDim.x < 256) conv_items(p, blockIdx.x, gridDim.x);
}

struct ScanFrag {
  bf16x8 wf[4], qf[4], inf[2], kf[2][2];
  float uf[4];
  float gl;
};

DI void phase_scan(const Params& p, char* smem) {
  char* ws = p.ws;
  if (blockIdx.x >= 128) {
    if (gridDim.x >= 256) {
      const int bid = blockIdx.x - 128, nb = gridDim.x - 128;
      conv_items(p, bid, nb);
      kv_gemm(p, smem, bid, nb);
      weight_transposes(p, smem, 0x36u, bid, nb);
      keys_convert(p, bid, nb);
      rowconv8(p.expert_u, (unsigned char*)(ws + OFF_EU), p.norm_ffn, EU_SCALE, 16384, bid, nb);
      rowconv8(p.expert_v, (unsigned char*)(ws + OFF_EV), nullptr, EV_SCALE, 16384, bid, nb);
    }
    return;
  }
  const int tid = tidx(), lane = tid & 63, w = tid >> 6, m = lane & 15, g = lane >> 4;
  const int bid = blockIdx.x;
  const int bh = (bid & 7) + 8 * ((bid >> 3) & 1), sl = bid >> 4;
  const int b = bh >> 2, h = bh & 3, e0 = sl * 16;
  u16* ST = (u16*)smem;
  u16* VT = (u16*)(smem + 4352);
  const u16* QD = (const u16*)p.out;
  const u16* KD = (const u16*)((const char*)p.out + 32 * MiB);
  const u16* UU = (const u16*)((const char*)p.out + 64 * MiB);
  const u16* WW = (const u16*)((const char*)p.out + 96 * MiB);
  const u16* IN = (const u16*)(ws + OFF_XB);
  const float* GL = (const float*)(ws + OFF_GL);
  u16* ymix = (u16*)(ws + OFF_YMIX);

  for (int i = tid; i < 16 * 136 / 2; i += 256) ((uint32_t*)ST)[i] = 0u;
  f32x4 Sacc[2];
#pragma unroll
  for (int mt = 0; mt < 2; ++mt)
#pragma unroll
    for (int j = 0; j < 4; ++j) Sacc[mt][j] = 0.f;

  auto load = [&](int c, ScanFrag& f) {
    const u16* wp = WW + ((size_t)c * 64 + 16 * w + m) * 128 + 8 * g;
    const u16* qp = QD + ((size_t)c * 64 + 16 * w + m) * 128 + 8 * g;
#pragma unroll
    for (int ks = 0; ks < 4; ++ks) { f.wf[ks] = *(const bf16x8*)(wp + 32 * ks); f.qf[ks] = *(const bf16x8*)(qp + 32 * ks); }
    const u16* ip = IN + ((size_t)c * 64 + 16 * w + m) * 64 + 8 * g;
#pragma unroll
    for (int ks = 0; ks < 2; ++ks) f.inf[ks] = *(const bf16x8*)(ip + 32 * ks);
#pragma unroll
    for (int mt = 0; mt < 2; ++mt)
#pragma unroll
      for (int ks = 0; ks < 2; ++ks) f.kf[mt][ks] = *(const bf16x8*)(KD + ((size_t)c * 128 + 32 * w + 16 * mt + m) * 64 + 32 * ks + 8 * g);
#pragma unroll
    for (int j = 0; j < 4; ++j) f.uf[j] = bf2f(UU[((size_t)c * 64 + 16 * w + 4 * g + j) * 128 + e0 + m]);
    f.gl = GL[c];
  };

  const int c0 = bh * 128;
  const int t0 = b * SEQ;
  ScanFrag cur, nxt;
  load(c0, cur);
  nxt = cur;
  __syncthreads();
  for (int n = 0; n < 128; ++n) {
    if (n + 1 < 128) load(c0 + n + 1, nxt);
    f32x4 av = {0.f, 0.f, 0.f, 0.f}, aq = {0.f, 0.f, 0.f, 0.f};
#pragma unroll
    for (int ks = 0; ks < 4; ++ks) {
      const bf16x8 sf = *(const bf16x8*)(ST + m * 136 + 32 * ks + 8 * g);
      av = MFMA16(cur.wf[ks], sf, av);
      aq = MFMA16(cur.qf[ks], sf, aq);
    }
    float vn[4];
#pragma unroll
    for (int j = 0; j < 4; ++j) vn[j] = cur.uf[j] - av[j];
    *(uint2*)(VT + m * 72 + 16 * w + 4 * g) = make_uint2(pack2(vn[0], vn[1]), pack2(vn[2], vn[3]));
    __syncthreads();
    bf16x8 vf[2];
#pragma unroll
    for (int ks = 0; ks < 2; ++ks) vf[ks] = *(const bf16x8*)(VT + m * 72 + 32 * ks + 8 * g);
#pragma unroll
    for (int ks = 0; ks < 2; ++ks) aq = MFMA16(cur.inf[ks], vf[ks], aq);
#pragma unroll
    for (int j = 0; j < 4; ++j)
      ymix[(size_t)(t0 + n * 64 + 16 * w + 4 * g + j) * 1024 + 512 + h * 128 + e0 + m] = f2bf(aq[j]);
#pragma unroll
    for (int mt = 0; mt < 2; ++mt) {
#pragma unroll
      for (int j = 0; j < 4; ++j) Sacc[mt][j] *= cur.gl;
#pragma unroll
      for (int ks = 0; ks < 2; ++ks) Sacc[mt] = MFMA16(cur.kf[mt][ks], vf[ks], Sacc[mt]);
      *(uint2*)(ST + m * 136 + 32 * w + 16 * mt + 4 * g) = make_uint2(pack2(Sacc[mt][0], Sacc[mt][1]), pack2(Sacc[mt][2], Sacc[mt][3]));
    }
    __syncthreads();
    cur = nxt;
  }
}

DI void phase_gate(const Params& p) {
  char* ws = p.ws;
  const u16* proj = (const u16*)(ws + OFF_PROJ);
  u16* ymix = (u16*)(ws + OFF_YMIX);
  for (int item = blockIdx.x * 256 + tidx(); item < T_TOK * 64; item += gridDim.x * 256) {
    const int t = item >> 6, hh = (item >> 4) & 3, part = item & 15;
    u16* op = ymix + (size_t)t * 1024 + 512 + hh * 128 + part * 8;
    float o[8], z[8];
    unpack8(*(const uint4*)op, o);
    unpack8(*(const uint4*)(proj + (size_t)t * INC + 3072 + hh * 128 + part * 8), z);
    float ss = 0.f;
#pragma unroll
    for (int c = 0; c < 8; ++c) ss += o[c] * o[c];
    ss += __shfl_xor(ss, 1); ss += __shfl_xor(ss, 2); ss += __shfl_xor(ss, 4); ss += __shfl_xor(ss, 8);
    const float rn = rsqrtf(ss * (1.f / 128.f) + EPS);
    const float4 g0 = *(const float4*)(p.dn_norm + part * 8), g1 = *(const float4*)(p.dn_norm + part * 8 + 4);
    const float gg[8] = {g0.x, g0.y, g0.z, g0.w, g1.x, g1.y, g1.z, g1.w};
#pragma unroll
    for (int c = 0; c < 8; ++c) o[c] = o[c] * rn * gg[c] * silu_f(z[c]);
    *(uint4*)op = pack8(o);
  }
}

DI void phase_attn(const Params& p, char* smem) {
  char* ws = p.ws;
  const int tid = tidx(), lane = tid & 63, wave = tid >> 6, m = lane & 15, g = lane >> 4;
  const u16* QX = (const u16*)(ws + OFF_QX);
  const u16* KX = (const u16*)(ws + OFF_KX);
  const u16* VTp = (const u16*)(ws + OFF_VT);
  u16* OX = (u16*)(ws + OFF_OX);
  u16* Kc = (u16*)smem;
  u16* Vc = (u16*)(smem + 34816);
  for (int job = blockIdx.x; job < 2048; job += gridDim.x) {
    const int head = job & 3, qt = (job >> 2) & 127, b = job >> 9;
    const size_t qrow = (size_t)b * SEQ + qt * 64 + wave * 16;
    bf16x8 qf[8];
#pragma unroll
    for (int ks = 0; ks < 8; ++ks) qf[ks] = *(const bf16x8*)(QX + (qrow + m) * 1024 + head * 256 + 32 * ks + 8 * g);
    const u16* kb = KX + (size_t)(b * 4 + head) * 65536;
    const u16* vb = VTp + (size_t)(b * 4 + head) * 65536;
    const u16* ksrc = kb + (size_t)(tid >> 5) * 256 + (tid & 31) * 8;
    const u16* vsrc = vb + (size_t)(tid >> 3) * 256 + (tid & 7) * 8;
    u16* kdst = Kc + (tid >> 5) * 264 + (tid & 31) * 8;
    u16* vdst = Vc + (tid >> 3) * 72 + (tid & 7) * 8;

    u32x4 st[8];
#define ATT_ISSUE_K(c_) { _Pragma("unroll") for (int i = 0; i < 8; ++i) gload16(st[i], ksrc + (size_t)((c_) * 64 + i * 8) * 256); }
#define ATT_ISSUE_V(c_) { _Pragma("unroll") for (int i = 0; i < 8; ++i) gload16(st[i], vsrc + (size_t)(i * 32) * 256 + (c_) * 64); }
#define ATT_LAND_K() { gwait8_all(st[0], st[1], st[2], st[3], st[4], st[5], st[6], st[7]); \
                       _Pragma("unroll") for (int i = 0; i < 8; ++i) *(u32x4*)(kdst + i * 8 * 264) = st[i]; }
#define ATT_LAND_V() { gwait8_all(st[0], st[1], st[2], st[3], st[4], st[5], st[6], st[7]); \
                       _Pragma("unroll") for (int i = 0; i < 8; ++i) *(u32x4*)(vdst + i * 32 * 72) = st[i]; }
    f32x4 s[16];
#pragma unroll
    for (int mt = 0; mt < 16; ++mt) s[mt] = {0.f, 0.f, 0.f, 0.f};
    ATT_ISSUE_K(0)
#pragma unroll
    for (int kc = 0; kc < 4; ++kc) {
      ATT_LAND_K()
      if (kc < 3) ATT_ISSUE_K(kc + 1) else ATT_ISSUE_V(0)
      __syncthreads();
      const u16* kbase = Kc + m * 264 + 8 * g;
      asm volatile("" : "+v"(kbase));
#pragma unroll
      for (int mt2 = 0; mt2 < 4; ++mt2)
#pragma unroll
        for (int ks = 0; ks < 8; ++ks) {
          const bf16x8 a = *(const bf16x8*)(kbase + 16 * mt2 * 264 + 32 * ks);
          s[kc * 4 + mt2] = MFMA16(a, qf[ks], s[kc * 4 + mt2]);
          if (ks == 7) asm volatile("" ::: "memory");
        }
      __syncthreads();
    }
    float mx = -1e30f;
#pragma unroll
    for (int mt = 0; mt < 16; ++mt)
#pragma unroll
      for (int j = 0; j < 4; ++j) { s[mt][j] *= 0.0625f; mx = fmaxf(mx, s[mt][j]); }
    mx = fmaxf(mx, __shfl_xor(mx, 16)); mx = fmaxf(mx, __shfl_xor(mx, 32));
    float sum = 0.f;
#pragma unroll
    for (int mt = 0; mt < 16; ++mt)
#pragma unroll
      for (int j = 0; j < 4; ++j) { s[mt][j] = __expf(s[mt][j] - mx); sum += s[mt][j]; }
    sum += __shfl_xor(sum, 16); sum += __shfl_xor(sum, 32);
    const float inv = 1.f / sum;
    bf16x8 pf[8];
#pragma unroll
    for (int k2 = 0; k2 < 8; ++k2) {
      uint4 u = make_uint4(pack2(s[2 * k2][0], s[2 * k2][1]), pack2(s[2 * k2][2], s[2 * k2][3]),
                           pack2(s[2 * k2 + 1][0], s[2 * k2 + 1][1]), pack2(s[2 * k2 + 1][2], s[2 * k2 + 1][3]));
      pf[k2] = __builtin_bit_cast(bf16x8, u);
    }
    float invr[4];
#pragma unroll
    for (int j = 0; j < 4; ++j) invr[j] = __shfl(inv, 4 * g + j);
    f32x4 o[16];
#pragma unroll
    for (int nt = 0; nt < 16; ++nt) o[nt] = {0.f, 0.f, 0.f, 0.f};
#pragma unroll
    for (int vc = 0; vc < 4; ++vc) {
      ATT_LAND_V()
      if (vc < 3) ATT_ISSUE_V(vc + 1)
      __syncthreads();
      const u16* vbase = Vc + m * 72 + 4 * g;
      asm volatile("" : "+v"(vbase));
#pragma unroll
      for (int nt = 0; nt < 16; ++nt) {
#pragma unroll
        for (int k2l = 0; k2l < 2; ++k2l) {
          const uint2 lo = *(const uint2*)(vbase + 16 * nt * 72 + 32 * k2l);
          const uint2 hi = *(const uint2*)(vbase + 16 * nt * 72 + 32 * k2l + 16);
          const uint4 u = make_uint4(lo.x, lo.y, hi.x, hi.y);
          o[nt] = MFMA16(pf[2 * vc + k2l], __builtin_bit_cast(bf16x8, u), o[nt]);
        }
        if ((nt & 3) == 3) asm volatile("" ::: "memory");
      }
      __syncthreads();
    }
#undef ATT_ISSUE_K
#undef ATT_ISSUE_V
#undef ATT_LAND_K
#undef ATT_LAND_V
#pragma unroll
    for (int j = 0; j < 4; ++j) {
      u16* ob = OX + (qrow + 4 * g + j) * 1024 + head * 256 + m;
      asm volatile("" : "+v"(ob));
#pragma unroll
      for (int nt = 0; nt < 16; ++nt) ob[16 * nt] = f2bf(o[nt][j] * invr[j]);
    }
  }
}

DI uint32_t ordf(float f) { uint32_t u = __float_as_uint(f); return u ^ ((uint32_t)((int32_t)u >> 31) | 0x80000000u); }
DI float unordf(uint32_t k) { return __uint_as_float(k ^ ((~(uint32_t)((int32_t)k >> 31)) | 0x80000000u)); }
DI void ins32(uint32_t (&top)[16], uint32_t x) {
#pragma unroll
  for (int i = 0; i < 16; ++i) { const uint32_t hi = max(top[i], x); x = min(top[i], x); top[i] = hi; }
}
DI void ins64(uint32_t (&tk)[16], uint32_t (&tv)[16], uint32_t xk, uint32_t xv) {
#pragma unroll
  for (int i = 0; i < 16; ++i) {
    const bool gt = xk > tk[i];
    const uint32_t nk = gt ? xk : tk[i], nv = gt ? xv : tv[i];
    xk = gt ? tk[i] : xk; xv = gt ? tv[i] : xv;
    tk[i] = nk; tv[i] = nv;
  }
}

DI void sort16_desc(uint32_t (&v)[16]) {
#pragma unroll
  for (int k = 2; k <= 16; k <<= 1)
#pragma unroll
    for (int j = k >> 1; j > 0; j >>= 1)
#pragma unroll
      for (int i = 0; i < 16; ++i) {
        const int l = i ^ j;
        if (l > i) {
          const uint32_t hi = max(v[i], v[l]), lo = min(v[i], v[l]);
          if ((i & k) == 0) { v[i] = hi; v[l] = lo; } else { v[i] = lo; v[l] = hi; }
        }
      }
}
DI void merge16_desc(uint32_t (&a)[16], const uint32_t (&b)[16]) {
#pragma unroll
  for (int i = 0; i < 16; ++i) a[i] = max(a[i], b[15 - i]);
#pragma unroll
  for (int st = 8; st >= 1; st >>= 1)
#pragma unroll
    for (int i = 0; i < 16; ++i)
      if ((i & st) == 0) { const uint32_t hi = max(a[i], a[i + st]), lo = min(a[i], a[i + st]); a[i] = hi; a[i + st] = lo; }
}

__device__ constexpr int PAIR_I[50] = {0,0,0,0,0,0,0,0,0,0,0,0,0,0,0,0,1,1,1,1,1,1,1,1,2,2,2,2,2,3,3,3,3,4,4,4,5,5,6,6,7,7,8,9,10,11,12,13,14,15};
__device__ constexpr int PAIR_J[50] = {0,1,2,3,4,5,6,7,8,9,10,11,12,13,14,15,0,1,2,3,4,5,6,7,0,1,2,3,4,0,1,2,3,0,1,2,0,1,0,1,0,1,0,0,0,0,0,0,0,0};

DI void topk_block(const u16* qrow0, int qstride, int hd, size_t tok0, const u16* KEYS, int* SELI, float* SELG) {
  const int lane = tidx() & 63, l31 = lane & 31, hh = lane >> 5;
  const uint32_t hh4 = (uint32_t)hh << 2;
  {
    const size_t tok = tok0 + l31;
    uint32_t top[2][16];
#pragma unroll
    for (int pp = 0; pp < 2; ++pp) {
      bf16x8 qf[4];
#pragma unroll
      for (int ks = 0; ks < 4; ++ks) qf[ks] = *(const bf16x8*)(qrow0 + (size_t)l31 * qstride + pp * 64 + 16 * ks + 8 * hh);
      f32x16 acc[4];
#pragma unroll
      for (int mt = 0; mt < 4; ++mt) {
#pragma unroll
        for (int i = 0; i < 16; ++i) acc[mt][i] = 0.f;
#pragma unroll
        for (int ks = 0; ks < 4; ++ks) {
          const bf16x8 a = *(const bf16x8*)(KEYS + (size_t)((hd * 2 + pp) * 128 + 32 * mt + l31) * 64 + 16 * ks + 8 * hh);
          acc[mt] = MFMA32(a, qf[ks], acc[mt]);
        }
      }
      uint32_t lst[4][16];
#pragma unroll
      for (int mt = 0; mt < 4; ++mt) {
#pragma unroll
        for (int i = 0; i < 16; ++i) {
          const uint32_t kc = (uint32_t)(127 - (32 * mt + (i & 3) + 8 * (i >> 2)));
          lst[mt][i] = ((ordf(acc[mt][i]) & 0xFFFFFF80u) | kc) ^ hh4;
        }
        sort16_desc(lst[mt]);
      }
      merge16_desc(lst[0], lst[1]);
      merge16_desc(lst[2], lst[3]);
      merge16_desc(lst[0], lst[2]);
#pragma unroll
      for (int i = 0; i < 16; ++i) top[pp][i] = lst[0][i];
      uint32_t c[16];
#pragma unroll
      for (int i = 0; i < 16; ++i) c[i] = max(top[pp][i], (uint32_t)__shfl_xor((int)top[pp][15 - i], 32));
#pragma unroll
      for (int st = 8; st >= 1; st >>= 1)
#pragma unroll
        for (int i = 0; i < 16; ++i)
          if ((i & st) == 0) { const uint32_t hi = max(c[i], c[i + st]), lo = min(c[i], c[i + st]); c[i] = hi; c[i + st] = lo; }
#pragma unroll
      for (int i = 0; i < 16; ++i) top[pp][i] = c[i];
    }
    uint32_t tk[16], tv[16];
#pragma unroll
    for (int i = 0; i < 16; ++i) { tk[i] = 0u; tv[i] = 0u; }
#pragma unroll
    for (int q = 0; q < 25; ++q) {
      const int ia = PAIR_I[2 * q], ja = PAIR_J[2 * q], ib = PAIR_I[2 * q + 1], jb = PAIR_J[2 * q + 1];
      const uint32_t k1 = hh ? top[0][ib] : top[0][ia];
      const uint32_t k2 = hh ? top[1][jb] : top[1][ja];
      const float xs = unordf(k1 & 0xFFFFFF80u) + unordf(k2 & 0xFFFFFF80u);
      const uint32_t xv = (127u - (k1 & 127u)) * 128u + (127u - (k2 & 127u));
      ins64(tk, tv, ordf(xs), xv);
    }
    {
      uint32_t ck[16], cv[16];
#pragma unroll
      for (int i = 0; i < 16; ++i) {
        const uint32_t ok = (uint32_t)__shfl_xor((int)tk[15 - i], 32), ov = (uint32_t)__shfl_xor((int)tv[15 - i], 32);
        const bool gt = ok > tk[i];
        ck[i] = gt ? ok : tk[i]; cv[i] = gt ? ov : tv[i];
      }
#pragma unroll
      for (int i = 0; i < 16; ++i) { tk[i] = ck[i]; tv[i] = cv[i]; }
    }
    float e[16], sum = 0.f;
    uint32_t mk = tk[0];
#pragma unroll
    for (int i = 1; i < 16; ++i) mk = max(mk, tk[i]);
    const float mx = unordf(mk);
#pragma unroll
    for (int i = 0; i < 16; ++i) { e[i] = __expf(unordf(tk[i]) - mx); sum += e[i]; }
    const float inv = 1.f / sum;
    int* ip = SELI + (tok * 8 + hd) * 16;
    float* gp = SELG + (tok * 8 + hd) * 16;
    if (hh == 0) {
      *(uint4*)ip = make_uint4(tv[0], tv[1], tv[2], tv[3]);
      *(uint4*)(ip + 4) = make_uint4(tv[4], tv[5], tv[6], tv[7]);
      *(uint4*)(ip + 8) = make_uint4(tv[8], tv[9], tv[10], tv[11]);
      *(uint4*)(ip + 12) = make_uint4(tv[12], tv[13], tv[14], tv[15]);
      *(float4*)gp = make_float4(e[0] * inv, e[1] * inv, e[2] * inv, e[3] * inv);
      *(float4*)(gp + 4) = make_float4(e[4] * inv, e[5] * inv, e[6] * inv, e[7] * inv);
      *(float4*)(gp + 8) = make_float4(e[8] * inv, e[9] * inv, e[10] * inv, e[11] * inv);
      *(float4*)(gp + 12) = make_float4(e[12] * inv, e[13] * inv, e[14] * inv, e[15] * inv);
    }
  }
}

DI void phase_pq_topk(const Params& p, char* smem) {
  char* ws = p.ws;
  const int tid = tidx(), lane = tid & 63, wave = tid >> 6, wm = wave >> 1, wn = wave & 1, hh = lane >> 5;
  float* rs = rs_ptr(smem);
  const float* ssq = (const float*)(ws + OFF_SSQ2);
  u16* Qs = (u16*)smem;
  for (int it = 0;; ++it) {
    int mt, nt;
    if (!tile_map(it, 256, 8, mt, nt)) break;
    const int m0 = mt * 128, n0 = nt * 128;
    f32x16 acc[2][2];
    gemm_main((const u16*)(ws + OFF_XB), (const u16*)(ws + OFF_WPQ), m0, n0, smem, acc);
    if (tid < 128) {
      const float4* sp = (const float4*)(ssq + (size_t)(m0 + tid) * 8);
      float4 s0 = sp[0], s1 = sp[1];
      rs[tid] = rsqrtf((s0.x + s0.y + s0.z + s0.w + s1.x + s1.y + s1.z + s1.w) * (1.f / 1024.f) + EPS);
    }
    __syncthreads();
#pragma unroll
    for (int mi = 0; mi < 2; ++mi) {
      const int rl = 64 * wm + 32 * mi + (lane & 31);
      const float sc = rs[rl];
#pragma unroll
      for (int ni = 0; ni < 2; ++ni)
#pragma unroll
        for (int q = 0; q < 4; ++q) {
          const int col = 64 * wn + 32 * ni + 8 * q + 4 * hh;
          *(uint2*)(Qs + rl * 136 + col) =
              make_uint2(pack2(acc[mi][ni][4 * q] * sc, acc[mi][ni][4 * q + 1] * sc), pack2(acc[mi][ni][4 * q + 2] * sc, acc[mi][ni][4 * q + 3] * sc));
        }
    }
    __syncthreads();
    topk_block(Qs + 32 * wave * 136, 136, nt, (size_t)m0 + 32 * wave, (const u16*)(ws + OFF_KEYS), (int*)(ws + OFF_SELI), (float*)(ws + OFF_SELG));
    __syncthreads();
  }
}

DI bf16x8 fp8x8_to_bf16(uint32_t d0, uint32_t d1) {
  const bf16x2v c0 = __builtin_amdgcn_cvt_scalef32_pk_bf16_fp8((int)d0, 1.0f, false);
  const bf16x2v c1 = __builtin_amdgcn_cvt_scalef32_pk_bf16_fp8((int)d0, 1.0f, true);
  const bf16x2v c2 = __builtin_amdgcn_cvt_scalef32_pk_bf16_fp8((int)d1, 1.0f, false);
  const bf16x2v c3 = __builtin_amdgcn_cvt_scalef32_pk_bf16_fp8((int)d1, 1.0f, true);
  const uint4 u = make_uint4(__builtin_bit_cast(uint32_t, c0), __builtin_bit_cast(uint32_t, c1), __builtin_bit_cast(uint32_t, c2), __builtin_bit_cast(uint32_t, c3));
  return __builtin_bit_cast(bf16x8, u);
}

DI void phase_peer(const Params& p, char* smem, float* dst) {
  char* ws = p.ws;
  const int tid = tidx(), lane = tid & 63, wave = tid >> 6, m = lane & 15, g = lane >> 4;
  const u16* HB = (const u16*)(ws + OFF_XB);
  const unsigned char* EU = (const unsigned char*)(ws + OFF_EU);
  const unsigned char* EV = (const unsigned char*)(ws + OFF_EV);
  const int* SELI = (const int*)(ws + OFF_SELI);
  const float* SELG = (const float*)(ws + OFF_SELG);
  const float* SSQ = (const float*)(ws + OFF_SSQ2);
  float* coef = (float*)(smem + wave * 1024);
  int* idxs = (int*)(smem + wave * 1024 + 512);
  for (int tile = blockIdx.x; tile < T_TOK / 4; tile += gridDim.x) {
    const size_t t = (size_t)tile * 4 + wave;
    const float4 q0 = *(const float4*)(SSQ + t * 8), q1 = *(const float4*)(SSQ + t * 8 + 4);
    const float rstd = rsqrtf((q0.x + q0.y + q0.z + q0.w + q1.x + q1.y + q1.z + q1.w) * (1.f / 1024.f) + EPS) * (1.f / EU_SCALE);
    int myidx[8];
#pragma unroll
    for (int grp = 0; grp < 8; ++grp) myidx[grp] = SELI[t * 128 + grp * 16 + m];
    f32x4 acc[8];
#pragma unroll
    for (int grp = 0; grp < 8; ++grp) acc[grp] = {0.f, 0.f, 0.f, 0.f};
    for (int kb2 = 0; kb2 < 8; ++kb2) {
      bf16x8 xf[4];
#pragma unroll
      for (int j = 0; j < 4; ++j) xf[j] = *(const bf16x8*)(HB + t * 1024 + kb2 * 128 + g * 32 + 8 * j);
      uint4 raw0[8], raw1[8];
#pragma unroll
      for (int grp = 0; grp < 8; ++grp) {
        const unsigned char* up = EU + (size_t)myidx[grp] * 1024 + kb2 * 128 + g * 32;
        raw0[grp] = *(const uint4*)up;
        raw1[grp] = *(const uint4*)(up + 16);
      }
#pragma unroll
      for (int grp = 0; grp < 8; ++grp) {
        acc[grp] = MFMA16(fp8x8_to_bf16(raw0[grp].x, raw0[grp].y), xf[0], acc[grp]);
        acc[grp] = MFMA16(fp8x8_to_bf16(raw0[grp].z, raw0[grp].w), xf[1], acc[grp]);
        acc[grp] = MFMA16(fp8x8_to_bf16(raw1[grp].x, raw1[grp].y), xf[2], acc[grp]);
        acc[grp] = MFMA16(fp8x8_to_bf16(raw1[grp].z, raw1[grp].w), xf[3], acc[grp]);
      }
    }
    if (g == 0) {
#pragma unroll
      for (int grp = 0; grp < 8; ++grp) idxs[grp * 16 + m] = myidx[grp];
    }
    if (m == 0) {
#pragma unroll
      for (int grp = 0; grp < 8; ++grp)
#pragma unroll
        for (int j = 0; j < 4; ++j) {
          const int e = grp * 16 + 4 * g + j;
          const float a = acc[grp][j] * rstd;
          const float ge = 0.5f * a * (1.f + erff(a * 0.7071067811865475f));
          coef[e] = SELG[t * 128 + e] * ge * (1.f / EV_SCALE);
        }
    }
    __syncthreads();
    f32x2 y[8];
#pragma unroll
    for (int i = 0; i < 8; ++i) y[i] = {0.f, 0.f};
#pragma unroll 8
    for (int e = 0; e < 128; ++e) {
      const float c = coef[e];
      const f32x2 c2 = {c, c};
      const uint4 r = *(const uint4*)(EV + (size_t)idxs[e] * 1024 + lane * 16);
      y[0] += c2 * __builtin_amdgcn_cvt_pk_f32_fp8((int)r.x, false);
      y[1] += c2 * __builtin_amdgcn_cvt_pk_f32_fp8((int)r.x, true);
      y[2] += c2 * __builtin_amdgcn_cvt_pk_f32_fp8((int)r.y, false);
      y[3] += c2 * __builtin_amdgcn_cvt_pk_f32_fp8((int)r.y, true);
      y[4] += c2 * __builtin_amdgcn_cvt_pk_f32_fp8((int)r.z, false);
      y[5] += c2 * __builtin_amdgcn_cvt_pk_f32_fp8((int)r.z, true);
      y[6] += c2 * __builtin_amdgcn_cvt_pk_f32_fp8((int)r.w, false);
      y[7] += c2 * __builtin_amdgcn_cvt_pk_f32_fp8((int)r.w, true);
    }
    float* dp = dst + t * 1024 + lane * 16;
    float hv[16];
    unpack8(*(const uint4*)(HB + t * 1024 + lane * 16), hv);
    unpack8(*(const uint4*)(HB + t * 1024 + lane * 16 + 8), hv + 8);
    float ss = 0.f;
#pragma unroll
    for (int i = 0; i < 8; ++i) { hv[2 * i] += y[i][0]; hv[2 * i + 1] += y[i][1]; }
#pragma unroll
    for (int i = 0; i < 16; ++i) ss += hv[i] * hv[i];
    ss = wave_sum(ss);
    const float rn = rsqrtf(ss * (1.f / 1024.f) + EPS);
#pragma unroll
    for (int q = 0; q < 4; ++q) {
      const float4 n4 = *(const float4*)(p.norm_final + lane * 16 + 4 * q);
      *(float4*)(dp + 4 * q) = make_float4(hv[4 * q] * rn * n4.x, hv[4 * q + 1] * rn * n4.y, hv[4 * q + 2] * rn * n4.z, hv[4 * q + 3] * rn * n4.w);
    }
    __syncthreads();
  }
}

#define XB_TMO      128
#define XB_XCNT(j)  (256  + 64 * (j))
#define XB_XSUB(j)  (1280 + 64 * (j))
#define XB_XGEN(j)  (2304 + 64 * (j))
#define XB_TOP      3328
#define XB_TOPGEN   3392
#define XCD_BAR_WORDS 3456
#define XB_SPIN_CAP (1u << 22)
#define LAS __attribute__((address_space(3)))
DI unsigned xb_ld(unsigned* p)              { return __hip_atomic_load(p, __ATOMIC_RELAXED, __HIP_MEMORY_SCOPE_AGENT); }
DI unsigned xb_add(unsigned* p, unsigned v) { return __hip_atomic_fetch_add(p, v, __ATOMIC_RELAXED, __HIP_MEMORY_SCOPE_AGENT); }
DI unsigned xb_xcc_id() { return (unsigned)__builtin_amdgcn_s_getreg((3 << 11) | 20) & 0xFu; }
#define XB_SPIN(cond, bar) do { unsigned _sp = 0; while (cond) { __builtin_amdgcn_s_sleep(1); \
    if ((++_sp & 255u) == 0u) { if (xb_ld(&(bar)[XB_TMO])) break; if (_sp > XB_SPIN_CAP) { atomicAdd(&(bar)[XB_TMO], 1u); break; } } } } while (0)
struct XcdBarrier { unsigned* bar; unsigned x; volatile LAS unsigned* st; };
DI XcdBarrier xcd_barrier_post(unsigned* bar, volatile LAS unsigned* st) {
  XcdBarrier b; b.bar = bar; b.x = xb_xcc_id(); b.st = st;
  if (__builtin_amdgcn_workitem_id_x() == 0) (void)xb_add(&bar[XB_XCNT(b.x)], 1u);
  return b;
}
DI void xcd_barrier_complete(unsigned* bar, unsigned x, unsigned& nloc, unsigned& nx) {
  const unsigned G = gridDim.x * gridDim.y * gridDim.z;
  unsigned sum, cnt, mine, sp = 0u;
  for (;;) {
    sum = 0u; cnt = 0u; mine = 0u;
#pragma unroll
    for (unsigned j = 0; j < 16; ++j) { const unsigned c = xb_ld(&bar[XB_XCNT(j)]); sum += c; cnt += (c > 0u) ? 1u : 0u; mine = (j == x) ? c : mine; }
    if (sum == G) break;
    __builtin_amdgcn_s_sleep(1);
    if ((++sp & 255u) == 0u) { if (xb_ld(&bar[XB_TMO])) break; if (sp > XB_SPIN_CAP) { atomicAdd(&bar[XB_TMO], 1u); break; } }
  }
  nloc = mine > 0u ? mine : 1u; nx = cnt > 0u ? cnt : 1u;
}
DI void xcd_barrier(const XcdBarrier& b) {
  asm volatile("s_waitcnt vmcnt(0)" ::: "memory");
  __syncthreads();
  if (__builtin_amdgcn_workitem_id_x() == 0) {
    unsigned* bar = b.bar;
    __builtin_amdgcn_s_waitcnt(0);
    unsigned nloc = b.st[0], nx = b.st[1];
    if (nloc == 0u) { xcd_barrier_complete(bar, b.x, nloc, nx); b.st[0] = nloc; b.st[1] = nx; }
    const unsigned old = xb_add(&bar[XB_XSUB(b.x)], 1u);
    const unsigned gen = old / nloc;
    if (old + 1u == (gen + 1u) * nloc) {
      __builtin_amdgcn_fence(__ATOMIC_RELEASE, "agent");
      asm volatile("s_waitcnt vmcnt(0)" ::: "memory");
      const unsigned og = xb_add(&bar[XB_TOP], 1u);
      const unsigned tg = og / nx;
      if (og + 1u == (tg + 1u) * nx) xb_add(&bar[XB_TOPGEN], 1u);
      else XB_SPIN(xb_ld(&bar[XB_TOPGEN]) == tg, bar);
      __builtin_amdgcn_fence(__ATOMIC_ACQUIRE, "agent");
      xb_add(&bar[XB_XGEN(b.x)], 1u);
      asm volatile("s_waitcnt vmcnt(0)" ::: "memory");
    } else {
      XB_SPIN(xb_ld(&bar[XB_XGEN(b.x)]) == gen, bar);
      __builtin_amdgcn_fence(__ATOMIC_ACQUIRE, "agent");
      asm volatile("s_waitcnt vmcnt(0)" ::: "memory");
    }
  }
  __syncthreads();
}

__global__ void __launch_bounds__(256, 2) fwd_kernel(Params p_in, int ph_lo, int ph_hi) {
  extern __shared__ __attribute__((aligned(16))) char smem[];
  char* ws0 = p_in.ws;
#ifndef DOUBLE_MASK
#define DOUBLE_MASK 0
#endif
  const bool multi = (ph_hi - ph_lo) > 1;
  XcdBarrier xb;
  if (multi) {
    volatile LAS unsigned* st = (volatile LAS unsigned*)(smem + SMEM_BYTES - 16);
    if (__builtin_amdgcn_workitem_id_x() == 0) { st[0] = 0u; st[1] = 0u; }
    __syncthreads();
    xb = xcd_barrier_post((unsigned*)(ws0 + OFF_BAR), st);
  }
  if (ph_lo < -1000) cg::this_grid().sync();
#if defined(__HIP_DEVICE_COMPILE__)
#define LOAD_PARAMS(dst_) { const __attribute__((address_space(4))) char* kp_ = (const __attribute__((address_space(4))) char*)__builtin_amdgcn_kernarg_segment_ptr(); \
                            asm volatile("" : "+s"(kp_)); __builtin_memcpy(&(dst_), kp_, sizeof(Params)); }
#else
#define LOAD_PARAMS(dst_) { dst_ = p_in; }
#endif
#define RUN_PHASE(k, call) if (ph_lo <= (k) && (k) < ph_hi) { \
    _Pragma("unroll 1") for (int rep = ((DOUBLE_MASK >> (k)) & 1); rep >= 0; --rep) { \
      Params pl; LOAD_PARAMS(pl); const Params& p = pl; char* ws = p.ws; (void)ws; \
      call; if (rep > 0 || (k) + 1 < ph_hi) xcd_barrier(xb); } }
  RUN_PHASE(0, phase_prep(p, smem))
  RUN_PHASE(1, phase_proj(p, smem))
  RUN_PHASE(2, phase_chunks(p, smem))
  RUN_PHASE(3, phase_scan(p, smem))
  RUN_PHASE(4, phase_gate(p))
  RUN_PHASE(5, phase_resid((const u16*)(ws + OFF_YMIX), (const u16*)(ws + OFF_WOUT), p.x, (u16*)(ws + OFF_XB), (float*)(ws + OFF_SSQ1), smem))
  RUN_PHASE(6, phase_scaled((const u16*)(ws + OFF_XB), (const u16*)(ws + OFF_WXQ), (const float*)(ws + OFF_SSQ1), (u16*)(ws + OFF_QX), smem))
  RUN_PHASE(7, phase_attn(p, smem))
  RUN_PHASE(8, phase_resid((const u16*)(ws + OFF_OX), (const u16*)(ws + OFF_WXO), nullptr, (u16*)(ws + OFF_XB), (float*)(ws + OFF_SSQ2), smem))
  RUN_PHASE(9, phase_pq_topk(p, smem))
  if (ph_lo <= 11 && 11 < ph_hi) {
    Params pl; LOAD_PARAMS(pl); const Params& p = pl;
#if (DOUBLE_MASK >> 11) & 1
    phase_peer(p, smem, (float*)(p.ws + OFF_PROJ)); xcd_barrier(xb);
#endif
    phase_peer(p, smem, p.out);
  }
}

extern "C" void kernel_launch(void* const* d_in, const int* in_sizes, int n_in, void* d_out, int out_size, void* d_ws, size_t ws_size,
                              hipStream_t stream) {
  static int grid = 0;
  if (grid == 0) {
    if (n_in != 21 || out_size != T_TOK * DM || ws_size < WS_END) {
      fprintf(stderr, "kernel_launch: unexpected shapes (n_in %d out %d ws %zu need %zu)\n", n_in, out_size, ws_size, (size_t)WS_END);
      grid = -1;
      return;
    }
    int dev = 0, cus = 0, per_cu = 0;
    hipGetDevice(&dev);
    hipDeviceGetAttribute(&cus, hipDeviceAttributeMultiprocessorCount, dev);
    hipFuncSetAttribute((const void*)fwd_kernel, hipFuncAttributeMaxDynamicSharedMemorySize, SMEM_BYTES);
    hipOccupancyMaxActiveBlocksPerMultiprocessor(&per_cu, (const void*)fwd_kernel, 256, SMEM_BYTES);
    if (per_cu < 1) per_cu = 1;
    if (per_cu > 2) per_cu = 2;
    grid = cus * per_cu;
    if (grid < 128) { fprintf(stderr, "kernel_launch: grid %d too small\n", grid); grid = -1; return; }
  }
  if (grid < 0) return;
  Params p{};
  const float** pp = (const float**)&p;
  for (int i = 0; i < 21; ++i) pp[i] = (const float*)d_in[i];
  p.out = (float*)d_out;
  p.ws = (char*)d_ws;
#if ONE_LAUNCH
  hipMemsetAsync((char*)d_ws + OFF_BAR, 0, BAR_BYTES, stream);
  int lo = 0, hi = NPH;
  void* args[] = {&p, &lo, &hi};
  hipError_t e = hipLaunchCooperativeKernel((const void*)fwd_kernel, dim3(grid), dim3(256), args, SMEM_BYTES, stream);
  if (e != hipSuccess) fprintf(stderr, "cooperative launch failed: %s (grid %d)\n", hipGetErrorString(e), grid);
#else
  for (int ph = 0; ph < NPH; ++ph) hipLaunchKernelGGL(fwd_kernel, dim3(grid), dim3(256), SMEM_BYTES, stream, p, ph, ph + 1);
#endif
}
```

```cpp
#include <hip/hip_runtime.h>
#include <hip/hip_cooperative_groups.h>
#include <stdint.h>
#include <stdio.h>
namespace cg = cooperative_groups;

typedef unsigned short u16;
using bf16x8 = __attribute__((ext_vector_type(8))) short;
using f32x4  = __attribute__((ext_vector_type(4))) float;
using f32x16 = __attribute__((ext_vector_type(16))) float;
using f32x2  = __attribute__((ext_vector_type(2))) float;
using bf16x2v = __attribute__((ext_vector_type(2))) __bf16;

#define DI __device__ __forceinline__
#define MFMA32(a, b, c) __builtin_amdgcn_mfma_f32_32x32x16_bf16((a), (b), (c), 0, 0, 0)
#define MFMA16(a, b, c) __builtin_amdgcn_mfma_f32_16x16x32_bf16((a), (b), (c), 0, 0, 0)

#ifndef ONE_LAUNCH
#define ONE_LAUNCH 1
#endif

constexpr int T_TOK = 32768;
constexpr int SEQ = 8192;
constexpr int DM = 1024;
constexpr int INC = 3592;
constexpr int NPH = 12;
constexpr float EPS = 1e-6f;
constexpr float EU_SCALE = 64.f, EV_SCALE = 8.f;

constexpr size_t MiB = 1024ull * 1024ull;
constexpr size_t OFF_WIN  = 0;
constexpr size_t OFF_WOUT = OFF_WIN + 3712ull * 1024 * 2;
constexpr size_t OFF_WXQ  = OFF_WOUT + 2 * MiB;
constexpr size_t OFF_WXKV = OFF_WXQ + 2 * MiB;
constexpr size_t OFF_WXO  = OFF_WXKV + 4 * MiB;
constexpr size_t OFF_WPQ  = OFF_WXO + 2 * MiB;
constexpr size_t OFF_KEYS = OFF_WPQ + 2 * MiB;
constexpr size_t OFF_EU   = OFF_KEYS + 262144;
constexpr size_t OFF_EV   = OFF_EU + 32 * MiB;
constexpr size_t OFF_XB   = OFF_EV + 32 * MiB;
constexpr size_t OFF_MEMB = OFF_XB + 64 * MiB;
constexpr size_t OFF_KX   = OFF_MEMB + 2 * MiB;
constexpr size_t OFF_VT   = OFF_KX + 2 * MiB;
constexpr size_t OFF_RSTD0 = OFF_VT + 2 * MiB;
constexpr size_t OFF_RSTDM = OFF_RSTD0 + 131072;
constexpr size_t OFF_SSQ1 = OFF_RSTDM + 4096;
constexpr size_t OFF_SSQ2 = OFF_SSQ1 + 1 * MiB;
constexpr size_t OFF_BA   = OFF_SSQ2 + 1 * MiB;
constexpr size_t OFF_GL   = OFF_BA + 1 * MiB;
constexpr size_t OFF_YMIX = OFF_GL + 8192;
constexpr size_t OFF_PROJ = OFF_YMIX + 64 * MiB;
constexpr size_t PROJ_BYTES = (size_t)T_TOK * INC * 2;
constexpr size_t OFF_BAR  = OFF_PROJ + PROJ_BYTES;
constexpr size_t BAR_BYTES = 16384;
constexpr size_t OFF_TS   = OFF_BAR + BAR_BYTES;
constexpr size_t WS_END   = OFF_TS + 4096;
constexpr size_t OFF_QX   = OFF_PROJ;
constexpr size_t OFF_OX   = OFF_PROJ + 64 * MiB;
constexpr size_t OFF_PQ   = OFF_PROJ + 128 * MiB;
constexpr size_t OFF_SELI = OFF_PROJ + 192 * MiB;
constexpr size_t OFF_SELG = OFF_PROJ + 208 * MiB;

constexpr int SMEM_BYTES = 75776;

struct Params {
  const float *x, *mem, *norm_mix, *w_in, *conv_w, *dn_conv_w, *dn_a_log, *dn_dt_bias, *dn_norm, *w_out,
      *norm_x, *norm_mem, *w_xq, *w_xkv, *w_xo, *norm_ffn, *w_pq, *peer_keys, *expert_u, *expert_v, *norm_final;
  float* out;
  char* ws;
};

DI int tidx() { int t = (int)__builtin_amdgcn_workitem_id_x(); asm volatile("" : "+v"(t)); return t; }
DI u16 f2bf(float x) { return __builtin_bit_cast(u16, (__bf16)x); }
DI float bf2f(u16 v) { return __uint_as_float(((uint32_t)v) << 16); }
DI uint32_t pack2(float a, float b) { const bf16x2v v = {(__bf16)a, (__bf16)b}; return __builtin_bit_cast(uint32_t, v); }
DI float bflo(uint32_t u) { return __uint_as_float(u << 16); }
DI float bfhi(uint32_t u) { return __uint_as_float(u & 0xffff0000u); }
DI int crow32(int i, int h) { return (i & 3) + 8 * (i >> 2) + 4 * h; }
DI float silu_f(float v) { return v / (1.f + __expf(-v)); }
DI float wave_sum(float v) {
#pragma unroll
  for (int o = 32; o >= 1; o >>= 1) v += __shfl_xor(v, o);
  return v;
}
DI void unpack8(const uint4& r, float* f) {
  f[0] = bflo(r.x); f[1] = bfhi(r.x); f[2] = bflo(r.y); f[3] = bfhi(r.y);
  f[4] = bflo(r.z); f[5] = bfhi(r.z); f[6] = bflo(r.w); f[7] = bfhi(r.w);
}
DI uint4 pack8(const float* f) { return make_uint4(pack2(f[0], f[1]), pack2(f[2], f[3]), pack2(f[4], f[5]), pack2(f[6], f[7])); }

DI void rowconv(const float* __restrict__ src, u16* __restrict__ dst, const float* __restrict__ gain, float* __restrict__ rstd, int rows) {
  const int lane = tidx() & 63;
  const int gw = blockIdx.x * 4 + (tidx() >> 6), nw = gridDim.x * 4;
  for (int r = gw; r < rows; r += nw) {
    const float4* s = (const float4*)(src + (size_t)r * 1024);
    float4 a0 = s[lane * 2], a1 = s[lane * 2 + 1], b0 = s[128 + lane * 2], b1 = s[128 + lane * 2 + 1];
    float f[16] = {a0.x, a0.y, a0.z, a0.w, a1.x, a1.y, a1.z, a1.w, b0.x, b0.y, b0.z, b0.w, b1.x, b1.y, b1.z, b1.w};
    if (rstd) {
      float ss = 0.f;
#pragma unroll
      for (int i = 0; i < 16; ++i) ss += f[i] * f[i];
      ss = wave_sum(ss);
      if (lane == 0) rstd[r] = rsqrtf(ss * (1.f / 1024.f) + EPS);
    }
    if (gain) {
      const float4* gp = (const float4*)gain;
      float4 g0 = gp[lane * 2], g1 = gp[lane * 2 + 1], g2 = gp[128 + lane * 2], g3 = gp[128 + lane * 2 + 1];
      float gg[16] = {g0.x, g0.y, g0.z, g0.w, g1.x, g1.y, g1.z, g1.w, g2.x, g2.y, g2.z, g2.w, g3.x, g3.y, g3.z, g3.w};
#pragma unroll
      for (int i = 0; i < 16; ++i) f[i] *= gg[i];
    }
    *(uint4*)(dst + (size_t)r * 1024 + lane * 8) = pack8(f);
    *(uint4*)(dst + (size_t)r * 1024 + 512 + lane * 8) = pack8(f + 8);
  }
}


DI void rowconv8(const float* __restrict__ src, unsigned char* __restrict__ dst, const float* __restrict__ gain, float scale, int rows, int bid, int nb) {
  const int lane = tidx() & 63;
  const int gw = bid * 4 + (tidx() >> 6), nw = nb * 4;
  float gg[16];
#pragma unroll
  for (int i = 0; i < 16; ++i) gg[i] = scale;
  if (gain) {
    const float4* gp = (const float4*)(gain + lane * 16);
#pragma unroll
    for (int q = 0; q < 4; ++q) { const float4 g4 = gp[q]; gg[4 * q] *= g4.x; gg[4 * q + 1] *= g4.y; gg[4 * q + 2] *= g4.z; gg[4 * q + 3] *= g4.w; }
  }
  for (int r = gw; r < rows; r += nw) {
    const float4* s = (const float4*)(src + (size_t)r * 1024 + lane * 16);
    uint32_t o[4];
#pragma unroll
    for (int q = 0; q < 4; ++q) {
      const float4 v = s[q];
      int pk = __builtin_amdgcn_cvt_pk_fp8_f32(v.x * gg[4 * q], v.y * gg[4 * q + 1], 0, false);
      pk = __builtin_amdgcn_cvt_pk_fp8_f32(v.z * gg[4 * q + 2], v.w * gg[4 * q + 3], pk, true);
      o[q] = (uint32_t)pk;
    }
    *(uint4*)(dst + (size_t)r * 1024 + lane * 16) = make_uint4(o[0], o[1], o[2], o[3]);
  }
}

DI void transpose_tile(const float* __restrict__ W, int N, const float* __restrict__ gain, u16* __restrict__ Wt, int nt, int kt, float* tile) {
  const int t = tidx();
  const int k0 = kt * 64, n0 = nt * 64;
#pragma unroll
  for (int i = 0; i < 16; ++i) {
    int kk = i * 4 + (t >> 6), nn = t & 63;
    float v = 0.f;
    if (n0 + nn < N) v = W[(size_t)(k0 + kk) * N + n0 + nn] * (gain ? gain[k0 + kk] : 1.f);
    tile[kk * 65 + nn] = v;
  }
  __syncthreads();
#pragma unroll
  for (int i = 0; i < 16; ++i) {
    int nn = i * 4 + (t >> 6), kk = t & 63;
    if (n0 + nn < N) Wt[(size_t)(n0 + nn) * 1024 + k0 + kk] = f2bf(tile[kk * 65 + nn]);
  }
  __syncthreads();
}

DI void weight_transposes(const Params& p, char* smem, unsigned mask, int bid, int nb) {
  char* ws = p.ws;
  const int cnt_all[6] = {57 * 16, 256, 256, 512, 256, 256};
  int cnt[6], total = 0;
  for (int i = 0; i < 6; ++i) { cnt[i] = ((mask >> i) & 1u) ? cnt_all[i] : 0; total += cnt[i]; }
  for (int job = bid; job < total; job += nb) {
    int j = job, w = 0;
    while (j >= cnt[w]) { j -= cnt[w]; ++w; }
    const float* W; const float* gain; u16* dst; int N;
    switch (w) {
      case 0: W = p.w_in; gain = p.norm_mix; dst = (u16*)(ws + OFF_WIN); N = INC; break;
      case 1: W = p.w_out; gain = nullptr; dst = (u16*)(ws + OFF_WOUT); N = 1024; break;
      case 2: W = p.w_xq; gain = p.norm_x; dst = (u16*)(ws + OFF_WXQ); N = 1024; break;
      case 3: W = p.w_xkv; gain = p.norm_mem; dst = (u16*)(ws + OFF_WXKV); N = 2048; break;
      case 4: W = p.w_xo; gain = nullptr; dst = (u16*)(ws + OFF_WXO); N = 1024; break;
      default: W = p.w_pq; gain = p.norm_ffn; dst = (u16*)(ws + OFF_WPQ); N = 1024; break;
    }
    transpose_tile(W, N, gain, dst, j >> 4, j & 15, (float*)smem);
  }
}
DI void keys_convert(const Params& p, int bid, int nb) {
  u16* kd = (u16*)(p.ws + OFF_KEYS);
  for (int i = bid * 256 + tidx(); i < 131072; i += nb * 256) kd[i] = f2bf(p.peer_keys[i]);
}

DI void phase_prep(const Params& p, char* smem) {
  char* ws = p.ws;
  const bool defer = gridDim.x >= 256;
  weight_transposes(p, smem, defer ? 0x09u : 0x3Fu, blockIdx.x, gridDim.x);
  rowconv(p.x, (u16*)(ws + OFF_XB), nullptr, (float*)(ws + OFF_RSTD0), T_TOK);
  rowconv(p.mem, (u16*)(ws + OFF_MEMB), nullptr, (float*)(ws + OFF_RSTDM), 1024);
  if (!defer) {
    rowconv8(p.expert_u, (unsigned char*)(ws + OFF_EU), p.norm_ffn, EU_SCALE, 16384, blockIdx.x, gridDim.x);
    rowconv8(p.expert_v, (unsigned char*)(ws + OFF_EV), nullptr, EV_SCALE, 16384, blockIdx.x, gridDim.x);
    keys_convert(p, blockIdx.x, gridDim.x);
  }
}

typedef unsigned u32x4 __attribute__((ext_vector_type(4)));
DI void gload16(u32x4& dst, const void* p) { asm volatile("global_load_dwordx4 %0, %1, off" : "=&v"(dst) : "v"(p) : "memory"); }
DI void gwait8_all(u32x4& a0, u32x4& a1, u32x4& a2, u32x4& a3, u32x4& b0, u32x4& b1, u32x4& b2, u32x4& b3) {
  asm volatile("s_waitcnt vmcnt(0)" : "+v"(a0), "+v"(a1), "+v"(a2), "+v"(a3), "+v"(b0), "+v"(b1), "+v"(b2), "+v"(b3) : : "memory");
}
DI void gwait8_keep8(u32x4& a0, u32x4& a1, u32x4& a2, u32x4& a3, u32x4& b0, u32x4& b1, u32x4& b2, u32x4& b3) {
  asm volatile("s_waitcnt vmcnt(8)" : "+v"(a0), "+v"(a1), "+v"(a2), "+v"(a3), "+v"(b0), "+v"(b1), "+v"(b2), "+v"(b3) : : "memory");
}

DI void gemm_main(const u16* __restrict__ A, const u16* __restrict__ Bt, int m0, int n0, char* smem, f32x16 (&acc)[2][2]) {
  const int tid = tidx(), lane = tid & 63, wave = tid >> 6;
  const int wm = wave >> 1, wn = wave & 1;
  u16* As = (u16*)smem;
  u16* Bs = (u16*)(smem + 36864);
  const int srow = tid >> 3, scol = (tid & 7) * 8;
  const u16* Ap = A + (size_t)(m0 + srow) * 1024 + scol;
  const u16* Bp = Bt + (size_t)(n0 + srow) * 1024 + scol;
  u32x4 r0a[4], r0b[4], r1a[4], r1b[4];
#pragma unroll
  for (int mi = 0; mi < 2; ++mi)
#pragma unroll
    for (int ni = 0; ni < 2; ++ni)
#pragma unroll
      for (int i = 0; i < 16; ++i) acc[mi][ni][i] = 0.f;
#define ISSUE(ra_, rb_, k_) { _Pragma("unroll") for (int i = 0; i < 4; ++i) { gload16(ra_[i], Ap + (size_t)i * 32 * 1024 + (k_) * 64); gload16(rb_[i], Bp + (size_t)i * 32 * 1024 + (k_) * 64); } }
#define STORE(ra_, rb_, buf_) { u16* as2 = As + (buf_) * 128 * 72; u16* bs2 = Bs + (buf_) * 128 * 72; \
    _Pragma("unroll") for (int i = 0; i < 4; ++i) { *(u32x4*)(as2 + (srow + 32 * i) * 72 + scol) = ra_[i]; *(u32x4*)(bs2 + (srow + 32 * i) * 72 + scol) = rb_[i]; } }
  auto compute = [&](int cur) {
    const u16* as = As + cur * 128 * 72;
    const u16* bs = Bs + cur * 128 * 72;
#pragma unroll
    for (int ks = 0; ks < 4; ++ks) {
      bf16x8 a[2], b[2];
#pragma unroll
      for (int mi = 0; mi < 2; ++mi) a[mi] = *(const bf16x8*)(as + (64 * wm + 32 * mi + (lane & 31)) * 72 + 16 * ks + 8 * (lane >> 5));
#pragma unroll
      for (int ni = 0; ni < 2; ++ni) b[ni] = *(const bf16x8*)(bs + (64 * wn + 32 * ni + (lane & 31)) * 72 + 16 * ks + 8 * (lane >> 5));
#pragma unroll
      for (int mi = 0; mi < 2; ++mi)
#pragma unroll
        for (int ni = 0; ni < 2; ++ni) acc[mi][ni] = MFMA32(b[ni], a[mi], acc[mi][ni]);
    }
  };
  ISSUE(r0a, r0b, 0)
  ISSUE(r1a, r1b, 1)
  gwait8_keep8(r0a[0], r0a[1], r0a[2], r0a[3], r0b[0], r0b[1], r0b[2], r0b[3]);
  STORE(r0a, r0b, 0)
  __syncthreads();
#pragma unroll 1
  for (int kk = 0; kk < 16; kk += 2) {
    const int k2 = (kk + 2 < 16) ? kk + 2 : 15, k3 = (kk + 3 < 16) ? kk + 3 : 15;
    ISSUE(r0a, r0b, k2)
    compute(0);
    gwait8_keep8(r1a[0], r1a[1], r1a[2], r1a[3], r1b[0], r1b[1], r1b[2], r1b[3]);
    STORE(r1a, r1b, 1)
    __syncthreads();
    ISSUE(r1a, r1b, k3)
    compute(1);
    gwait8_keep8(r0a[0], r0a[1], r0a[2], r0a[3], r0b[0], r0b[1], r0b[2], r0b[3]);
    STORE(r0a, r0b, 0)
    __syncthreads();
  }
  gwait8_all(r1a[0], r1a[1], r1a[2], r1a[3], r1b[0], r1b[1], r1b[2], r1b[3]);
#undef ISSUE
#undef STORE
}

DI bool tile_map(int it, int MT, int NT, int& mt, int& nt) {
  const int nb = gridDim.x >> 3;
  if ((gridDim.x & 7) != 0) {
    const int tile = blockIdx.x + it * gridDim.x;
    if (tile >= MT * NT) return false;
    mt = tile / NT; nt = tile % NT;
    return true;
  }
  const int vx = blockIdx.x & 7, lb = blockIdx.x >> 3;
  const int per = (MT >> 3) * NT;
  const int q = it * nb + lb;
  if (q >= per) return false;
  const int grp = q / (8 * NT), r = q % (8 * NT);
  mt = vx * (MT >> 3) + grp * 8 + (r & 7);
  nt = r >> 3;
  return true;
}

DI float* rs_ptr(char* smem) { return (float*)(smem + 73728); }
DI float* sq_ptr(char* smem) { return (float*)(smem + 73728 + 512); }

DI void kv_gemm(const Params& p, char* smem, int bid, int nb);
DI void phase_proj(const Params& p, char* smem) {
  char* ws = p.ws;
  const int tid = tidx(), lane = tid & 63, wave = tid >> 6, wm = wave >> 1, wn = wave & 1, hh = lane >> 5;
  float* rs = rs_ptr(smem);
  u16* proj = (u16*)(ws + OFF_PROJ);
  float* ba = (float*)(ws + OFF_BA);
  for (int it = 0;; ++it) {
    int mt, nt;
    if (!tile_map(it, 256, 29, mt, nt)) break;
    const int m0 = mt * 128, n0 = nt * 128;
    f32x16 acc[2][2];
    gemm_main((const u16*)(ws + OFF_XB), (const u16*)(ws + OFF_WIN), m0, n0, smem, acc);
    if (tid < 128) rs[tid] = ((const float*)(ws + OFF_RSTD0))[m0 + tid];
    __syncthreads();
#pragma unroll
    for (int mi = 0; mi < 2; ++mi) {
      const int rl = 64 * wm + 32 * mi + (lane & 31);
      const float sc = rs[rl];
      const size_t row = (size_t)(m0 + rl);
#pragma unroll
      for (int ni = 0; ni < 2; ++ni)
#pragma unroll
        for (int q = 0; q < 4; ++q) {
          const int col = n0 + 64 * wn + 32 * ni + 8 * q + 4 * hh;
          const float v0 = acc[mi][ni][4 * q] * sc, v1 = acc[mi][ni][4 * q + 1] * sc, v2 = acc[mi][ni][4 * q + 2] * sc, v3 = acc[mi][ni][4 * q + 3] * sc;
          if (col < 3584) *(uint2*)(proj + row * INC + col) = make_uint2(pack2(v0, v1), pack2(v2, v3));
          else if (col < INC) *(float4*)(ba + row * 8 + (col - 3584)) = make_float4(v0, v1, v2, v3);
        }
    }
    __syncthreads();
  }
  if (gridDim.x < 256) kv_gemm(p, smem, blockIdx.x, gridDim.x);
}

DI void kv_gemm(const Params& p, char* smem, int bid, int nb) {
  char* ws = p.ws;
  const int tid = tidx(), lane = tid & 63, wave = tid >> 6, wm = wave >> 1, wn = wave & 1, hh = lane >> 5;
  float* rs = rs_ptr(smem);
  u16* kx = (u16*)(ws + OFF_KX);
  u16* vt = (u16*)(ws + OFF_VT);
  for (int t2 = bid; t2 < 128; t2 += nb) {
    const int mt = t2 >> 4, nt = t2 & 15, m0 = mt * 128, n0 = nt * 128;
    f32x16 acc[2][2];
    gemm_main((const u16*)(ws + OFF_MEMB), (const u16*)(ws + OFF_WXKV), m0, n0, smem, acc);
    if (tid < 128) rs[tid] = ((const float*)(ws + OFF_RSTDM))[m0 + tid];
    __syncthreads();
#pragma unroll
    for (int mi = 0; mi < 2; ++mi) {
      const int rl = 64 * wm + 32 * mi + (lane & 31);
      const float sc = rs[rl];
      const int row = m0 + rl, b = row >> 8, mm = row & 255;
#pragma unroll
      for (int ni = 0; ni < 2; ++ni)
#pragma unroll
        for (int q = 0; q < 4; ++q) {
          const int col = n0 + 64 * wn + 32 * ni + 8 * q + 4 * hh;
          const float v0 = acc[mi][ni][4 * q] * sc, v1 = acc[mi][ni][4 * q + 1] * sc, v2 = acc[mi][ni][4 * q + 2] * sc, v3 = acc[mi][ni][4 * q + 3] * sc;
          if (col < 1024) {
            const int head = col >> 8, d = col & 255;
            *(uint2*)(kx + ((size_t)((b * 4 + head) * 256 + mm)) * 256 + d) = make_uint2(pack2(v0, v1), pack2(v2, v3));
          } else {
            const int c2 = col - 1024, head = c2 >> 8, d = c2 & 255;
            u16* vp = vt + ((size_t)((b * 4 + head) * 256 + d)) * 256 + mm;
            vp[0] = f2bf(v0); vp[256] = f2bf(v1); vp[512] = f2bf(v2); vp[768] = f2bf(v3);
          }
        }
    }
    __syncthreads();
  }
}

DI void phase_resid(const u16* A, const u16* Bt, const float* resid_f32, u16* hb, float* ssq, char* smem) {
  const int tid = tidx(), lane = tid & 63, wave = tid >> 6, wm = wave >> 1, wn = wave & 1, hh = lane >> 5;
  float* sq = sq_ptr(smem);
  for (int it = 0;; ++it) {
    int mt, nt;
    if (!tile_map(it, 256, 8, mt, nt)) break;
    const int m0 = mt * 128, n0 = nt * 128;
    f32x16 acc[2][2];
    gemm_main(A, Bt, m0, n0, smem, acc);
    if (tid < 128) sq[tid] = 0.f;
    __syncthreads();
#pragma unroll
    for (int mi = 0; mi < 2; ++mi) {
      const int rl = 64 * wm + 32 * mi + (lane & 31);
      const size_t row = (size_t)(m0 + rl);
      float s2 = 0.f;
#pragma unroll
      for (int ni = 0; ni < 2; ++ni)
#pragma unroll
        for (int q = 0; q < 4; ++q) {
          const int col = n0 + 64 * wn + 32 * ni + 8 * q + 4 * hh;
          float r0, r1, r2, r3;
          if (resid_f32) {
            const float4 r = *(const float4*)(resid_f32 + row * 1024 + col);
            r0 = r.x; r1 = r.y; r2 = r.z; r3 = r.w;
          } else {
            const uint2 r = *(const uint2*)(hb + row * 1024 + col);
            r0 = bflo(r.x); r1 = bfhi(r.x); r2 = bflo(r.y); r3 = bfhi(r.y);
          }
          const float h0 = r0 + acc[mi][ni][4 * q], h1 = r1 + acc[mi][ni][4 * q + 1], h2 = r2 + acc[mi][ni][4 * q + 2], h3 = r3 + acc[mi][ni][4 * q + 3];
          *(uint2*)(hb + row * 1024 + col) = make_uint2(pack2(h0, h1), pack2(h2, h3));
          s2 += h0 * h0 + h1 * h1 + h2 * h2 + h3 * h3;
        }
      atomicAdd(&sq[rl], s2);
    }
    __syncthreads();
    if (tid < 128) ssq[(size_t)(m0 + tid) * 8 + nt] = sq[tid];
    __syncthreads();
  }
}

DI void phase_scaled(const u16* A, const u16* Bt, const float* ssq, u16* out, char* smem) {
  const int tid = tidx(), lane = tid & 63, wave = tid >> 6, wm = wave >> 1, wn = wave & 1, hh = lane >> 5;
  float* rs = rs_ptr(smem);
  for (int it = 0;; ++it) {
    int mt, nt;
    if (!tile_map(it, 256, 8, mt, nt)) break;
    const int m0 = mt * 128, n0 = nt * 128;
    f32x16 acc[2][2];
    gemm_main(A, Bt, m0, n0, smem, acc);
    if (tid < 128) {
      const float4* sp = (const float4*)(ssq + (size_t)(m0 + tid) * 8);
      float4 s0 = sp[0], s1 = sp[1];
      rs[tid] = rsqrtf((s0.x + s0.y + s0.z + s0.w + s1.x + s1.y + s1.z + s1.w) * (1.f / 1024.f) + EPS);
    }
    __syncthreads();
#pragma unroll
    for (int mi = 0; mi < 2; ++mi) {
      const int rl = 64 * wm + 32 * mi + (lane & 31);
      const float sc = rs[rl];
#pragma unroll
      for (int ni = 0; ni < 2; ++ni)
#pragma unroll
        for (int q = 0; q < 4; ++q) {
          const int col = n0 + 64 * wn + 32 * ni + 8 * q + 4 * hh;
          *(uint2*)(out + (size_t)(m0 + rl) * 1024 + col) =
              make_uint2(pack2(acc[mi][ni][4 * q] * sc, acc[mi][ni][4 * q + 1] * sc), pack2(acc[mi][ni][4 * q + 2] * sc, acc[mi][ni][4 * q + 3] * sc));
        }
    }
    __syncthreads();
  }
}

DI void chunk_job(const Params& p, int cj, char* smem) {
  char* ws = p.ws;
  const int tid = tidx(), lane = tid & 63, wave = tid >> 6;
  const int bh = cj >> 7, n = cj & 127, b = bh >> 2, h = bh & 3;
  const int t0 = b * SEQ + n * 64;
  u16* Kb  = (u16*)smem;
  u16* Qb  = (u16*)(smem + 17408);
  u16* Vt  = (u16*)(smem + 34816);
  u16* KGt = (u16*)(smem + 53248);
  float* gc = (float*)(smem + 71680);
  float* bt = gc + 64;
  float* As = (float*)(smem + 17408);
  u16* Tb = (u16*)smem;
  const u16* proj = (const u16*)(ws + OFF_PROJ);
  u16* QD = (u16*)p.out;
  u16* KD = (u16*)((char*)p.out + 32 * MiB);
  u16* UU = (u16*)((char*)p.out + 64 * MiB);
  u16* WW = (u16*)((char*)p.out + 96 * MiB);
  u16* IN = (u16*)(ws + OFF_EU + 16 * MiB);
  float* GL = (float*)(ws + OFF_GL);

  if (wave == 0) {
    const float* ba = (const float*)(ws + OFF_BA) + (size_t)(t0 + lane) * 8;
    const float bl = ba[h], al = ba[4 + h] + p.dn_dt_bias[h];
    const float sp = fmaxf(al, 0.f) + log1pf(expf(-fabsf(al)));
    float g = -expf(p.dn_a_log[h]) * sp;
#pragma unroll
    for (int o = 1; o < 64; o <<= 1) { float v = __shfl_up(g, o); if (lane >= o) g += v; }
    gc[lane] = g;
    bt[lane] = 1.f / (1.f + expf(-bl));
    if (lane == 63) GL[cj] = expf(g);
  }
  __syncthreads();

  {
    const int cgp = tid & 15, ts = tid >> 4;
    const float glast = gc[63];
    float eg[4], ed[4], be[4];
#pragma unroll
    for (int tt = 0; tt < 4; ++tt) { const float gv = gc[4 * ts + tt]; eg[tt] = expf(gv); ed[tt] = expf(glast - gv); be[tt] = bt[4 * ts + tt]; }
#pragma unroll 1
    for (int part = 0; part < 3; ++part) {
      const int cc = part * 512 + h * 128 + cgp * 8;
      const int cb = 1536 + cc;
      float xin[7][8];
#pragma unroll
      for (int r = 0; r < 7; ++r) {
        const int sp = n * 64 + 4 * ts - 3 + r;
        if (sp >= 0) { uint4 raw = *(const uint4*)(proj + (size_t)(t0 + 4 * ts - 3 + r) * INC + cb); unpack8(raw, xin[r]); }
        else {
#pragma unroll
          for (int c = 0; c < 8; ++c) xin[r][c] = 0.f;
        }
      }
      float o[4][8];
#pragma unroll
      for (int tt = 0; tt < 4; ++tt)
#pragma unroll
        for (int c = 0; c < 8; ++c) o[tt][c] = 0.f;
#pragma unroll
      for (int j = 0; j < 4; ++j) {
        const float4 w0 = *(const float4*)(p.dn_conv_w + j * 1536 + cc), w1 = *(const float4*)(p.dn_conv_w + j * 1536 + cc + 4);
        const float wj[8] = {w0.x, w0.y, w0.z, w0.w, w1.x, w1.y, w1.z, w1.w};
#pragma unroll
        for (int tt = 0; tt < 4; ++tt)
#pragma unroll
          for (int c = 0; c < 8; ++c) o[tt][c] += wj[c] * xin[tt + j][c];
      }
#pragma unroll
      for (int tt = 0; tt < 4; ++tt)
#pragma unroll
        for (int c = 0; c < 8; ++c) o[tt][c] = silu_f(o[tt][c]);
      if (part < 2) {
#pragma unroll
        for (int tt = 0; tt < 4; ++tt) {
          float ss = 0.f;
#pragma unroll
          for (int c = 0; c < 8; ++c) ss += o[tt][c] * o[tt][c];
          ss += __shfl_xor(ss, 1); ss += __shfl_xor(ss, 2); ss += __shfl_xor(ss, 4); ss += __shfl_xor(ss, 8);
          const float rn = rsqrtf(ss + EPS) * (part == 0 ? 0.08838834764831845f : 1.f);
#pragma unroll
          for (int c = 0; c < 8; ++c) o[tt][c] *= rn;
        }
      }
      if (part == 0) {
#pragma unroll
        for (int tt = 0; tt < 4; ++tt) {
          const int tok = 4 * ts + tt;
          *(uint4*)(Qb + tok * 136 + cgp * 8) = pack8(o[tt]);
          float qd[8];
#pragma unroll
          for (int c = 0; c < 8; ++c) qd[c] = o[tt][c] * eg[tt];
          *(uint4*)(QD + ((size_t)cj * 64 + tok) * 128 + cgp * 8) = pack8(qd);
        }
      } else if (part == 1) {
#pragma unroll
        for (int tt = 0; tt < 4; ++tt) *(uint4*)(Kb + (4 * ts + tt) * 136 + cgp * 8) = pack8(o[tt]);
#pragma unroll
        for (int c = 0; c < 8; ++c) {
          const int d = cgp * 8 + c;
          *(uint2*)(KGt + d * 72 + 4 * ts) = make_uint2(pack2(o[0][c] * be[0] * eg[0], o[1][c] * be[1] * eg[1]), pack2(o[2][c] * be[2] * eg[2], o[3][c] * be[3] * eg[3]));
          *(uint2*)(KD + ((size_t)cj * 128 + d) * 64 + 4 * ts) = make_uint2(pack2(o[0][c] * ed[0], o[1][c] * ed[1]), pack2(o[2][c] * ed[2], o[3][c] * ed[3]));
        }
      } else {
#pragma unroll
        for (int c = 0; c < 8; ++c) {
          const int d = cgp * 8 + c;
          *(uint2*)(Vt + d * 72 + 4 * ts) = make_uint2(pack2(o[0][c] * be[0], o[1][c] * be[1]), pack2(o[2][c] * be[2], o[3][c] * be[3]));
        }
      }
    }
  }
  __syncthreads();

  {
    const int wi = wave >> 1, wj = wave & 1, hh = lane >> 5;
    f32x16 aK, aQ;
#pragma unroll
    for (int i = 0; i < 16; ++i) { aK[i] = 0.f; aQ[i] = 0.f; }
    if (wi >= wj) {
#pragma unroll
      for (int ks = 0; ks < 8; ++ks) {
        const bf16x8 fk = *(const bf16x8*)(Kb + (32 * wi + (lane & 31)) * 136 + 16 * ks + 8 * hh);
        const bf16x8 fq = *(const bf16x8*)(Qb + (32 * wi + (lane & 31)) * 136 + 16 * ks + 8 * hh);
        const bf16x8 fb = *(const bf16x8*)(Kb + (32 * wj + (lane & 31)) * 136 + 16 * ks + 8 * hh);
        aK = MFMA32(fk, fb, aK);
        aQ = MFMA32(fq, fb, aQ);
      }
    }
    __syncthreads();
    const int j = 32 * wj + (lane & 31);
    const float gj = gc[j];
#pragma unroll
    for (int ii = 0; ii < 16; ++ii) {
      const int i = 32 * wi + crow32(ii, hh);
      const float dec = (i >= j) ? expf(gc[i] - gj) : 0.f;
      As[i * 68 + j] = (i > j) ? aK[ii] * bt[i] * dec : 0.f;
      IN[((size_t)cj * 64 + i) * 64 + j] = f2bf((i >= j) ? aQ[ii] * dec : 0.f);
    }
  }
  __syncthreads();

  if (wave == 0) {
    float xcol[64];
#pragma unroll
    for (int i = 0; i < 64; ++i) {
      int lv = lane;
      asm volatile("" : "+v"(lv));
      float s = (i == lv) ? 1.f : 0.f;
#pragma unroll
      for (int j4 = 0; j4 < (i + 3) / 4; ++j4) {
        const float4 a4 = *(const float4*)(As + i * 68 + 4 * j4);
        if (4 * j4 + 0 < i) s -= a4.x * xcol[4 * j4 + 0];
        if (4 * j4 + 1 < i) s -= a4.y * xcol[4 * j4 + 1];
        if (4 * j4 + 2 < i) s -= a4.z * xcol[4 * j4 + 2];
        if (4 * j4 + 3 < i) s -= a4.w * xcol[4 * j4 + 3];
      }
      xcol[i] = s;
      asm volatile("" ::: "memory");
    }
#pragma unroll
    for (int i = 0; i < 64; ++i) Tb[i * 72 + lane] = f2bf(xcol[i]);
  }
  __syncthreads();

  {
    const int hh = lane >> 5;
    f32x16 aU[2], aW[2];
#pragma unroll
    for (int mi = 0; mi < 2; ++mi)
#pragma unroll
      for (int i = 0; i < 16; ++i) { aU[mi][i] = 0.f; aW[mi][i] = 0.f; }
#pragma unroll
    for (int ks = 0; ks < 4; ++ks) {
      const bf16x8 bv = *(const bf16x8*)(Vt + (32 * wave + (lane & 31)) * 72 + 16 * ks + 8 * hh);
      const bf16x8 bk = *(const bf16x8*)(KGt + (32 * wave + (lane & 31)) * 72 + 16 * ks + 8 * hh);
#pragma unroll
      for (int mi = 0; mi < 2; ++mi) {
        const bf16x8 a = *(const bf16x8*)(Tb + (32 * mi + (lane & 31)) * 72 + 16 * ks + 8 * hh);
        aU[mi] = MFMA32(a, bv, aU[mi]);
        aW[mi] = MFMA32(a, bk, aW[mi]);
      }
    }
    const int d = 32 * wave + (lane & 31);
#pragma unroll
    for (int mi = 0; mi < 2; ++mi)
#pragma unroll
      for (int ii = 0; ii < 16; ++ii) {
        const int i = 32 * mi + crow32(ii, hh);
        UU[((size_t)cj * 64 + i) * 128 + d] = f2bf(aU[mi][ii]);
        WW[((size_t)cj * 64 + i) * 128 + d] = f2bf(aW[mi][ii]);
      }
  }
  __syncthreads();
}

DI void conv_items(const Params& p, int bid, int nb) {
  char* ws = p.ws;
  const u16* proj = (const u16*)(ws + OFF_PROJ);
  u16* ymix = (u16*)(ws + OFF_YMIX);
  for (int item = bid * 256 + tidx(); item < T_TOK * 64; item += nb * 256) {
    const int t = item >> 6, c0 = (item & 63) * 8;
    const int s = t & (SEQ - 1);
    float accv[8];
#pragma unroll
    for (int c = 0; c < 8; ++c) accv[c] = 0.f;
#pragma unroll
    for (int k = 0; k < 3; ++k) {
      if (s - 2 + k >= 0) {
        const size_t row = (size_t)(t - 2 + k) * INC;
        float cg8[8], hc8[8];
        unpack8(*(const uint4*)(proj + row + 512 + c0), cg8);
        unpack8(*(const uint4*)(proj + row + 1024 + c0), hc8);
        const float4 w0 = *(const float4*)(p.conv_w + k * 512 + c0), w1 = *(const float4*)(p.conv_w + k * 512 + c0 + 4);
        const float wk[8] = {w0.x, w0.y, w0.z, w0.w, w1.x, w1.y, w1.z, w1.w};
#pragma unroll
        for (int c = 0; c < 8; ++c) accv[c] += wk[c] * cg8[c] * hc8[c];
      }
    }
    float bg[8];
    unpack8(*(const uint4*)(proj + (size_t)t * INC + c0), bg);
#pragma unroll
    for (int c = 0; c < 8; ++c) accv[c] *= bg[c];
    *(uint4*)(ymix + (size_t)t * 1024 + c0) = pack8(accv);
  }
}

DI void phase_chunks(const Params& p, char* smem) {
  char* ws = p.ws;
  for (int cj = blockIdx.x; cj < 2048; cj += gridDim.x) chunk_job(p, cj, smem);
  if (gridDim.x < 256) conv_items(p, blockIdx.x, gridDim.x);
}

struct ScanFrag {
  bf16x8 wf[4], qf[4], inf[2], kf[2][2];
  float uf[4];
  float gl;
};

DI void phase_scan(const Params& p, char* smem) {
  char* ws = p.ws;
  if (blockIdx.x >= 128) {
    if (gridDim.x >= 256) {
      const int bid = blockIdx.x - 128, nb = gridDim.x - 128;
      conv_items(p, bid, nb);
      kv_gemm(p, smem, bid, nb);
      weight_transposes(p, smem, 0x36u, bid, nb);
      keys_convert(p, bid, nb);
      rowconv8(p.expert_u, (unsigned char*)(ws + OFF_EU), p.norm_ffn, EU_SCALE, 16384, bid, nb);
      rowconv8(p.expert_v, (unsigned char*)(ws + OFF_EV), nullptr, EV_SCALE, 16384, bid, nb);
    }
    return;
  }
  const int tid = tidx(), lane = tid & 63, w = tid >> 6, m = lane & 15, g = lane >> 4;
  const int bid = blockIdx.x;
  const int bh = (bid & 7) + 8 * ((bid >> 3) & 1), sl = bid >> 4;
  const int b = bh >> 2, h = bh & 3, e0 = sl * 16;
  u16* ST = (u16*)smem;
  u16* VT = (u16*)(smem + 4352);
  const u16* QD = (const u16*)p.out;
  const u16* KD = (const u16*)((const char*)p.out + 32 * MiB);
  const u16* UU = (const u16*)((const char*)p.out + 64 * MiB);
  const u16* WW = (const u16*)((const char*)p.out + 96 * MiB);
  const u16* IN = (const u16*)(ws + OFF_EU + 16 * MiB);
  const float* GL = (const float*)(ws + OFF_GL);
  u16* ymix = (u16*)(ws + OFF_YMIX);

  for (int i = tid; i < 16 * 136 / 2; i += 256) ((uint32_t*)ST)[i] = 0u;
  f32x4 Sacc[2];
#pragma unroll
  for (int mt = 0; mt < 2; ++mt)
#pragma unroll
    for (int j = 0; j < 4; ++j) Sacc[mt][j] = 0.f;

  auto load = [&](int c, ScanFrag& f) {
    const u16* wp = WW + ((size_t)c * 64 + 16 * w + m) * 128 + 8 * g;
    const u16* qp = QD + ((size_t)c * 64 + 16 * w + m) * 128 + 8 * g;
#pragma unroll
    for (int ks = 0; ks < 4; ++ks) { f.wf[ks] = *(const bf16x8*)(wp + 32 * ks); f.qf[ks] = *(const bf16x8*)(qp + 32 * ks); }
    const u16* ip = IN + ((size_t)c * 64 + 16 * w + m) * 64 + 8 * g;
#pragma unroll
    for (int ks = 0; ks < 2; ++ks) f.inf[ks] = *(const bf16x8*)(ip + 32 * ks);
#pragma unroll
    for (int mt = 0; mt < 2; ++mt)
#pragma unroll
      for (int ks = 0; ks < 2; ++ks) f.kf[mt][ks] = *(const bf16x8*)(KD + ((size_t)c * 128 + 32 * w + 16 * mt + m) * 64 + 32 * ks + 8 * g);
#pragma unroll
    for (int j = 0; j < 4; ++j) f.uf[j] = bf2f(UU[((size_t)c * 64 + 16 * w + 4 * g + j) * 128 + e0 + m]);
    f.gl = GL[c];
  };

  const int c0 = bh * 128;
  const int t0 = b * SEQ;
  ScanFrag cur, nxt;
  load(c0, cur);
  nxt = cur;
  __syncthreads();
  for (int n = 0; n < 128; ++n) {
    if (n + 1 < 128) load(c0 + n + 1, nxt);
    f32x4 av = {0.f, 0.f, 0.f, 0.f}, aq = {0.f, 0.f, 0.f, 0.f};
#pragma unroll
    for (int ks = 0; ks < 4; ++ks) {
      const bf16x8 sf = *(const bf16x8*)(ST + m * 136 + 32 * ks + 8 * g);
      av = MFMA16(cur.wf[ks], sf, av);
      aq = MFMA16(cur.qf[ks], sf, aq);
    }
    float vn[4];
#pragma unroll
    for (int j = 0; j < 4; ++j) vn[j] = cur.uf[j] - av[j];
    *(uint2*)(VT + m * 72 + 16 * w + 4 * g) = make_uint2(pack2(vn[0], vn[1]), pack2(vn[2], vn[3]));
    __syncthreads();
    bf16x8 vf[2];
#pragma unroll
    for (int ks = 0; ks < 2; ++ks) vf[ks] = *(const bf16x8*)(VT + m * 72 + 32 * ks + 8 * g);
#pragma unroll
    for (int ks = 0; ks < 2; ++ks) aq = MFMA16(cur.inf[ks], vf[ks], aq);
#pragma unroll
    for (int j = 0; j < 4; ++j)
      ymix[(size_t)(t0 + n * 64 + 16 * w + 4 * g + j) * 1024 + 512 + h * 128 + e0 + m] = f2bf(aq[j]);
#pragma unroll
    for (int mt = 0; mt < 2; ++mt) {
#pragma unroll
      for (int j = 0; j < 4; ++j) Sacc[mt][j] *= cur.gl;
#pragma unroll
      for (int ks = 0; ks < 2; ++ks) Sacc[mt] = MFMA16(cur.kf[mt][ks], vf[ks], Sacc[mt]);
      *(uint2*)(ST + m * 136 + 32 * w + 16 * mt + 4 * g) = make_uint2(pack2(Sacc[mt][0], Sacc[mt][1]), pack2(Sacc[mt][2], Sacc[mt][3]));
    }
    __syncthreads();
    cur = nxt;
  }
}

DI void phase_gate(const Params& p) {
  char* ws = p.ws;
  const u16* proj = (const u16*)(ws + OFF_PROJ);
  u16* ymix = (u16*)(ws + OFF_YMIX);
  for (int item = blockIdx.x * 256 + tidx(); item < T_TOK * 64; item += gridDim.x * 256) {
    const int t = item >> 6, hh = (item >> 4) & 3, part = item & 15;
    u16* op = ymix + (size_t)t * 1024 + 512 + hh * 128 + part * 8;
    float o[8], z[8];
    unpack8(*(const uint4*)op, o);
    unpack8(*(const uint4*)(proj + (size_t)t * INC + 3072 + hh * 128 + part * 8), z);
    float ss = 0.f;
#pragma unroll
    for (int c = 0; c < 8; ++c) ss += o[c] * o[c];
    ss += __shfl_xor(ss, 1); ss += __shfl_xor(ss, 2); ss += __shfl_xor(ss, 4); ss += __shfl_xor(ss, 8);
    const float rn = rsqrtf(ss * (1.f / 128.f) + EPS);
    const float4 g0 = *(const float4*)(p.dn_norm + part * 8), g1 = *(const float4*)(p.dn_norm + part * 8 + 4);
    const float gg[8] = {g0.x, g0.y, g0.z, g0.w, g1.x, g1.y, g1.z, g1.w};
#pragma unroll
    for (int c = 0; c < 8; ++c) o[c] = o[c] * rn * gg[c] * silu_f(z[c]);
    *(uint4*)op = pack8(o);
  }
}

DI void phase_attn(const Params& p, char* smem) {
  char* ws = p.ws;
  const int tid = tidx(), lane = tid & 63, wave = tid >> 6, m = lane & 15, g = lane >> 4;
  const u16* QX = (const u16*)(ws + OFF_QX);
  const u16* KX = (const u16*)(ws + OFF_KX);
  const u16* VTp = (const u16*)(ws + OFF_VT);
  u16* OX = (u16*)(ws + OFF_OX);
  u16* Kc = (u16*)smem;
  u16* Vc = (u16*)(smem + 34816);
  for (int job = blockIdx.x; job < 2048; job += gridDim.x) {
    const int head = job & 3, qt = (job >> 2) & 127, b = job >> 9;
    const size_t qrow = (size_t)b * SEQ + qt * 64 + wave * 16;
    bf16x8 qf[8];
#pragma unroll
    for (int ks = 0; ks < 8; ++ks) qf[ks] = *(const bf16x8*)(QX + (qrow + m) * 1024 + head * 256 + 32 * ks + 8 * g);
    const u16* kb = KX + (size_t)(b * 4 + head) * 65536;
    const u16* vb = VTp + (size_t)(b * 4 + head) * 65536;
    const u16* ksrc = kb + (size_t)(tid >> 5) * 256 + (tid & 31) * 8;
    const u16* vsrc = vb + (size_t)(tid >> 3) * 256 + (tid & 7) * 8;
    u16* kdst = Kc + (tid >> 5) * 264 + (tid & 31) * 8;
    u16* vdst = Vc + (tid >> 3) * 72 + (tid & 7) * 8;

    u32x4 st[8];
#define ATT_ISSUE_K(c_) { _Pragma("unroll") for (int i = 0; i < 8; ++i) gload16(st[i], ksrc + (size_t)((c_) * 64 + i * 8) * 256); }
#define ATT_ISSUE_V(c_) { _Pragma("unroll") for (int i = 0; i < 8; ++i) gload16(st[i], vsrc + (size_t)(i * 32) * 256 + (c_) * 64); }
#define ATT_LAND_K() { gwait8_all(st[0], st[1], st[2], st[3], st[4], st[5], st[6], st[7]); \
                       _Pragma("unroll") for (int i = 0; i < 8; ++i) *(u32x4*)(kdst + i * 8 * 264) = st[i]; }
#define ATT_LAND_V() { gwait8_all(st[0], st[1], st[2], st[3], st[4], st[5], st[6], st[7]); \
                       _Pragma("unroll") for (int i = 0; i < 8; ++i) *(u32x4*)(vdst + i * 32 * 72) = st[i]; }
    f32x4 s[16];
#pragma unroll
    for (int mt = 0; mt < 16; ++mt) s[mt] = {0.f, 0.f, 0.f, 0.f};
    ATT_ISSUE_K(0)
#pragma unroll
    for (int kc = 0; kc < 4; ++kc) {
      ATT_LAND_K()
      if (kc < 3) ATT_ISSUE_K(kc + 1) else ATT_ISSUE_V(0)
      __syncthreads();
      const u16* kbase = Kc + m * 264 + 8 * g;
      asm volatile("" : "+v"(kbase));
#pragma unroll
      for (int mt2 = 0; mt2 < 4; ++mt2)
#pragma unroll
        for (int ks = 0; ks < 8; ++ks) {
          const bf16x8 a = *(const bf16x8*)(kbase + 16 * mt2 * 264 + 32 * ks);
          s[kc * 4 + mt2] = MFMA16(a, qf[ks], s[kc * 4 + mt2]);
          if (ks == 7) asm volatile("" ::: "memory");
        }
      __syncthreads();
    }
    float mx = -1e30f;
#pragma unroll
    for (int mt = 0; mt < 16; ++mt)
#pragma unroll
      for (int j = 0; j < 4; ++j) { s[mt][j] *= 0.0625f; mx = fmaxf(mx, s[mt][j]); }
    mx = fmaxf(mx, __shfl_xor(mx, 16)); mx = fmaxf(mx, __shfl_xor(mx, 32));
    float sum = 0.f;
#pragma unroll
    for (int mt = 0; mt < 16; ++mt)
#pragma unroll
      for (int j = 0; j < 4; ++j) { s[mt][j] = __expf(s[mt][j] - mx); sum += s[mt][j]; }
    sum += __shfl_xor(sum, 16); sum += __shfl_xor(sum, 32);
    const float inv = 1.f / sum;
    bf16x8 pf[8];
#pragma unroll
    for (int k2 = 0; k2 < 8; ++k2) {
      uint4 u = make_uint4(pack2(s[2 * k2][0], s[2 * k2][1]), pack2(s[2 * k2][2], s[2 * k2][3]),
                           pack2(s[2 * k2 + 1][0], s[2 * k2 + 1][1]), pack2(s[2 * k2 + 1][2], s[2 * k2 + 1][3]));
      pf[k2] = __builtin_bit_cast(bf16x8, u);
    }
    float invr[4];
#pragma unroll
    for (int j = 0; j < 4; ++j) invr[j] = __shfl(inv, 4 * g + j);
    f32x4 o[16];
#pragma unroll
    for (int nt = 0; nt < 16; ++nt) o[nt] = {0.f, 0.f, 0.f, 0.f};
#pragma unroll
    for (int vc = 0; vc < 4; ++vc) {
      ATT_LAND_V()
      if (vc < 3) ATT_ISSUE_V(vc + 1)
      __syncthreads();
      const u16* vbase = Vc + m * 72 + 4 * g;
      asm volatile("" : "+v"(vbase));
#pragma unroll
      for (int nt = 0; nt < 16; ++nt) {
#pragma unroll
        for (int k2l = 0; k2l < 2; ++k2l) {
          const uint2 lo = *(const uint2*)(vbase + 16 * nt * 72 + 32 * k2l);
          const uint2 hi = *(const uint2*)(vbase + 16 * nt * 72 + 32 * k2l + 16);
          const uint4 u = make_uint4(lo.x, lo.y, hi.x, hi.y);
          o[nt] = MFMA16(pf[2 * vc + k2l], __builtin_bit_cast(bf16x8, u), o[nt]);
        }
        if ((nt & 3) == 3) asm volatile("" ::: "memory");
      }
      __syncthreads();
    }
#undef ATT_ISSUE_K
#undef ATT_ISSUE_V
#undef ATT_LAND_K
#undef ATT_LAND_V
#pragma unroll
    for (int j = 0; j < 4; ++j) {
      u16* ob = OX + (qrow + 4 * g + j) * 1024 + head * 256 + m;
      asm volatile("" : "+v"(ob));
#pragma unroll
      for (int nt = 0; nt < 16; ++nt) ob[16 * nt] = f2bf(o[nt][j] * invr[j]);
    }
  }
}

DI uint32_t ordf(float f) { uint32_t u = __float_as_uint(f); return u ^ ((uint32_t)((int32_t)u >> 31) | 0x80000000u); }
DI float unordf(uint32_t k) { return __uint_as_float(k ^ ((~(uint32_t)((int32_t)k >> 31)) | 0x80000000u)); }
DI void ins32(uint32_t (&top)[16], uint32_t x) {
#pragma unroll
  for (int i = 0; i < 16; ++i) { const uint32_t hi = max(top[i], x); x = min(top[i], x); top[i] = hi; }
}
DI void ins64(uint32_t (&tk)[16], uint32_t (&tv)[16], uint32_t xk, uint32_t xv) {
#pragma unroll
  for (int i = 0; i < 16; ++i) {
    const bool gt = xk > tk[i];
    const uint32_t nk = gt ? xk : tk[i], nv = gt ? xv : tv[i];
    xk = gt ? tk[i] : xk; xv = gt ? tv[i] : xv;
    tk[i] = nk; tv[i] = nv;
  }
}

DI void sort16_desc(uint32_t (&v)[16]) {
#pragma unroll
  for (int k = 2; k <= 16; k <<= 1)
#pragma unroll
    for (int j = k >> 1; j > 0; j >>= 1)
#pragma unroll
      for (int i = 0; i < 16; ++i) {
        const int l = i ^ j;
        if (l > i) {
          const uint32_t hi = max(v[i], v[l]), lo = min(v[i], v[l]);
          if ((i & k) == 0) { v[i] = hi; v[l] = lo; } else { v[i] = lo; v[l] = hi; }
        }
      }
}
DI void merge16_desc(uint32_t (&a)[16], const uint32_t (&b)[16]) {
#pragma unroll
  for (int i = 0; i < 16; ++i) a[i] = max(a[i], b[15 - i]);
#pragma unroll
  for (int st = 8; st >= 1; st >>= 1)
#pragma unroll
    for (int i = 0; i < 16; ++i)
      if ((i & st) == 0) { const uint32_t hi = max(a[i], a[i + st]), lo = min(a[i], a[i + st]); a[i] = hi; a[i + st] = lo; }
}

__device__ constexpr int PAIR_I[50] = {0,0,0,0,0,0,0,0,0,0,0,0,0,0,0,0,1,1,1,1,1,1,1,1,2,2,2,2,2,3,3,3,3,4,4,4,5,5,6,6,7,7,8,9,10,11,12,13,14,15};
__device__ constexpr int PAIR_J[50] = {0,1,2,3,4,5,6,7,8,9,10,11,12,13,14,15,0,1,2,3,4,5,6,7,0,1,2,3,4,0,1,2,3,0,1,2,0,1,0,1,0,1,0,0,0,0,0,0,0,0};

DI void topk_block(const u16* qrow0, int qstride, int hd, size_t tok0, const u16* KEYS, int* SELI, float* SELG) {
  const int lane = tidx() & 63, l31 = lane & 31, hh = lane >> 5;
  const uint32_t hh4 = (uint32_t)hh << 2;
  {
    const size_t tok = tok0 + l31;
    uint32_t top[2][16];
#pragma unroll
    for (int pp = 0; pp < 2; ++pp) {
      bf16x8 qf[4];
#pragma unroll
      for (int ks = 0; ks < 4; ++ks) qf[ks] = *(const bf16x8*)(qrow0 + (size_t)l31 * qstride + pp * 64 + 16 * ks + 8 * hh);
      f32x16 acc[4];
#pragma unroll
      for (int mt = 0; mt < 4; ++mt) {
#pragma unroll
        for (int i = 0; i < 16; ++i) acc[mt][i] = 0.f;
#pragma unroll
        for (int ks = 0; ks < 4; ++ks) {
          const bf16x8 a = *(const bf16x8*)(KEYS + (size_t)((hd * 2 + pp) * 128 + 32 * mt + l31) * 64 + 16 * ks + 8 * hh);
          acc[mt] = MFMA32(a, qf[ks], acc[mt]);
        }
      }
      uint32_t lst[4][16];
#pragma unroll
      for (int mt = 0; mt < 4; ++mt) {
#pragma unroll
        for (int i = 0; i < 16; ++i) {
          const uint32_t kc = (uint32_t)(127 - (32 * mt + (i & 3) + 8 * (i >> 2)));
          lst[mt][i] = ((ordf(acc[mt][i]) & 0xFFFFFF80u) | kc) ^ hh4;
        }
        sort16_desc(lst[mt]);
      }
      merge16_desc(lst[0], lst[1]);
      merge16_desc(lst[2], lst[3]);
      merge16_desc(lst[0], lst[2]);
#pragma unroll
      for (int i = 0; i < 16; ++i) top[pp][i] = lst[0][i];
      uint32_t c[16];
#pragma unroll
      for (int i = 0; i < 16; ++i) c[i] = max(top[pp][i], (uint32_t)__shfl_xor((int)top[pp][15 - i], 32));
#pragma unroll
      for (int st = 8; st >= 1; st >>= 1)
#pragma unroll
        for (int i = 0; i < 16; ++i)
          if ((i & st) == 0) { const uint32_t hi = max(c[i], c[i + st]), lo = min(c[i], c[i + st]); c[i] = hi; c[i + st] = lo; }
#pragma unroll
      for (int i = 0; i < 16; ++i) top[pp][i] = c[i];
    }
    uint32_t tk[16], tv[16];
#pragma unroll
    for (int i = 0; i < 16; ++i) { tk[i] = 0u; tv[i] = 0u; }
#pragma unroll
    for (int q = 0; q < 25; ++q) {
      const int ia = PAIR_I[2 * q], ja = PAIR_J[2 * q], ib = PAIR_I[2 * q + 1], jb = PAIR_J[2 * q + 1];
      const uint32_t k1 = hh ? top[0][ib] : top[0][ia];
      const uint32_t k2 = hh ? top[1][jb] : top[1][ja];
      const float xs = unordf(k1 & 0xFFFFFF80u) + unordf(k2 & 0xFFFFFF80u);
      const uint32_t xv = (127u - (k1 & 127u)) * 128u + (127u - (k2 & 127u));
      ins64(tk, tv, ordf(xs), xv);
    }
    {
      uint32_t ck[16], cv[16];
#pragma unroll
      for (int i = 0; i < 16; ++i) {
        const uint32_t ok = (uint32_t)__shfl_xor((int)tk[15 - i], 32), ov = (uint32_t)__shfl_xor((int)tv[15 - i], 32);
        const bool gt = ok > tk[i];
        ck[i] = gt ? ok : tk[i]; cv[i] = gt ? ov : tv[i];
      }
#pragma unroll
      for (int i = 0; i < 16; ++i) { tk[i] = ck[i]; tv[i] = cv[i]; }
    }
    float e[16], sum = 0.f;
    uint32_t mk = tk[0];
#pragma unroll
    for (int i = 1; i < 16; ++i) mk = max(mk, tk[i]);
    const float mx = unordf(mk);
#pragma unroll
    for (int i = 0; i < 16; ++i) { e[i] = __expf(unordf(tk[i]) - mx); sum += e[i]; }
    const float inv = 1.f / sum;
    int* ip = SELI + (tok * 8 + hd) * 16;
    float* gp = SELG + (tok * 8 + hd) * 16;
    if (hh == 0) {
      *(uint4*)ip = make_uint4(tv[0], tv[1], tv[2], tv[3]);
      *(uint4*)(ip + 4) = make_uint4(tv[4], tv[5], tv[6], tv[7]);
      *(uint4*)(ip + 8) = make_uint4(tv[8], tv[9], tv[10], tv[11]);
      *(uint4*)(ip + 12) = make_uint4(tv[12], tv[13], tv[14], tv[15]);
      *(float4*)gp = make_float4(e[0] * inv, e[1] * inv, e[2] * inv, e[3] * inv);
      *(float4*)(gp + 4) = make_float4(e[4] * inv, e[5] * inv, e[6] * inv, e[7] * inv);
      *(float4*)(gp + 8) = make_float4(e[8] * inv, e[9] * inv, e[10] * inv, e[11] * inv);
      *(float4*)(gp + 12) = make_float4(e[12] * inv, e[13] * inv, e[14] * inv, e[15] * inv);
    }
  }
}

DI void phase_pq_topk(const Params& p, char* smem) {
  char* ws = p.ws;
  const int tid = tidx(), lane = tid & 63, wave = tid >> 6, wm = wave >> 1, wn = wave & 1, hh = lane >> 5;
  float* rs = rs_ptr(smem);
  const float* ssq = (const float*)(ws + OFF_SSQ2);
  u16* Qs = (u16*)smem;
  for (int it = 0;; ++it) {
    int mt, nt;
    if (!tile_map(it, 256, 8, mt, nt)) break;
    const int m0 = mt * 128, n0 = nt * 128;
    f32x16 acc[2][2];
    gemm_main((const u16*)(ws + OFF_XB), (const u16*)(ws + OFF_WPQ), m0, n0, smem, acc);
    if (tid < 128) {
      const float4* sp = (const float4*)(ssq + (size_t)(m0 + tid) * 8);
      float4 s0 = sp[0], s1 = sp[1];
      rs[tid] = rsqrtf((s0.x + s0.y + s0.z + s0.w + s1.x + s1.y + s1.z + s1.w) * (1.f / 1024.f) + EPS);
    }
    __syncthreads();
#pragma unroll
    for (int mi = 0; mi < 2; ++mi) {
      const int rl = 64 * wm + 32 * mi + (lane & 31);
      const float sc = rs[rl];
#pragma unroll
      for (int ni = 0; ni < 2; ++ni)
#pragma unroll
        for (int q = 0; q < 4; ++q) {
          const int col = 64 * wn + 32 * ni + 8 * q + 4 * hh;
          *(uint2*)(Qs + rl * 136 + col) =
              make_uint2(pack2(acc[mi][ni][4 * q] * sc, acc[mi][ni][4 * q + 1] * sc), pack2(acc[mi][ni][4 * q + 2] * sc, acc[mi][ni][4 * q + 3] * sc));
        }
    }
    __syncthreads();
    topk_block(Qs + 32 * wave * 136, 136, nt, (size_t)m0 + 32 * wave, (const u16*)(ws + OFF_KEYS), (int*)(ws + OFF_SELI), (float*)(ws + OFF_SELG));
    __syncthreads();
  }
}

DI bf16x8 fp8x8_to_bf16(uint32_t d0, uint32_t d1) {
  const bf16x2v c0 = __builtin_amdgcn_cvt_scalef32_pk_bf16_fp8((int)d0, 1.0f, false);
  const bf16x2v c1 = __builtin_amdgcn_cvt_scalef32_pk_bf16_fp8((int)d0, 1.0f, true);
  const bf16x2v c2 = __builtin_amdgcn_cvt_scalef32_pk_bf16_fp8((int)d1, 1.0f, false);
  const bf16x2v c3 = __builtin_amdgcn_cvt_scalef32_pk_bf16_fp8((int)d1, 1.0f, true);
  const uint4 u = make_uint4(__builtin_bit_cast(uint32_t, c0), __builtin_bit_cast(uint32_t, c1), __builtin_bit_cast(uint32_t, c2), __builtin_bit_cast(uint32_t, c3));
  return __builtin_bit_cast(bf16x8, u);
}

DI void phase_peer(const Params& p, char* smem, float* dst) {
  char* ws = p.ws;
  const int tid = tidx(), lane = tid & 63, wave = tid >> 6, m = lane & 15, g = lane >> 4;
  const u16* HB = (const u16*)(ws + OFF_XB);
  const unsigned char* EU = (const unsigned char*)(ws + OFF_EU);
  const unsigned char* EV = (const unsigned char*)(ws + OFF_EV);
  const int* SELI = (const int*)(ws + OFF_SELI);
  const float* SELG = (const float*)(ws + OFF_SELG);
  const float* SSQ = (const float*)(ws + OFF_SSQ2);
  float* coef = (float*)(smem + wave * 1024);
  int* idxs = (int*)(smem + wave * 1024 + 512);
  for (int tile = blockIdx.x; tile < T_TOK / 4; tile += gridDim.x) {
    const size_t t = (size_t)tile * 4 + wave;
    const float4 q0 = *(const float4*)(SSQ + t * 8), q1 = *(const float4*)(SSQ + t * 8 + 4);
    const float rstd = rsqrtf((q0.x + q0.y + q0.z + q0.w + q1.x + q1.y + q1.z + q1.w) * (1.f / 1024.f) + EPS) * (1.f / EU_SCALE);
    int myidx[8];
#pragma unroll
    for (int grp = 0; grp < 8; ++grp) myidx[grp] = SELI[t * 128 + grp * 16 + m];
    f32x4 acc[8];
#pragma unroll
    for (int grp = 0; grp < 8; ++grp) acc[grp] = {0.f, 0.f, 0.f, 0.f};
    for (int kb2 = 0; kb2 < 8; ++kb2) {
      bf16x8 xf[4];
#pragma unroll
      for (int j = 0; j < 4; ++j) xf[j] = *(const bf16x8*)(HB + t * 1024 + kb2 * 128 + g * 32 + 8 * j);
      uint4 raw0[8], raw1[8];
#pragma unroll
      for (int grp = 0; grp < 8; ++grp) {
        const unsigned char* up = EU + (size_t)myidx[grp] * 1024 + kb2 * 128 + g * 32;
        raw0[grp] = *(const uint4*)up;
        raw1[grp] = *(const uint4*)(up + 16);
      }
#pragma unroll
      for (int grp = 0; grp < 8; ++grp) {
        acc[grp] = MFMA16(fp8x8_to_bf16(raw0[grp].x, raw0[grp].y), xf[0], acc[grp]);
        acc[grp] = MFMA16(fp8x8_to_bf16(raw0[grp].z, raw0[grp].w), xf[1], acc[grp]);
        acc[grp] = MFMA16(fp8x8_to_bf16(raw1[grp].x, raw1[grp].y), xf[2], acc[grp]);
        acc[grp] = MFMA16(fp8x8_to_bf16(raw1[grp].z, raw1[grp].w), xf[3], acc[grp]);
      }
    }
    if (g == 0) {
#pragma unroll
      for (int grp = 0; grp < 8; ++grp) idxs[grp * 16 + m] = myidx[grp];
    }
    if (m == 0) {
#pragma unroll
      for (int grp = 0; grp < 8; ++grp)
#pragma unroll
        for (int j = 0; j < 4; ++j) {
          const int e = grp * 16 + 4 * g + j;
          const float a = acc[grp][j] * rstd;
          const float ge = 0.5f * a * (1.f + erff(a * 0.7071067811865475f));
          coef[e] = SELG[t * 128 + e] * ge * (1.f / EV_SCALE);
        }
    }
    __syncthreads();
    f32x2 y[8];
#pragma unroll
    for (int i = 0; i < 8; ++i) y[i] = {0.f, 0.f};
#pragma unroll 8
    for (int e = 0; e < 128; ++e) {
      const float c = coef[e];
      const f32x2 c2 = {c, c};
      const uint4 r = *(const uint4*)(EV + (size_t)idxs[e] * 1024 + lane * 16);
      y[0] += c2 * __builtin_amdgcn_cvt_pk_f32_fp8((int)r.x, false);
      y[1] += c2 * __builtin_amdgcn_cvt_pk_f32_fp8((int)r.x, true);
      y[2] += c2 * __builtin_amdgcn_cvt_pk_f32_fp8((int)r.y, false);
      y[3] += c2 * __builtin_amdgcn_cvt_pk_f32_fp8((int)r.y, true);
      y[4] += c2 * __builtin_amdgcn_cvt_pk_f32_fp8((int)r.z, false);
      y[5] += c2 * __builtin_amdgcn_cvt_pk_f32_fp8((int)r.z, true);
      y[6] += c2 * __builtin_amdgcn_cvt_pk_f32_fp8((int)r.w, false);
      y[7] += c2 * __builtin_amdgcn_cvt_pk_f32_fp8((int)r.w, true);
    }
    float* dp = dst + t * 1024 + lane * 16;
    float hv[16];
    unpack8(*(const uint4*)(HB + t * 1024 + lane * 16), hv);
    unpack8(*(const uint4*)(HB + t * 1024 + lane * 16 + 8), hv + 8);
    float ss = 0.f;
#pragma unroll
    for (int i = 0; i < 8; ++i) { hv[2 * i] += y[i][0]; hv[2 * i + 1] += y[i][1]; }
#pragma unroll
    for (int i = 0; i < 16; ++i) ss += hv[i] * hv[i];
    ss = wave_sum(ss);
    const float rn = rsqrtf(ss * (1.f / 1024.f) + EPS);
#pragma unroll
    for (int q = 0; q < 4; ++q) {
      const float4 n4 = *(const float4*)(p.norm_final + lane * 16 + 4 * q);
      *(float4*)(dp + 4 * q) = make_float4(hv[4 * q] * rn * n4.x, hv[4 * q + 1] * rn * n4.y, hv[4 * q + 2] * rn * n4.z, hv[4 * q + 3] * rn * n4.w);
    }
    __syncthreads();
  }
}

#define XB_TMO      128
#define XB_XCNT(j)  (256  + 64 * (j))
#define XB_XSUB(j)  (1280 + 64 * (j))
#define XB_XGEN(j)  (2304 + 64 * (j))
#define XB_TOP      3328
#define XB_TOPGEN   3392
#define XCD_BAR_WORDS 3456
#define XB_SPIN_CAP (1u << 22)
#define LAS __attribute__((address_space(3)))
DI unsigned xb_ld(unsigned* p)              { return __hip_atomic_load(p, __ATOMIC_RELAXED, __HIP_MEMORY_SCOPE_AGENT); }
DI unsigned xb_add(unsigned* p, unsigned v) { return __hip_atomic_fetch_add(p, v, __ATOMIC_RELAXED, __HIP_MEMORY_SCOPE_AGENT); }
DI unsigned xb_xcc_id() { return (unsigned)__builtin_amdgcn_s_getreg((3 << 11) | 20) & 0xFu; }
#define XB_SPIN(cond, bar) do { unsigned _sp = 0; while (cond) { __builtin_amdgcn_s_sleep(1); \
    if ((++_sp & 255u) == 0u) { if (xb_ld(&(bar)[XB_TMO])) break; if (_sp > XB_SPIN_CAP) { atomicAdd(&(bar)[XB_TMO], 1u); break; } } } } while (0)
struct XcdBarrier { unsigned* bar; unsigned x; volatile LAS unsigned* st; };
DI XcdBarrier xcd_barrier_post(unsigned* bar, volatile LAS unsigned* st) {
  XcdBarrier b; b.bar = bar; b.x = xb_xcc_id(); b.st = st;
  if (__builtin_amdgcn_workitem_id_x() == 0) (void)xb_add(&bar[XB_XCNT(b.x)], 1u);
  return b;
}
DI void xcd_barrier_complete(unsigned* bar, unsigned x, unsigned& nloc, unsigned& nx) {
  const unsigned G = gridDim.x * gridDim.y * gridDim.z;
  unsigned sum, cnt, mine, sp = 0u;
  for (;;) {
    sum = 0u; cnt = 0u; mine = 0u;
#pragma unroll
    for (unsigned j = 0; j < 16; ++j) { const unsigned c = xb_ld(&bar[XB_XCNT(j)]); sum += c; cnt += (c > 0u) ? 1u : 0u; mine = (j == x) ? c : mine; }
    if (sum == G) break;
    __builtin_amdgcn_s_sleep(1);
    if ((++sp & 255u) == 0u) { if (xb_ld(&bar[XB_TMO])) break; if (sp > XB_SPIN_CAP) { atomicAdd(&bar[XB_TMO], 1u); break; } }
  }
  nloc = mine > 0u ? mine : 1u; nx = cnt > 0u ? cnt : 1u;
}
DI void xcd_barrier(const XcdBarrier& b) {
  asm volatile("s_waitcnt vmcnt(0)" ::: "memory");
  __syncthreads();
  if (__builtin_amdgcn_workitem_id_x() == 0) {
    unsigned* bar = b.bar;
    __builtin_amdgcn_s_waitcnt(0);
    unsigned nloc = b.st[0], nx = b.st[1];
    if (nloc == 0u) { xcd_barrier_complete(bar, b.x, nloc, nx); b.st[0] = nloc; b.st[1] = nx; }
    const unsigned old = xb_add(&bar[XB_XSUB(b.x)], 1u);
    const unsigned gen = old / nloc;
    if (old + 1u == (gen + 1u) * nloc) {
      __builtin_amdgcn_fence(__ATOMIC_RELEASE, "agent");
      asm volatile("s_waitcnt vmcnt(0)" ::: "memory");
      const unsigned og = xb_add(&bar[XB_TOP], 1u);
      const unsigned tg = og / nx;
      if (og + 1u == (tg + 1u) * nx) xb_add(&bar[XB_TOPGEN], 1u);
      else XB_SPIN(xb_ld(&bar[XB_TOPGEN]) == tg, bar);
      __builtin_amdgcn_fence(__ATOMIC_ACQUIRE, "agent");
      xb_add(&bar[XB_XGEN(b.x)], 1u);
      asm volatile("s_waitcnt vmcnt(0)" ::: "memory");
    } else {
      XB_SPIN(xb_ld(&bar[XB_XGEN(b.x)]) == gen, bar);
      __builtin_amdgcn_fence(__ATOMIC_ACQUIRE, "agent");
      asm volatile("s_waitcnt vmcnt(0)" ::: "memory");
    }
  }
  __syncthreads();
}

__global__ void __launch_bounds__(256, 2) fwd_kernel(Params p_in, int ph_lo, int ph_hi) {
  extern __shared__ __attribute__((aligned(16))) char smem[];
  char* ws0 = p_in.ws;
#ifndef DOUBLE_MASK
#define DOUBLE_MASK 0
#endif
  const bool multi = (ph_hi - ph_lo) > 1;
  XcdBarrier xb;
  if (multi) {
    volatile LAS unsigned* st = (volatile LAS unsigned*)(smem + SMEM_BYTES - 16);
    if (__builtin_amdgcn_workitem_id_x() == 0) { st[0] = 0u; st[1] = 0u; }
    __syncthreads();
    xb = xcd_barrier_post((unsigned*)(ws0 + OFF_BAR), st);
  }
  if (ph_lo < -1000) cg::this_grid().sync();
#if defined(__HIP_DEVICE_COMPILE__)
#define LOAD_PARAMS(dst_) { const __attribute__((address_space(4))) char* kp_ = (const __attribute__((address_space(4))) char*)__builtin_amdgcn_kernarg_segment_ptr(); \
                            asm volatile("" : "+s"(kp_)); __builtin_memcpy(&(dst_), kp_, sizeof(Params)); }
#else
#define LOAD_PARAMS(dst_) { dst_ = p_in; }
#endif
#define RUN_PHASE(k, call) if (ph_lo <= (k) && (k) < ph_hi) { \
    _Pragma("unroll 1") for (int rep = ((DOUBLE_MASK >> (k)) & 1); rep >= 0; --rep) { \
      Params pl; LOAD_PARAMS(pl); const Params& p = pl; char* ws = p.ws; (void)ws; \
      call; if (rep > 0 || (k) + 1 < ph_hi) xcd_barrier(xb); } }
  RUN_PHASE(0, phase_prep(p, smem))
  RUN_PHASE(1, phase_proj(p, smem))
  RUN_PHASE(2, phase_chunks(p, smem))
  RUN_PHASE(3, phase_scan(p, smem))
  RUN_PHASE(4, phase_gate(p))
  RUN_PHASE(5, phase_resid((const u16*)(ws + OFF_YMIX), (const u16*)(ws + OFF_WOUT), nullptr, (u16*)(ws + OFF_XB), (float*)(ws + OFF_SSQ1), smem))
  RUN_PHASE(6, phase_scaled((const u16*)(ws + OFF_XB), (const u16*)(ws + OFF_WXQ), (const float*)(ws + OFF_SSQ1), (u16*)(ws + OFF_QX), smem))
  RUN_PHASE(7, phase_attn(p, smem))
  RUN_PHASE(8, phase_resid((const u16*)(ws + OFF_OX), (const u16*)(ws + OFF_WXO), nullptr, (u16*)(ws + OFF_XB), (float*)(ws + OFF_SSQ2), smem))
  RUN_PHASE(9, phase_pq_topk(p, smem))
  if (ph_lo <= 11 && 11 < ph_hi) {
    Params pl; LOAD_PARAMS(pl); const Params& p = pl;
#if (DOUBLE_MASK >> 11) & 1
    phase_peer(p, smem, (float*)(p.ws + OFF_PROJ)); xcd_barrier(xb);
#endif
    phase_peer(p, smem, p.out);
  }
}

extern "C" void kernel_launch(void* const* d_in, const int* in_sizes, int n_in, void* d_out, int out_size, void* d_ws, size_t ws_size,
                              hipStream_t stream) {
  static int grid = 0;
  if (grid == 0) {
    if (n_in != 21 || out_size != T_TOK * DM || ws_size < WS_END) {
      fprintf(stderr, "kernel_launch: unexpected shapes (n_in %d out %d ws %zu need %zu)\n", n_in, out_size, ws_size, (size_t)WS_END);
      grid = -1;
      return;
    }
    int dev = 0, cus = 0, per_cu = 0;
    hipGetDevice(&dev);
    hipDeviceGetAttribute(&cus, hipDeviceAttributeMultiprocessorCount, dev);
    hipFuncSetAttribute((const void*)fwd_kernel, hipFuncAttributeMaxDynamicSharedMemorySize, SMEM_BYTES);
    hipOccupancyMaxActiveBlocksPerMultiprocessor(&per_cu, (const void*)fwd_kernel, 256, SMEM_BYTES);
    if (per_cu < 1) per_cu = 1;
    if (per_cu > 2) per_cu = 2;
    grid = cus * per_cu;
    if (grid < 128) { fprintf(stderr, "kernel_launch: grid %d too small\n", grid); grid = -1; return; }
  }
  if (grid < 0) return;
  Params p{};
  const float** pp = (const float**)&p;
  for (int i = 0; i < 21; ++i) pp[i] = (const float*)d_in[i];
  p.out = (float*)d_out;
  p.ws = (char*)d_ws;
#if ONE_LAUNCH
  hipMemsetAsync((char*)d_ws + OFF_BAR, 0, BAR_BYTES, stream);
  int lo = 0, hi = NPH;
  void* args[] = {&p, &lo, &hi};
  hipError_t e = hipLaunchCooperativeKernel((const void*)fwd_kernel, dim3(grid), dim3(256), args, SMEM_BYTES, stream);
  if (e != hipSuccess) fprintf(stderr, "cooperative launch failed: %s (grid %d)\n", hipGetErrorString(e), grid);
#else
  for (int ph = 0; ph < NPH; ++ph) hipLaunchKernelGGL(fwd_kernel, dim3(grid), dim3(256), SMEM_BYTES, stream, p, ph, ph + 1);
#endif
}
```

```cpp
#include <hip/hip_runtime.h>
#include <hip/hip_cooperative_groups.h>
#include <stdint.h>
#include <stdio.h>
namespace cg = cooperative_groups;

typedef unsigned short u16;
using bf16x8 = __attribute__((ext_vector_type(8))) short;
using f32x4  = __attribute__((ext_vector_type(4))) float;
using f32x16 = __attribute__((ext_vector_type(16))) float;
using f32x2  = __attribute__((ext_vector_type(2))) float;
using bf16x2v = __attribute__((ext_vector_type(2))) __bf16;

#define DI __device__ __forceinline__
#define MFMA32(a, b, c) __builtin_amdgcn_mfma_f32_32x32x16_bf16((a), (b), (c), 0, 0, 0)
#define MFMA16(a, b, c) __builtin_amdgcn_mfma_f32_16x16x32_bf16((a), (b), (c), 0, 0, 0)

#ifndef ONE_LAUNCH
#define ONE_LAUNCH 1
#endif

constexpr int T_TOK = 32768;
constexpr int SEQ = 8192;
constexpr int DM = 1024;
constexpr int INC = 3592;
constexpr int NPH = 12;
constexpr float EPS = 1e-6f;
constexpr float EU_SCALE = 64.f, EV_SCALE = 8.f;

constexpr size_t MiB = 1024ull * 1024ull;
constexpr size_t OFF_WIN  = 0;
constexpr size_t OFF_WOUT = OFF_WIN + 3712ull * 1024 * 2;
constexpr size_t OFF_WXQ  = OFF_WOUT + 2 * MiB;
constexpr size_t OFF_WXKV = OFF_WXQ + 2 * MiB;
constexpr size_t OFF_WXO  = OFF_WXKV + 4 * MiB;
constexpr size_t OFF_WPQ  = OFF_WXO + 2 * MiB;
constexpr size_t OFF_KEYS = OFF_WPQ + 2 * MiB;
constexpr size_t OFF_EU   = OFF_KEYS + 262144;
constexpr size_t OFF_EV   = OFF_EU + 32 * MiB;
constexpr size_t OFF_XB   = OFF_EV + 32 * MiB;
constexpr size_t OFF_MEMB = OFF_XB + 64 * MiB;
constexpr size_t OFF_KX   = OFF_MEMB + 2 * MiB;
constexpr size_t OFF_VT   = OFF_KX + 2 * MiB;
constexpr size_t OFF_RSTD0 = OFF_VT + 2 * MiB;
constexpr size_t OFF_RSTDM = OFF_RSTD0 + 131072;
constexpr size_t OFF_SSQ1 = OFF_RSTDM + 4096;
constexpr size_t OFF_SSQ2 = OFF_SSQ1 + 1 * MiB;
constexpr size_t OFF_BA   = OFF_SSQ2 + 1 * MiB;
constexpr size_t OFF_GL   = OFF_BA + 1 * MiB;
constexpr size_t OFF_YMIX = OFF_GL + 8192;
constexpr size_t OFF_PROJ = OFF_YMIX + 64 * MiB;
constexpr size_t PROJ_BYTES = (size_t)T_TOK * INC * 2;
constexpr size_t OFF_BAR  = OFF_PROJ + PROJ_BYTES;
constexpr size_t BAR_BYTES = 16384;
constexpr size_t OFF_TS   = OFF_BAR + BAR_BYTES;
constexpr size_t WS_END   = OFF_TS + 4096;
constexpr size_t OFF_QX   = OFF_PROJ;
constexpr size_t OFF_OX   = OFF_PROJ + 64 * MiB;
constexpr size_t OFF_PQ   = OFF_PROJ + 128 * MiB;
constexpr size_t OFF_SELI = OFF_PROJ + 192 * MiB;
constexpr size_t OFF_SELG = OFF_PROJ + 208 * MiB;

constexpr int SMEM_BYTES = 75776;

struct Params {
  const float *x, *mem, *norm_mix, *w_in, *conv_w, *dn_conv_w, *dn_a_log, *dn_dt_bias, *dn_norm, *w_out,
      *norm_x, *norm_mem, *w_xq, *w_xkv, *w_xo, *norm_ffn, *w_pq, *peer_keys, *expert_u, *expert_v, *norm_final;
  float* out;
  char* ws;
};

DI int tidx() { int t = (int)__builtin_amdgcn_workitem_id_x(); asm volatile("" : "+v"(t)); return t; }
DI u16 f2bf(float x) { return __builtin_bit_cast(u16, (__bf16)x); }
DI float bf2f(u16 v) { return __uint_as_float(((uint32_t)v) << 16); }
DI uint32_t pack2(float a, float b) { const bf16x2v v = {(__bf16)a, (__bf16)b}; return __builtin_bit_cast(uint32_t, v); }
DI float bflo(uint32_t u) { return __uint_as_float(u << 16); }
DI float bfhi(uint32_t u) { return __uint_as_float(u & 0xffff0000u); }
DI int crow32(int i, int h) { return (i & 3) + 8 * (i >> 2) + 4 * h; }
DI float silu_f(float v) { return v / (1.f + __expf(-v)); }
DI float wave_sum(float v) {
#pragma unroll
  for (int o = 32; o >= 1; o >>= 1) v += __shfl_xor(v, o);
  return v;
}
DI void unpack8(const uint4& r, float* f) {
  f[0] = bflo(r.x); f[1] = bfhi(r.x); f[2] = bflo(r.y); f[3] = bfhi(r.y);
  f[4] = bflo(r.z); f[5] = bfhi(r.z); f[6] = bflo(r.w); f[7] = bfhi(r.w);
}
DI uint4 pack8(const float* f) { return make_uint4(pack2(f[0], f[1]), pack2(f[2], f[3]), pack2(f[4], f[5]), pack2(f[6], f[7])); }

DI void rowconv(const float* __restrict__ src, u16* __restrict__ dst, const float* __restrict__ gain, float* __restrict__ rstd, int rows) {
  const int lane = tidx() & 63;
  const int gw = blockIdx.x * 4 + (tidx() >> 6), nw = gridDim.x * 4;
  for (int r = gw; r < rows; r += nw) {
    const float4* s = (const float4*)(src + (size_t)r * 1024);
    float4 a0 = s[lane * 2], a1 = s[lane * 2 + 1], b0 = s[128 + lane * 2], b1 = s[128 + lane * 2 + 1];
    float f[16] = {a0.x, a0.y, a0.z, a0.w, a1.x, a1.y, a1.z, a1.w, b0.x, b0.y, b0.z, b0.w, b1.x, b1.y, b1.z, b1.w};
    if (rstd) {
      float ss = 0.f;
#pragma unroll
      for (int i = 0; i < 16; ++i) ss += f[i] * f[i];
      ss = wave_sum(ss);
      if (lane == 0) rstd[r] = rsqrtf(ss * (1.f / 1024.f) + EPS);
    }
    if (gain) {
      const float4* gp = (const float4*)gain;
      float4 g0 = gp[lane * 2], g1 = gp[lane * 2 + 1], g2 = gp[128 + lane * 2], g3 = gp[128 + lane * 2 + 1];
      float gg[16] = {g0.x, g0.y, g0.z, g0.w, g1.x, g1.y, g1.z, g1.w, g2.x, g2.y, g2.z, g2.w, g3.x, g3.y, g3.z, g3.w};
#pragma unroll
      for (int i = 0; i < 16; ++i) f[i] *= gg[i];
    }
    *(uint4*)(dst + (size_t)r * 1024 + lane * 8) = pack8(f);
    *(uint4*)(dst + (size_t)r * 1024 + 512 + lane * 8) = pack8(f + 8);
  }
}


DI void rowconv8(const float* __restrict__ src, unsigned char* __restrict__ dst, const float* __restrict__ gain, float scale, int rows, int bid, int nb) {
  const int lane = tidx() & 63;
  const int gw = bid * 4 + (tidx() >> 6), nw = nb * 4;
  float gg[16];
#pragma unroll
  for (int i = 0; i < 16; ++i) gg[i] = scale;
  if (gain) {
    const float4* gp = (const float4*)(gain + lane * 16);
#pragma unroll
    for (int q = 0; q < 4; ++q) { const float4 g4 = gp[q]; gg[4 * q] *= g4.x; gg[4 * q + 1] *= g4.y; gg[4 * q + 2] *= g4.z; gg[4 * q + 3] *= g4.w; }
  }
  for (int r = gw; r < rows; r += nw) {
    const float4* s = (const float4*)(src + (size_t)r * 1024 + lane * 16);
    uint32_t o[4];
#pragma unroll
    for (int q = 0; q < 4; ++q) {
      const float4 v = s[q];
      int pk = __builtin_amdgcn_cvt_pk_fp8_f32(v.x * gg[4 * q], v.y * gg[4 * q + 1], 0, false);
      pk = __builtin_amdgcn_cvt_pk_fp8_f32(v.z * gg[4 * q + 2], v.w * gg[4 * q + 3], pk, true);
      o[q] = (uint32_t)pk;
    }
    *(uint4*)(dst + (size_t)r * 1024 + lane * 16) = make_uint4(o[0], o[1], o[2], o[3]);
  }
}

DI void transpose_tile(const float* __restrict__ W, int N, const float* __restrict__ gain, u16* __restrict__ Wt, int nt, int kt, float* tile) {
  const int t = tidx();
  const int k0 = kt * 64, n0 = nt * 64;
#pragma unroll
  for (int i = 0; i < 16; ++i) {
    int kk = i * 4 + (t >> 6), nn = t & 63;
    float v = 0.f;
    if (n0 + nn < N) v = W[(size_t)(k0 + kk) * N + n0 + nn] * (gain ? gain[k0 + kk] : 1.f);
    tile[kk * 65 + nn] = v;
  }
  __syncthreads();
#pragma unroll
  for (int i = 0; i < 16; ++i) {
    int nn = i * 4 + (t >> 6), kk = t & 63;
    if (n0 + nn < N) Wt[(size_t)(n0 + nn) * 1024 + k0 + kk] = f2bf(tile[kk * 65 + nn]);
  }
  __syncthreads();
}

DI void weight_transposes(const Params& p, char* smem, unsigned mask, int bid, int nb) {
  char* ws = p.ws;
  const int cnt_all[6] = {57 * 16, 256, 256, 512, 256, 256};
  int cnt[6], total = 0;
  for (int i = 0; i < 6; ++i) { cnt[i] = ((mask >> i) & 1u) ? cnt_all[i] : 0; total += cnt[i]; }
  for (int job = bid; job < total; job += nb) {
    int j = job, w = 0;
    while (j >= cnt[w]) { j -= cnt[w]; ++w; }
    const float* W; const float* gain; u16* dst; int N;
    switch (w) {
      case 0: W = p.w_in; gain = p.norm_mix; dst = (u16*)(ws + OFF_WIN); N = INC; break;
      case 1: W = p.w_out; gain = nullptr; dst = (u16*)(ws + OFF_WOUT); N = 1024; break;
      case 2: W = p.w_xq; gain = p.norm_x; dst = (u16*)(ws + OFF_WXQ); N = 1024; break;
      case 3: W = p.w_xkv; gain = p.norm_mem; dst = (u16*)(ws + OFF_WXKV); N = 2048; break;
      case 4: W = p.w_xo; gain = nullptr; dst = (u16*)(ws + OFF_WXO); N = 1024; break;
      default: W = p.w_pq; gain = p.norm_ffn; dst = (u16*)(ws + OFF_WPQ); N = 1024; break;
    }
    transpose_tile(W, N, gain, dst, j >> 4, j & 15, (float*)smem);
  }
}
DI void keys_convert(const Params& p, int bid, int nb) {
  u16* kd = (u16*)(p.ws + OFF_KEYS);
  for (int i = bid * 256 + tidx(); i < 131072; i += nb * 256) kd[i] = f2bf(p.peer_keys[i]);
}

DI void phase_prep(const Params& p, char* smem) {
  char* ws = p.ws;
  const bool defer = gridDim.x >= 256;
  weight_transposes(p, smem, defer ? 0x09u : 0x3Fu, blockIdx.x, gridDim.x);
  rowconv(p.x, (u16*)(ws + OFF_XB), nullptr, (float*)(ws + OFF_RSTD0), T_TOK);
  rowconv(p.mem, (u16*)(ws + OFF_MEMB), nullptr, (float*)(ws + OFF_RSTDM), 1024);
  if (!defer) {
    rowconv8(p.expert_u, (unsigned char*)(ws + OFF_EU), p.norm_ffn, EU_SCALE, 16384, blockIdx.x, gridDim.x);
    rowconv8(p.expert_v, (unsigned char*)(ws + OFF_EV), nullptr, EV_SCALE, 16384, blockIdx.x, gridDim.x);
    keys_convert(p, blockIdx.x, gridDim.x);
  }
}

typedef unsigned u32x4 __attribute__((ext_vector_type(4)));
DI void gload16(u32x4& dst, const void* p) { asm volatile("global_load_dwordx4 %0, %1, off" : "=&v"(dst) : "v"(p) : "memory"); }
DI void gwait8_all(u32x4& a0, u32x4& a1, u32x4& a2, u32x4& a3, u32x4& b0, u32x4& b1, u32x4& b2, u32x4& b3) {
  asm volatile("s_waitcnt vmcnt(0)" : "+v"(a0), "+v"(a1), "+v"(a2), "+v"(a3), "+v"(b0), "+v"(b1), "+v"(b2), "+v"(b3) : : "memory");
}
DI void gwait8_keep8(u32x4& a0, u32x4& a1, u32x4& a2, u32x4& a3, u32x4& b0, u32x4& b1, u32x4& b2, u32x4& b3) {
  asm volatile("s_waitcnt vmcnt(8)" : "+v"(a0), "+v"(a1), "+v"(a2), "+v"(a3), "+v"(b0), "+v"(b1), "+v"(b2), "+v"(b3) : : "memory");
}

DI void gemm_main(const u16* __restrict__ A, const u16* __restrict__ Bt, int m0, int n0, char* smem, f32x16 (&acc)[2][2]) {
  const int tid = tidx(), lane = tid & 63, wave = tid >> 6;
  const int wm = wave >> 1, wn = wave & 1;
  u16* As = (u16*)smem;
  u16* Bs = (u16*)(smem + 36864);
  const int srow = tid >> 3, scol = (tid & 7) * 8;
  const u16* Ap = A + (size_t)(m0 + srow) * 1024 + scol;
  const u16* Bp = Bt + (size_t)(n0 + srow) * 1024 + scol;
  u32x4 r0a[4], r0b[4], r1a[4], r1b[4];
#pragma unroll
  for (int mi = 0; mi < 2; ++mi)
#pragma unroll
    for (int ni = 0; ni < 2; ++ni)
#pragma unroll
      for (int i = 0; i < 16; ++i) acc[mi][ni][i] = 0.f;
#define ISSUE(ra_, rb_, k_) { _Pragma("unroll") for (int i = 0; i < 4; ++i) { gload16(ra_[i], Ap + (size_t)i * 32 * 1024 + (k_) * 64); gload16(rb_[i], Bp + (size_t)i * 32 * 1024 + (k_) * 64); } }
#define STORE(ra_, rb_, buf_) { u16* as2 = As + (buf_) * 128 * 72; u16* bs2 = Bs + (buf_) * 128 * 72; \
    _Pragma("unroll") for (int i = 0; i < 4; ++i) { *(u32x4*)(as2 + (srow + 32 * i) * 72 + scol) = ra_[i]; *(u32x4*)(bs2 + (srow + 32 * i) * 72 + scol) = rb_[i]; } }
  auto compute = [&](int cur) {
    const u16* as = As + cur * 128 * 72;
    const u16* bs = Bs + cur * 128 * 72;
#pragma unroll
    for (int ks = 0; ks < 4; ++ks) {
      bf16x8 a[2], b[2];
#pragma unroll
      for (int mi = 0; mi < 2; ++mi) a[mi] = *(const bf16x8*)(as + (64 * wm + 32 * mi + (lane & 31)) * 72 + 16 * ks + 8 * (lane >> 5));
#pragma unroll
      for (int ni = 0; ni < 2; ++ni) b[ni] = *(const bf16x8*)(bs + (64 * wn + 32 * ni + (lane & 31)) * 72 + 16 * ks + 8 * (lane >> 5));
#pragma unroll
      for (int mi = 0; mi < 2; ++mi)
#pragma unroll
        for (int ni = 0; ni < 2; ++ni) acc[mi][ni] = MFMA32(b[ni], a[mi], acc[mi][ni]);
    }
  };
  ISSUE(r0a, r0b, 0)
  ISSUE(r1a, r1b, 1)
  gwait8_keep8(r0a[0], r0a[1], r0a[2], r0a[3], r0b[0], r0b[1], r0b[2], r0b[3]);
  STORE(r0a, r0b, 0)
  __syncthreads();
#pragma unroll 1
  for (int kk = 0; kk < 16; kk += 2) {
    const int k2 = (kk + 2 < 16) ? kk + 2 : 15, k3 = (kk + 3 < 16) ? kk + 3 : 15;
    ISSUE(r0a, r0b, k2)
    compute(0);
    gwait8_keep8(r1a[0], r1a[1], r1a[2], r1a[3], r1b[0], r1b[1], r1b[2], r1b[3]);
    STORE(r1a, r1b, 1)
    __syncthreads();
    ISSUE(r1a, r1b, k3)
    compute(1);
    gwait8_keep8(r0a[0], r0a[1], r0a[2], r0a[3], r0b[0], r0b[1], r0b[2], r0b[3]);
    STORE(r0a, r0b, 0)
    __syncthreads();
  }
  gwait8_all(r1a[0], r1a[1], r1a[2], r1a[3], r1b[0], r1b[1], r1b[2], r1b[3]);
#undef ISSUE
#undef STORE
}

DI bool tile_map(int it, int MT, int NT, int& mt, int& nt) {
  const int nb = gridDim.x >> 3;
  if ((gridDim.x & 7) != 0) {
    const int tile = blockIdx.x + it * gridDim.x;
    if (tile >= MT * NT) return false;
    mt = tile / NT; nt = tile % NT;
    return true;
  }
  const int vx = blockIdx.x & 7, lb = blockIdx.x >> 3;
  const int per = (MT >> 3) * NT;
  const int q = it * nb + lb;
  if (q >= per) return false;
  const int grp = q / (8 * NT), r = q % (8 * NT);
  mt = vx * (MT >> 3) + grp * 8 + (r & 7);
  nt = r >> 3;
  return true;
}

DI float* rs_ptr(char* smem) { return (float*)(smem + 73728); }
DI float* sq_ptr(char* smem) { return (float*)(smem + 73728 + 512); }

DI void kv_gemm(const Params& p, char* smem, int bid, int nb);
DI void acc_to_lds(f32x16 (&acc)[2][2], const float* rs, u16* Ts) {
  const int lane = tidx() & 63, wave = tidx() >> 6, wm = wave >> 1, wn = wave & 1, hh = lane >> 5;
#pragma unroll
  for (int mi = 0; mi < 2; ++mi) {
    const int rl = 64 * wm + 32 * mi + (lane & 31);
    const float sc = rs ? rs[rl] : 1.f;
#pragma unroll
    for (int ni = 0; ni < 2; ++ni)
#pragma unroll
      for (int q = 0; q < 4; ++q) {
        const int col = 64 * wn + 32 * ni + 8 * q + 4 * hh;
        *(uint2*)(Ts + rl * 136 + col) =
            make_uint2(pack2(acc[mi][ni][4 * q] * sc, acc[mi][ni][4 * q + 1] * sc), pack2(acc[mi][ni][4 * q + 2] * sc, acc[mi][ni][4 * q + 3] * sc));
      }
  }
}

DI void phase_proj(const Params& p, char* smem) {
  char* ws = p.ws;
  const int tid = tidx(), lane = tid & 63, wave = tid >> 6, wm = wave >> 1, wn = wave & 1, hh = lane >> 5;
  float* rs = rs_ptr(smem);
  u16* proj = (u16*)(ws + OFF_PROJ);
  float* ba = (float*)(ws + OFF_BA);
  for (int it = 0;; ++it) {
    int mt, nt;
    if (!tile_map(it, 256, 29, mt, nt)) break;
    const int m0 = mt * 128, n0 = nt * 128;
    f32x16 acc[2][2];
    gemm_main((const u16*)(ws + OFF_XB), (const u16*)(ws + OFF_WIN), m0, n0, smem, acc);
    if (tid < 128) rs[tid] = ((const float*)(ws + OFF_RSTD0))[m0 + tid];
    __syncthreads();
    if (n0 + 128 > 3584) {
#pragma unroll
      for (int mi = 0; mi < 2; ++mi) {
        const int rl = 64 * wm + 32 * mi + (lane & 31);
        const float sc = rs[rl];
#pragma unroll
        for (int ni = 0; ni < 2; ++ni)
#pragma unroll
          for (int q = 0; q < 4; ++q) {
            const int col = n0 + 64 * wn + 32 * ni + 8 * q + 4 * hh;
            if (col >= 3584 && col < INC)
              *(float4*)(ba + (size_t)(m0 + rl) * 8 + (col - 3584)) = make_float4(acc[mi][ni][4 * q] * sc, acc[mi][ni][4 * q + 1] * sc, acc[mi][ni][4 * q + 2] * sc, acc[mi][ni][4 * q + 3] * sc);
          }
      }
    }
    u16* Ts = (u16*)smem;
    acc_to_lds(acc, rs, Ts);
    __syncthreads();
#pragma unroll
    for (int i = 0; i < 8; ++i) {
      const int c = tid + 256 * i, row = c >> 4, col = n0 + (c & 15) * 8;
      if (col < 3584) *(uint4*)(proj + (size_t)(m0 + row) * INC + col) = *(const uint4*)(Ts + row * 136 + (c & 15) * 8);
    }
    __syncthreads();
  }
  if (gridDim.x < 256) kv_gemm(p, smem, blockIdx.x, gridDim.x);
}

DI void kv_gemm(const Params& p, char* smem, int bid, int nb) {
  char* ws = p.ws;
  const int tid = tidx(), lane = tid & 63, wave = tid >> 6, wm = wave >> 1, wn = wave & 1, hh = lane >> 5;
  float* rs = rs_ptr(smem);
  u16* kx = (u16*)(ws + OFF_KX);
  u16* vt = (u16*)(ws + OFF_VT);
  for (int t2 = bid; t2 < 128; t2 += nb) {
    const int mt = t2 >> 4, nt = t2 & 15, m0 = mt * 128, n0 = nt * 128;
    f32x16 acc[2][2];
    gemm_main((const u16*)(ws + OFF_MEMB), (const u16*)(ws + OFF_WXKV), m0, n0, smem, acc);
    if (tid < 128) rs[tid] = ((const float*)(ws + OFF_RSTDM))[m0 + tid];
    __syncthreads();
#pragma unroll
    for (int mi = 0; mi < 2; ++mi) {
      const int rl = 64 * wm + 32 * mi + (lane & 31);
      const float sc = rs[rl];
      const int row = m0 + rl, b = row >> 8, mm = row & 255;
#pragma unroll
      for (int ni = 0; ni < 2; ++ni)
#pragma unroll
        for (int q = 0; q < 4; ++q) {
          const int col = n0 + 64 * wn + 32 * ni + 8 * q + 4 * hh;
          const float v0 = acc[mi][ni][4 * q] * sc, v1 = acc[mi][ni][4 * q + 1] * sc, v2 = acc[mi][ni][4 * q + 2] * sc, v3 = acc[mi][ni][4 * q + 3] * sc;
          if (col < 1024) {
            const int head = col >> 8, d = col & 255;
            *(uint2*)(kx + ((size_t)((b * 4 + head) * 256 + mm)) * 256 + d) = make_uint2(pack2(v0, v1), pack2(v2, v3));
          } else {
            const int c2 = col - 1024, head = c2 >> 8, d = c2 & 255;
            u16* vp = vt + ((size_t)((b * 4 + head) * 256 + d)) * 256 + mm;
            vp[0] = f2bf(v0); vp[256] = f2bf(v1); vp[512] = f2bf(v2); vp[768] = f2bf(v3);
          }
        }
    }
    __syncthreads();
  }
}

DI void phase_resid(const u16* A, const u16* Bt, const float* resid_f32, u16* hb, float* ssq, char* smem) {
  const int tid = tidx();
  u16* Ts = (u16*)smem;
  for (int it = 0;; ++it) {
    int mt, nt;
    if (!tile_map(it, 256, 8, mt, nt)) break;
    const int m0 = mt * 128, n0 = nt * 128;
    f32x16 acc[2][2];
    gemm_main(A, Bt, m0, n0, smem, acc);
    acc_to_lds(acc, nullptr, Ts);
    __syncthreads();
#pragma unroll
    for (int i = 0; i < 8; ++i) {
      const int c = tid + 256 * i, row = c >> 4, c16 = c & 15;
      const size_t g = (size_t)(m0 + row) * 1024 + n0 + c16 * 8;
      float u[8], r[8];
      unpack8(*(const uint4*)(Ts + row * 136 + c16 * 8), u);
      if (resid_f32) {
        const float4 r0 = *(const float4*)(resid_f32 + g), r1 = *(const float4*)(resid_f32 + g + 4);
        r[0] = r0.x; r[1] = r0.y; r[2] = r0.z; r[3] = r0.w; r[4] = r1.x; r[5] = r1.y; r[6] = r1.z; r[7] = r1.w;
      } else {
        unpack8(*(const uint4*)(hb + g), r);
      }
      float s2 = 0.f;
#pragma unroll
      for (int k = 0; k < 8; ++k) { r[k] += u[k]; s2 += r[k] * r[k]; }
      *(uint4*)(hb + g) = pack8(r);
      s2 += __shfl_xor(s2, 1); s2 += __shfl_xor(s2, 2); s2 += __shfl_xor(s2, 4); s2 += __shfl_xor(s2, 8);
      if (c16 == 0) ssq[(size_t)(m0 + row) * 8 + nt] = s2;
    }
    __syncthreads();
  }
}

DI void phase_scaled(const u16* A, const u16* Bt, const float* ssq, u16* out, char* smem) {
  const int tid = tidx();
  float* rs = rs_ptr(smem);
  u16* Ts = (u16*)smem;
  for (int it = 0;; ++it) {
    int mt, nt;
    if (!tile_map(it, 256, 8, mt, nt)) break;
    const int m0 = mt * 128, n0 = nt * 128;
    f32x16 acc[2][2];
    gemm_main(A, Bt, m0, n0, smem, acc);
    if (tid < 128) {
      const float4* sp = (const float4*)(ssq + (size_t)(m0 + tid) * 8);
      float4 s0 = sp[0], s1 = sp[1];
      rs[tid] = rsqrtf((s0.x + s0.y + s0.z + s0.w + s1.x + s1.y + s1.z + s1.w) * (1.f / 1024.f) + EPS);
    }
    __syncthreads();
    acc_to_lds(acc, rs, Ts);
    __syncthreads();
#pragma unroll
    for (int i = 0; i < 8; ++i) {
      const int c = tid + 256 * i, row = c >> 4, c16 = c & 15;
      *(uint4*)(out + (size_t)(m0 + row) * 1024 + n0 + c16 * 8) = *(const uint4*)(Ts + row * 136 + c16 * 8);
    }
    __syncthreads();
  }
}

DI void chunk_job(const Params& p, int cj, char* smem) {
  char* ws = p.ws;
  const int tid = tidx(), lane = tid & 63, wave = tid >> 6;
  const int bh = cj >> 7, n = cj & 127, b = bh >> 2, h = bh & 3;
  const int t0 = b * SEQ + n * 64;
  u16* Kb  = (u16*)smem;
  u16* Qb  = (u16*)(smem + 17408);
  u16* Vt  = (u16*)(smem + 34816);
  u16* KGt = (u16*)(smem + 53248);
  float* gc = (float*)(smem + 71680);
  float* bt = gc + 64;
  float* As = (float*)(smem + 17408);
  u16* Tb = (u16*)smem;
  const u16* proj = (const u16*)(ws + OFF_PROJ);
  u16* QD = (u16*)p.out;
  u16* KD = (u16*)((char*)p.out + 32 * MiB);
  u16* UU = (u16*)((char*)p.out + 64 * MiB);
  u16* WW = (u16*)((char*)p.out + 96 * MiB);
  u16* IN = (u16*)(ws + OFF_EU + 16 * MiB);
  float* GL = (float*)(ws + OFF_GL);

  if (wave == 0) {
    const float* ba = (const float*)(ws + OFF_BA) + (size_t)(t0 + lane) * 8;
    const float bl = ba[h], al = ba[4 + h] + p.dn_dt_bias[h];
    const float sp = fmaxf(al, 0.f) + log1pf(expf(-fabsf(al)));
    float g = -expf(p.dn_a_log[h]) * sp;
#pragma unroll
    for (int o = 1; o < 64; o <<= 1) { float v = __shfl_up(g, o); if (lane >= o) g += v; }
    gc[lane] = g;
    bt[lane] = 1.f / (1.f + expf(-bl));
    if (lane == 63) GL[cj] = expf(g);
  }
  __syncthreads();

  {
    const int cgp = tid & 15, ts = tid >> 4;
    const float glast = gc[63];
    float eg[4], ed[4], be[4];
#pragma unroll
    for (int tt = 0; tt < 4; ++tt) { const float gv = gc[4 * ts + tt]; eg[tt] = expf(gv); ed[tt] = expf(glast - gv); be[tt] = bt[4 * ts + tt]; }
#pragma unroll 1
    for (int part = 0; part < 3; ++part) {
      const int cc = part * 512 + h * 128 + cgp * 8;
      const int cb = 1536 + cc;
      float xin[7][8];
#pragma unroll
      for (int r = 0; r < 7; ++r) {
        const int sp = n * 64 + 4 * ts - 3 + r;
        if (sp >= 0) { uint4 raw = *(const uint4*)(proj + (size_t)(t0 + 4 * ts - 3 + r) * INC + cb); unpack8(raw, xin[r]); }
        else {
#pragma unroll
          for (int c = 0; c < 8; ++c) xin[r][c] = 0.f;
        }
      }
      float o[4][8];
#pragma unroll
      for (int tt = 0; tt < 4; ++tt)
#pragma unroll
        for (int c = 0; c < 8; ++c) o[tt][c] = 0.f;
#pragma unroll
      for (int j = 0; j < 4; ++j) {
        const float4 w0 = *(const float4*)(p.dn_conv_w + j * 1536 + cc), w1 = *(const float4*)(p.dn_conv_w + j * 1536 + cc + 4);
        const float wj[8] = {w0.x, w0.y, w0.z, w0.w, w1.x, w1.y, w1.z, w1.w};
#pragma unroll
        for (int tt = 0; tt < 4; ++tt)
#pragma unroll
          for (int c = 0; c < 8; ++c) o[tt][c] += wj[c] * xin[tt + j][c];
      }
#pragma unroll
      for (int tt = 0; tt < 4; ++tt)
#pragma unroll
        for (int c = 0; c < 8; ++c) o[tt][c] = silu_f(o[tt][c]);
      if (part < 2) {
#pragma unroll
        for (int tt = 0; tt < 4; ++tt) {
          float ss = 0.f;
#pragma unroll
          for (int c = 0; c < 8; ++c) ss += o[tt][c] * o[tt][c];
          ss += __shfl_xor(ss, 1); ss += __shfl_xor(ss, 2); ss += __shfl_xor(ss, 4); ss += __shfl_xor(ss, 8);
          const float rn = rsqrtf(ss + EPS) * (part == 0 ? 0.08838834764831845f : 1.f);
#pragma unroll
          for (int c = 0; c < 8; ++c) o[tt][c] *= rn;
        }
      }
      if (part == 0) {
#pragma unroll
        for (int tt = 0; tt < 4; ++tt) {
          const int tok = 4 * ts + tt;
          *(uint4*)(Qb + tok * 136 + cgp * 8) = pack8(o[tt]);
          float qd[8];
#pragma unroll
          for (int c = 0; c < 8; ++c) qd[c] = o[tt][c] * eg[tt];
          *(uint4*)(QD + ((size_t)cj * 64 + tok) * 128 + cgp * 8) = pack8(qd);
        }
      } else if (part == 1) {
#pragma unroll
        for (int tt = 0; tt < 4; ++tt) *(uint4*)(Kb + (4 * ts + tt) * 136 + cgp * 8) = pack8(o[tt]);
#pragma unroll
        for (int c = 0; c < 8; ++c) {
          const int d = cgp * 8 + c;
          *(uint2*)(KGt + d * 72 + 4 * ts) = make_uint2(pack2(o[0][c] * be[0] * eg[0], o[1][c] * be[1] * eg[1]), pack2(o[2][c] * be[2] * eg[2], o[3][c] * be[3] * eg[3]));
          *(uint2*)(KD + ((size_t)cj * 128 + d) * 64 + 4 * ts) = make_uint2(pack2(o[0][c] * ed[0], o[1][c] * ed[1]), pack2(o[2][c] * ed[2], o[3][c] * ed[3]));
        }
      } else {
#pragma unroll
        for (int c = 0; c < 8; ++c) {
          const int d = cgp * 8 + c;
          *(uint2*)(Vt + d * 72 + 4 * ts) = make_uint2(pack2(o[0][c] * be[0], o[1][c] * be[1]), pack2(o[2][c] * be[2], o[3][c] * be[3]));
        }
      }
    }
  }
  __syncthreads();

  {
    const int wi = wave >> 1, wj = wave & 1, hh = lane >> 5;
    f32x16 aK, aQ;
#pragma unroll
    for (int i = 0; i < 16; ++i) { aK[i] = 0.f; aQ[i] = 0.f; }
    if (wi >= wj) {
#pragma unroll
      for (int ks = 0; ks < 8; ++ks) {
        const bf16x8 fk = *(const bf16x8*)(Kb + (32 * wi + (lane & 31)) * 136 + 16 * ks + 8 * hh);
        const bf16x8 fq = *(const bf16x8*)(Qb + (32 * wi + (lane & 31)) * 136 + 16 * ks + 8 * hh);
        const bf16x8 fb = *(const bf16x8*)(Kb + (32 * wj + (lane & 31)) * 136 + 16 * ks + 8 * hh);
        aK = MFMA32(fk, fb, aK);
        aQ = MFMA32(fq, fb, aQ);
      }
    }
    __syncthreads();
    const int j = 32 * wj + (lane & 31);
    const float gj = gc[j];
#pragma unroll
    for (int ii = 0; ii < 16; ++ii) {
      const int i = 32 * wi + crow32(ii, hh);
      const float dec = (i >= j) ? expf(gc[i] - gj) : 0.f;
      As[i * 68 + j] = (i > j) ? aK[ii] * bt[i] * dec : 0.f;
      IN[((size_t)cj * 64 + i) * 64 + j] = f2bf((i >= j) ? aQ[ii] * dec : 0.f);
    }
  }
  __syncthreads();

  if (wave == 0) {
    float xcol[64];
#pragma unroll
    for (int i = 0; i < 64; ++i) {
      int lv = lane;
      asm volatile("" : "+v"(lv));
      float s = (i == lv) ? 1.f : 0.f;
#pragma unroll
      for (int j4 = 0; j4 < (i + 3) / 4; ++j4) {
        const float4 a4 = *(const float4*)(As + i * 68 + 4 * j4);
        if (4 * j4 + 0 < i) s -= a4.x * xcol[4 * j4 + 0];
        if (4 * j4 + 1 < i) s -= a4.y * xcol[4 * j4 + 1];
        if (4 * j4 + 2 < i) s -= a4.z * xcol[4 * j4 + 2];
        if (4 * j4 + 3 < i) s -= a4.w * xcol[4 * j4 + 3];
      }
      xcol[i] = s;
      asm volatile("" ::: "memory");
    }
#pragma unroll
    for (int i = 0; i < 64; ++i) Tb[i * 72 + lane] = f2bf(xcol[i]);
  }
  __syncthreads();

  {
    const int hh = lane >> 5;
    f32x16 aU[2], aW[2];
#pragma unroll
    for (int mi = 0; mi < 2; ++mi)
#pragma unroll
      for (int i = 0; i < 16; ++i) { aU[mi][i] = 0.f; aW[mi][i] = 0.f; }
#pragma unroll
    for (int ks = 0; ks < 4; ++ks) {
      const bf16x8 bv = *(const bf16x8*)(Vt + (32 * wave + (lane & 31)) * 72 + 16 * ks + 8 * hh);
      const bf16x8 bk = *(const bf16x8*)(KGt + (32 * wave + (lane & 31)) * 72 + 16 * ks + 8 * hh);
#pragma unroll
      for (int mi = 0; mi < 2; ++mi) {
        const bf16x8 a = *(const bf16x8*)(Tb + (32 * mi + (lane & 31)) * 72 + 16 * ks + 8 * hh);
        aU[mi] = MFMA32(a, bv, aU[mi]);
        aW[mi] = MFMA32(a, bk, aW[mi]);
      }
    }
    const int d = 32 * wave + (lane & 31);
#pragma unroll
    for (int mi = 0; mi < 2; ++mi)
#pragma unroll
      for (int ii = 0; ii < 16; ++ii) {
        const int i = 32 * mi + crow32(ii, hh);
        UU[((size_t)cj * 64 + i) * 128 + d] = f2bf(aU[mi][ii]);
        WW[((size_t)cj * 64 + i) * 128 + d] = f2bf(aW[mi][ii]);
      }
  }
  __syncthreads();
}

DI void conv_items(const Params& p, int bid, int nb) {
  char* ws = p.ws;
  const u16* proj = (const u16*)(ws + OFF_PROJ);
  u16* ymix = (u16*)(ws + OFF_YMIX);
  for (int item = bid * 256 + tidx(); item < T_TOK * 64; item += nb * 256) {
    const int t = item >> 6, c0 = (item & 63) * 8;
    const int s = t & (SEQ - 1);
    float accv[8];
#pragma unroll
    for (int c = 0; c < 8; ++c) accv[c] = 0.f;
#pragma unroll
    for (int k = 0; k < 3; ++k) {
      if (s - 2 + k >= 0) {
        const size_t row = (size_t)(t - 2 + k) * INC;
        float cg8[8], hc8[8];
        unpack8(*(const uint4*)(proj + row + 512 + c0), cg8);
        unpack8(*(const uint4*)(proj + row + 1024 + c0), hc8);
        const float4 w0 = *(const float4*)(p.conv_w + k * 512 + c0), w1 = *(const float4*)(p.conv_w + k * 512 + c0 + 4);
        const float wk[8] = {w0.x, w0.y, w0.z, w0.w, w1.x, w1.y, w1.z, w1.w};
#pragma unroll
        for (int c = 0; c < 8; ++c) accv[c] += wk[c] * cg8[c] * hc8[c];
      }
    }
    float bg[8];
    unpack8(*(const uint4*)(proj + (size_t)t * INC + c0), bg);
#pragma unroll
    for (int c = 0; c < 8; ++c) accv[c] *= bg[c];
    *(uint4*)(ymix + (size_t)t * 1024 + c0) = pack8(accv);
  }
}

DI void phase_chunks(const Params& p, char* smem) {
  char* ws = p.ws;
  for (int cj = blockIdx.x; cj < 2048; cj += gridDim.x) chunk_job(p, cj, smem);
  if (gridDim.x < 256) conv_items(p, blockIdx.x, gridDim.x);
}

struct ScanFrag {
  bf16x8 wf[4], qf[4], inf[2], kf[2][2];
  float uf[4];
  float gl;
};

DI void phase_scan(const Params& p, char* smem) {
  char* ws = p.ws;
  if (blockIdx.x >= 128) {
    if (gridDim.x >= 256) {
      const int bid = blockIdx.x - 128, nb = gridDim.x - 128;
      conv_items(p, bid, nb);
      kv_gemm(p, smem, bid, nb);
      weight_transposes(p, smem, 0x36u, bid, nb);
      keys_convert(p, bid, nb);
      rowconv8(p.expert_u, (unsigned char*)(ws + OFF_EU), p.norm_ffn, EU_SCALE, 16384, bid, nb);
      rowconv8(p.expert_v, (unsigned char*)(ws + OFF_EV), nullptr, EV_SCALE, 16384, bid, nb);
    }
    return;
  }
  const int tid = tidx(), lane = tid & 63, w = tid >> 6, m = lane & 15, g = lane >> 4;
  const int bid = blockIdx.x;
  const int bh = (bid & 7) + 8 * ((bid >> 3) & 1), sl = bid >> 4;
  const int b = bh >> 2, h = bh & 3, e0 = sl * 16;
  u16* ST = (u16*)smem;
  u16* VT = (u16*)(smem + 4352);
  const u16* QD = (const u16*)p.out;
  const u16* KD = (const u16*)((const char*)p.out + 32 * MiB);
  const u16* UU = (const u16*)((const char*)p.out + 64 * MiB);
  const u16* WW = (const u16*)((const char*)p.out + 96 * MiB);
  const u16* IN = (const u16*)(ws + OFF_EU + 16 * MiB);
  const float* GL = (const float*)(ws + OFF_GL);
  u16* ymix = (u16*)(ws + OFF_YMIX);

  for (int i = tid; i < 16 * 136 / 2; i += 256) ((uint32_t*)ST)[i] = 0u;
  f32x4 Sacc[2];
#pragma unroll
  for (int mt = 0; mt < 2; ++mt)
#pragma unroll
    for (int j = 0; j < 4; ++j) Sacc[mt][j] = 0.f;

  auto load = [&](int c, ScanFrag& f) {
    const u16* wp = WW + ((size_t)c * 64 + 16 * w + m) * 128 + 8 * g;
    const u16* qp = QD + ((size_t)c * 64 + 16 * w + m) * 128 + 8 * g;
#pragma unroll
    for (int ks = 0; ks < 4; ++ks) { f.wf[ks] = *(const bf16x8*)(wp + 32 * ks); f.qf[ks] = *(const bf16x8*)(qp + 32 * ks); }
    const u16* ip = IN + ((size_t)c * 64 + 16 * w + m) * 64 + 8 * g;
#pragma unroll
    for (int ks = 0; ks < 2; ++ks) f.inf[ks] = *(const bf16x8*)(ip + 32 * ks);
#pragma unroll
    for (int mt = 0; mt < 2; ++mt)
#pragma unroll
      for (int ks = 0; ks < 2; ++ks) f.kf[mt][ks] = *(const bf16x8*)(KD + ((size_t)c * 128 + 32 * w + 16 * mt + m) * 64 + 32 * ks + 8 * g);
#pragma unroll
    for (int j = 0; j < 4; ++j) f.uf[j] = bf2f(UU[((size_t)c * 64 + 16 * w + 4 * g + j) * 128 + e0 + m]);
    f.gl = GL[c];
  };

  const int c0 = bh * 128;
  const int t0 = b * SEQ;
  ScanFrag cur, nxt;
  load(c0, cur);
  nxt = cur;
  __syncthreads();
  for (int n = 0; n < 128; ++n) {
    if (n + 1 < 128) load(c0 + n + 1, nxt);
    f32x4 av = {0.f, 0.f, 0.f, 0.f}, aq = {0.f, 0.f, 0.f, 0.f};
#pragma unroll
    for (int ks = 0; ks < 4; ++ks) {
      const bf16x8 sf = *(const bf16x8*)(ST + m * 136 + 32 * ks + 8 * g);
      av = MFMA16(cur.wf[ks], sf, av);
      aq = MFMA16(cur.qf[ks], sf, aq);
    }
    float vn[4];
#pragma unroll
    for (int j = 0; j < 4; ++j) vn[j] = cur.uf[j] - av[j];
    *(uint2*)(VT + m * 72 + 16 * w + 4 * g) = make_uint2(pack2(vn[0], vn[1]), pack2(vn[2], vn[3]));
    __syncthreads();
    bf16x8 vf[2];
#pragma unroll
    for (int ks = 0; ks < 2; ++ks) vf[ks] = *(const bf16x8*)(VT + m * 72 + 32 * ks + 8 * g);
#pragma unroll
    for (int ks = 0; ks < 2; ++ks) aq = MFMA16(cur.inf[ks], vf[ks], aq);
#pragma unroll
    for (int j = 0; j < 4; ++j)
      ymix[(size_t)(t0 + n * 64 + 16 * w + 4 * g + j) * 1024 + 512 + h * 128 + e0 + m] = f2bf(aq[j]);
#pragma unroll
    for (int mt = 0; mt < 2; ++mt) {
#pragma unroll
      for (int j = 0; j < 4; ++j) Sacc[mt][j] *= cur.gl;
#pragma unroll
      for (int ks = 0; ks < 2; ++ks) Sacc[mt] = MFMA16(cur.kf[mt][ks], vf[ks], Sacc[mt]);
      *(uint2*)(ST + m * 136 + 32 * w + 16 * mt + 4 * g) = make_uint2(pack2(Sacc[mt][0], Sacc[mt][1]), pack2(Sacc[mt][2], Sacc[mt][3]));
    }
    __syncthreads();
    cur = nxt;
  }
}

DI void phase_gate(const Params& p) {
  char* ws = p.ws;
  const u16* proj = (const u16*)(ws + OFF_PROJ);
  u16* ymix = (u16*)(ws + OFF_YMIX);
  for (int item = blockIdx.x * 256 + tidx(); item < T_TOK * 64; item += gridDim.x * 256) {
    const int t = item >> 6, hh = (item >> 4) & 3, part = item & 15;
    u16* op = ymix + (size_t)t * 1024 + 512 + hh * 128 + part * 8;
    float o[8], z[8];
    unpack8(*(const uint4*)op, o);
    unpack8(*(const uint4*)(proj + (size_t)t * INC + 3072 + hh * 128 + part * 8), z);
    float ss = 0.f;
#pragma unroll
    for (int c = 0; c < 8; ++c) ss += o[c] * o[c];
    ss += __shfl_xor(ss, 1); ss += __shfl_xor(ss, 2); ss += __shfl_xor(ss, 4); ss += __shfl_xor(ss, 8);
    const float rn = rsqrtf(ss * (1.f / 128.f) + EPS);
    const float4 g0 = *(const float4*)(p.dn_norm + part * 8), g1 = *(const float4*)(p.dn_norm + part * 8 + 4);
    const float gg[8] = {g0.x, g0.y, g0.z, g0.w, g1.x, g1.y, g1.z, g1.w};
#pragma unroll
    for (int c = 0; c < 8; ++c) o[c] = o[c] * rn * gg[c] * silu_f(z[c]);
    *(uint4*)op = pack8(o);
  }
}

DI void phase_attn(const Params& p, char* smem) {
  char* ws = p.ws;
  const int tid = tidx(), lane = tid & 63, wave = tid >> 6, m = lane & 15, g = lane >> 4;
  const u16* QX = (const u16*)(ws + OFF_QX);
  const u16* KX = (const u16*)(ws + OFF_KX);
  const u16* VTp = (const u16*)(ws + OFF_VT);
  u16* OX = (u16*)(ws + OFF_OX);
  u16* Kc = (u16*)smem;
  u16* Vc = (u16*)(smem + 34816);
  for (int job = blockIdx.x; job < 2048; job += gridDim.x) {
    const int head = job & 3, qt = (job >> 2) & 127, b = job >> 9;
    const size_t qrow = (size_t)b * SEQ + qt * 64 + wave * 16;
    bf16x8 qf[8];
#pragma unroll
    for (int ks = 0; ks < 8; ++ks) qf[ks] = *(const bf16x8*)(QX + (qrow + m) * 1024 + head * 256 + 32 * ks + 8 * g);
    const u16* kb = KX + (size_t)(b * 4 + head) * 65536;
    const u16* vb = VTp + (size_t)(b * 4 + head) * 65536;
    const u16* ksrc = kb + (size_t)(tid >> 5) * 256 + (tid & 31) * 8;
    const u16* vsrc = vb + (size_t)(tid >> 3) * 256 + (tid & 7) * 8;
    u16* kdst = Kc + (tid >> 5) * 264 + (tid & 31) * 8;
    u16* vdst = Vc + (tid >> 3) * 72 + (tid & 7) * 8;

    u32x4 st[8];
#define ATT_ISSUE_K(c_) { _Pragma("unroll") for (int i = 0; i < 8; ++i) gload16(st[i], ksrc + (size_t)((c_) * 64 + i * 8) * 256); }
#define ATT_ISSUE_V(c_) { _Pragma("unroll") for (int i = 0; i < 8; ++i) gload16(st[i], vsrc + (size_t)(i * 32) * 256 + (c_) * 64); }
#define ATT_LAND_K() { gwait8_all(st[0], st[1], st[2], st[3], st[4], st[5], st[6], st[7]); \
                       _Pragma("unroll") for (int i = 0; i < 8; ++i) *(u32x4*)(kdst + i * 8 * 264) = st[i]; }
#define ATT_LAND_V() { gwait8_all(st[0], st[1], st[2], st[3], st[4], st[5], st[6], st[7]); \
                       _Pragma("unroll") for (int i = 0; i < 8; ++i) *(u32x4*)(vdst + i * 32 * 72) = st[i]; }
    f32x4 s[16];
#pragma unroll
    for (int mt = 0; mt < 16; ++mt) s[mt] = {0.f, 0.f, 0.f, 0.f};
    ATT_ISSUE_K(0)
#pragma unroll
    for (int kc = 0; kc < 4; ++kc) {
      ATT_LAND_K()
      if (kc < 3) ATT_ISSUE_K(kc + 1) else ATT_ISSUE_V(0)
      __syncthreads();
      const u16* kbase = Kc + m * 264 + 8 * g;
      asm volatile("" : "+v"(kbase));
#pragma unroll
      for (int mt2 = 0; mt2 < 4; ++mt2)
#pragma unroll
        for (int ks = 0; ks < 8; ++ks) {
          const bf16x8 a = *(const bf16x8*)(kbase + 16 * mt2 * 264 + 32 * ks);
          s[kc * 4 + mt2] = MFMA16(a, qf[ks], s[kc * 4 + mt2]);
          if (ks == 7) asm volatile("" ::: "memory");
        }
      __syncthreads();
    }
    float mx = -1e30f;
#pragma unroll
    for (int mt = 0; mt < 16; ++mt)
#pragma unroll
      for (int j = 0; j < 4; ++j) { s[mt][j] *= 0.0625f; mx = fmaxf(mx, s[mt][j]); }
    mx = fmaxf(mx, __shfl_xor(mx, 16)); mx = fmaxf(mx, __shfl_xor(mx, 32));
    float sum = 0.f;
#pragma unroll
    for (int mt = 0; mt < 16; ++mt)
#pragma unroll
      for (int j = 0; j < 4; ++j) { s[mt][j] = __expf(s[mt][j] - mx); sum += s[mt][j]; }
    sum += __shfl_xor(sum, 16); sum += __shfl_xor(sum, 32);
    const float inv = 1.f / sum;
    bf16x8 pf[8];
#pragma unroll
    for (int k2 = 0; k2 < 8; ++k2) {
      uint4 u = make_uint4(pack2(s[2 * k2][0], s[2 * k2][1]), pack2(s[2 * k2][2], s[2 * k2][3]),
                           pack2(s[2 * k2 + 1][0], s[2 * k2 + 1][1]), pack2(s[2 * k2 + 1][2], s[2 * k2 + 1][3]));
      pf[k2] = __builtin_bit_cast(bf16x8, u);
    }
    float invr[4];
#pragma unroll
    for (int j = 0; j < 4; ++j) invr[j] = __shfl(inv, 4 * g + j);
    f32x4 o[16];
#pragma unroll
    for (int nt = 0; nt < 16; ++nt) o[nt] = {0.f, 0.f, 0.f, 0.f};
#pragma unroll
    for (int vc = 0; vc < 4; ++vc) {
      ATT_LAND_V()
      if (vc < 3) ATT_ISSUE_V(vc + 1)
      __syncthreads();
      const u16* vbase = Vc + m * 72 + 4 * g;
      asm volatile("" : "+v"(vbase));
#pragma unroll
      for (int nt = 0; nt < 16; ++nt) {
#pragma unroll
        for (int k2l = 0; k2l < 2; ++k2l) {
          const uint2 lo = *(const uint2*)(vbase + 16 * nt * 72 + 32 * k2l);
          const uint2 hi = *(const uint2*)(vbase + 16 * nt * 72 + 32 * k2l + 16);
          const uint4 u = make_uint4(lo.x, lo.y, hi.x, hi.y);
          o[nt] = MFMA16(pf[2 * vc + k2l], __builtin_bit_cast(bf16x8, u), o[nt]);
        }
        if ((nt & 3) == 3) asm volatile("" ::: "memory");
      }
      __syncthreads();
    }
#undef ATT_ISSUE_K
#undef ATT_ISSUE_V
#undef ATT_LAND_K
#undef ATT_LAND_V
#pragma unroll
    for (int j = 0; j < 4; ++j) {
      u16* ob = OX + (qrow + 4 * g + j) * 1024 + head * 256 + m;
      asm volatile("" : "+v"(ob));
#pragma unroll
      for (int nt = 0; nt < 16; ++nt) ob[16 * nt] = f2bf(o[nt][j] * invr[j]);
    }
  }
}

DI uint32_t ordf(float f) { uint32_t u = __float_as_uint(f); return u ^ ((uint32_t)((int32_t)u >> 31) | 0x80000000u); }
DI float unordf(uint32_t k) { return __uint_as_float(k ^ ((~(uint32_t)((int32_t)k >> 31)) | 0x80000000u)); }
DI void ins32(uint32_t (&top)[16], uint32_t x) {
#pragma unroll
  for (int i = 0; i < 16; ++i) { const uint32_t hi = max(top[i], x); x = min(top[i], x); top[i] = hi; }
}
DI void ins64(uint32_t (&tk)[16], uint32_t (&tv)[16], uint32_t xk, uint32_t xv) {
#pragma unroll
  for (int i = 0; i < 16; ++i) {
    const bool gt = xk > tk[i];
    const uint32_t nk = gt ? xk : tk[i], nv = gt ? xv : tv[i];
    xk = gt ? tk[i] : xk; xv = gt ? tv[i] : xv;
    tk[i] = nk; tv[i] = nv;
  }
}

DI void sort16_desc(uint32_t (&v)[16]) {
#pragma unroll
  for (int k = 2; k <= 16; k <<= 1)
#pragma unroll
    for (int j = k >> 1; j > 0; j >>= 1)
#pragma unroll
      for (int i = 0; i < 16; ++i) {
        const int l = i ^ j;
        if (l > i) {
          const uint32_t hi = max(v[i], v[l]), lo = min(v[i], v[l]);
          if ((i & k) == 0) { v[i] = hi; v[l] = lo; } else { v[i] = lo; v[l] = hi; }
        }
      }
}
DI void merge16_desc(uint32_t (&a)[16], const uint32_t (&b)[16]) {
#pragma unroll
  for (int i = 0; i < 16; ++i) a[i] = max(a[i], b[15 - i]);
#pragma unroll
  for (int st = 8; st >= 1; st >>= 1)
#pragma unroll
    for (int i = 0; i < 16; ++i)
      if ((i & st) == 0) { const uint32_t hi = max(a[i], a[i + st]), lo = min(a[i], a[i + st]); a[i] = hi; a[i + st] = lo; }
}

__device__ constexpr int PAIR_I[50] = {0,0,0,0,0,0,0,0,0,0,0,0,0,0,0,0,1,1,1,1,1,1,1,1,2,2,2,2,2,3,3,3,3,4,4,4,5,5,6,6,7,7,8,9,10,11,12,13,14,15};
__device__ constexpr int PAIR_J[50] = {0,1,2,3,4,5,6,7,8,9,10,11,12,13,14,15,0,1,2,3,4,5,6,7,0,1,2,3,4,0,1,2,3,0,1,2,0,1,0,1,0,1,0,0,0,0,0,0,0,0};

DI void topk_block(const u16* qrow0, int qstride, int hd, size_t tok0, const u16* KEYS, int* SELI, float* SELG) {
  const int lane = tidx() & 63, l31 = lane & 31, hh = lane >> 5;
  const uint32_t hh4 = (uint32_t)hh << 2;
  {
    const size_t tok = tok0 + l31;
    uint32_t top[2][16];
#pragma unroll
    for (int pp = 0; pp < 2; ++pp) {
      bf16x8 qf[4];
#pragma unroll
      for (int ks = 0; ks < 4; ++ks) qf[ks] = *(const bf16x8*)(qrow0 + (size_t)l31 * qstride + pp * 64 + 16 * ks + 8 * hh);
      f32x16 acc[4];
#pragma unroll
      for (int mt = 0; mt < 4; ++mt) {
#pragma unroll
        for (int i = 0; i < 16; ++i) acc[mt][i] = 0.f;
#pragma unroll
        for (int ks = 0; ks < 4; ++ks) {
          const bf16x8 a = *(const bf16x8*)(KEYS + (size_t)((hd * 2 + pp) * 128 + 32 * mt + l31) * 64 + 16 * ks + 8 * hh);
          acc[mt] = MFMA32(a, qf[ks], acc[mt]);
        }
      }
      uint32_t lst[4][16];
#pragma unroll
      for (int mt = 0; mt < 4; ++mt) {
#pragma unroll
        for (int i = 0; i < 16; ++i) {
          const uint32_t kc = (uint32_t)(127 - (32 * mt + (i & 3) + 8 * (i >> 2)));
          lst[mt][i] = ((ordf(acc[mt][i]) & 0xFFFFFF80u) | kc) ^ hh4;
        }
        sort16_desc(lst[mt]);
      }
      merge16_desc(lst[0], lst[1]);
      merge16_desc(lst[2], lst[3]);
      merge16_desc(lst[0], lst[2]);
#pragma unroll
      for (int i = 0; i < 16; ++i) top[pp][i] = lst[0][i];
      uint32_t c[16];
#pragma unroll
      for (int i = 0; i < 16; ++i) c[i] = max(top[pp][i], (uint32_t)__shfl_xor((int)top[pp][15 - i], 32));
#pragma unroll
      for (int st = 8; st >= 1; st >>= 1)
#pragma unroll
        for (int i = 0; i < 16; ++i)
          if ((i & st) == 0) { const uint32_t hi = max(c[i], c[i + st]), lo = min(c[i], c[i + st]); c[i] = hi; c[i + st] = lo; }
#pragma unroll
      for (int i = 0; i < 16; ++i) top[pp][i] = c[i];
    }
    uint32_t tk[16], tv[16];
#pragma unroll
    for (int i = 0; i < 16; ++i) { tk[i] = 0u; tv[i] = 0u; }
#pragma unroll
    for (int q = 0; q < 25; ++q) {
      const int ia = PAIR_I[2 * q], ja = PAIR_J[2 * q], ib = PAIR_I[2 * q + 1], jb = PAIR_J[2 * q + 1];
      const uint32_t k1 = hh ? top[0][ib] : top[0][ia];
      const uint32_t k2 = hh ? top[1][jb] : top[1][ja];
      const float xs = unordf(k1 & 0xFFFFFF80u) + unordf(k2 & 0xFFFFFF80u);
      const uint32_t xv = (127u - (k1 & 127u)) * 128u + (127u - (k2 & 127u));
      ins64(tk, tv, ordf(xs), xv);
    }
    {
      uint32_t ck[16], cv[16];
#pragma unroll
      for (int i = 0; i < 16; ++i) {
        const uint32_t ok = (uint32_t)__shfl_xor((int)tk[15 - i], 32), ov = (uint32_t)__shfl_xor((int)tv[15 - i], 32);
        const bool gt = ok > tk[i];
        ck[i] = gt ? ok : tk[i]; cv[i] = gt ? ov : tv[i];
      }
#pragma unroll
      for (int i = 0; i < 16; ++i) { tk[i] = ck[i]; tv[i] = cv[i]; }
    }
    float e[16], sum = 0.f;
    uint32_t mk = tk[0];
#pragma unroll
    for (int i = 1; i < 16; ++i) mk = max(mk, tk[i]);
    const float mx = unordf(mk);
#pragma unroll
    for (int i = 0; i < 16; ++i) { e[i] = __expf(unordf(tk[i]) - mx); sum += e[i]; }
    const float inv = 1.f / sum;
    int* ip = SELI + (tok * 8 + hd) * 16;
    float* gp = SELG + (tok * 8 + hd) * 16;
    if (hh == 0) {
      *(uint4*)ip = make_uint4(tv[0], tv[1], tv[2], tv[3]);
      *(uint4*)(ip + 4) = make_uint4(tv[4], tv[5], tv[6], tv[7]);
      *(uint4*)(ip + 8) = make_uint4(tv[8], tv[9], tv[10], tv[11]);
      *(uint4*)(ip + 12) = make_uint4(tv[12], tv[13], tv[14], tv[15]);
      *(float4*)gp = make_float4(e[0] * inv, e[1] * inv, e[2] * inv, e[3] * inv);
      *(float4*)(gp + 4) = make_float4(e[4] * inv, e[5] * inv, e[6] * inv, e[7] * inv);
      *(float4*)(gp + 8) = make_float4(e[8] * inv, e[9] * inv, e[10] * inv, e[11] * inv);
      *(float4*)(gp + 12) = make_float4(e[12] * inv, e[13] * inv, e[14] * inv, e[15] * inv);
    }
  }
}

DI void phase_pq_topk(const Params& p, char* smem) {
  char* ws = p.ws;
  const int tid = tidx(), lane = tid & 63, wave = tid >> 6, wm = wave >> 1, wn = wave & 1, hh = lane >> 5;
  float* rs = rs_ptr(smem);
  const float* ssq = (const float*)(ws + OFF_SSQ2);
  u16* Qs = (u16*)smem;
  for (int it = 0;; ++it) {
    int mt, nt;
    if (!tile_map(it, 256, 8, mt, nt)) break;
    const int m0 = mt * 128, n0 = nt * 128;
    f32x16 acc[2][2];
    gemm_main((const u16*)(ws + OFF_XB), (const u16*)(ws + OFF_WPQ), m0, n0, smem, acc);
    if (tid < 128) {
      const float4* sp = (const float4*)(ssq + (size_t)(m0 + tid) * 8);
      float4 s0 = sp[0], s1 = sp[1];
      rs[tid] = rsqrtf((s0.x + s0.y + s0.z + s0.w + s1.x + s1.y + s1.z + s1.w) * (1.f / 1024.f) + EPS);
    }
    __syncthreads();
#pragma unroll
    for (int mi = 0; mi < 2; ++mi) {
      const int rl = 64 * wm + 32 * mi + (lane & 31);
      const float sc = rs[rl];
#pragma unroll
      for (int ni = 0; ni < 2; ++ni)
#pragma unroll
        for (int q = 0; q < 4; ++q) {
          const int col = 64 * wn + 32 * ni + 8 * q + 4 * hh;
          *(uint2*)(Qs + rl * 136 + col) =
              make_uint2(pack2(acc[mi][ni][4 * q] * sc, acc[mi][ni][4 * q + 1] * sc), pack2(acc[mi][ni][4 * q + 2] * sc, acc[mi][ni][4 * q + 3] * sc));
        }
    }
    __syncthreads();
    topk_block(Qs + 32 * wave * 136, 136, nt, (size_t)m0 + 32 * wave, (const u16*)(ws + OFF_KEYS), (int*)(ws + OFF_SELI), (float*)(ws + OFF_SELG));
    __syncthreads();
  }
}

DI bf16x8 fp8x8_to_bf16(uint32_t d0, uint32_t d1) {
  const bf16x2v c0 = __builtin_amdgcn_cvt_scalef32_pk_bf16_fp8((int)d0, 1.0f, false);
  const bf16x2v c1 = __builtin_amdgcn_cvt_scalef32_pk_bf16_fp8((int)d0, 1.0f, true);
  const bf16x2v c2 = __builtin_amdgcn_cvt_scalef32_pk_bf16_fp8((int)d1, 1.0f, false);
  const bf16x2v c3 = __builtin_amdgcn_cvt_scalef32_pk_bf16_fp8((int)d1, 1.0f, true);
  const uint4 u = make_uint4(__builtin_bit_cast(uint32_t, c0), __builtin_bit_cast(uint32_t, c1), __builtin_bit_cast(uint32_t, c2), __builtin_bit_cast(uint32_t, c3));
  return __builtin_bit_cast(bf16x8, u);
}

DI void phase_peer(const Params& p, char* smem, float* dst) {
  char* ws = p.ws;
  const int tid = tidx(), lane = tid & 63, wave = tid >> 6, m = lane & 15, g = lane >> 4;
  const u16* HB = (const u16*)(ws + OFF_XB);
  const unsigned char* EU = (const unsigned char*)(ws + OFF_EU);
  const unsigned char* EV = (const unsigned char*)(ws + OFF_EV);
  const int* SELI = (const int*)(ws + OFF_SELI);
  const float* SELG = (const float*)(ws + OFF_SELG);
  const float* SSQ = (const float*)(ws + OFF_SSQ2);
  float* coef = (float*)(smem + wave * 1024);
  int* idxs = (int*)(smem + wave * 1024 + 512);
  for (int tile = blockIdx.x; tile < T_TOK / 4; tile += gridDim.x) {
    const size_t t = (size_t)tile * 4 + wave;
    const float4 q0 = *(const float4*)(SSQ + t * 8), q1 = *(const float4*)(SSQ + t * 8 + 4);
    const float rstd = rsqrtf((q0.x + q0.y + q0.z + q0.w + q1.x + q1.y + q1.z + q1.w) * (1.f / 1024.f) + EPS) * (1.f / EU_SCALE);
    int myidx[8];
#pragma unroll
    for (int grp = 0; grp < 8; ++grp) myidx[grp] = SELI[t * 128 + grp * 16 + m];
    f32x4 acc[8];
#pragma unroll
    for (int grp = 0; grp < 8; ++grp) acc[grp] = {0.f, 0.f, 0.f, 0.f};
    for (int kb2 = 0; kb2 < 8; ++kb2) {
      bf16x8 xf[4];
#pragma unroll
      for (int j = 0; j < 4; ++j) xf[j] = *(const bf16x8*)(HB + t * 1024 + kb2 * 128 + g * 32 + 8 * j);
      uint4 raw0[8], raw1[8];
#pragma unroll
      for (int grp = 0; grp < 8; ++grp) {
        const unsigned char* up = EU + (size_t)myidx[grp] * 1024 + kb2 * 128 + g * 32;
        raw0[grp] = *(const uint4*)up;
        raw1[grp] = *(const uint4*)(up + 16);
      }
#pragma unroll
      for (int grp = 0; grp < 8; ++grp) {
        acc[grp] = MFMA16(fp8x8_to_bf16(raw0[grp].x, raw0[grp].y), xf[0], acc[grp]);
        acc[grp] = MFMA16(fp8x8_to_bf16(raw0[grp].z, raw0[grp].w), xf[1], acc[grp]);
        acc[grp] = MFMA16(fp8x8_to_bf16(raw1[grp].x, raw1[grp].y), xf[2], acc[grp]);
        acc[grp] = MFMA16(fp8x8_to_bf16(raw1[grp].z, raw1[grp].w), xf[3], acc[grp]);
      }
    }
    if (g == 0) {
#pragma unroll
      for (int grp = 0; grp < 8; ++grp) idxs[grp * 16 + m] = myidx[grp];
    }
    if (m == 0) {
#pragma unroll
      for (int grp = 0; grp < 8; ++grp)
#pragma unroll
        for (int j = 0; j < 4; ++j) {
          const int e = grp * 16 + 4 * g + j;
          const float a = acc[grp][j] * rstd;
          const float ge = 0.5f * a * (1.f + erff(a * 0.7071067811865475f));
          coef[e] = SELG[t * 128 + e] * ge * (1.f / EV_SCALE);
        }
    }
    __syncthreads();
    f32x2 y[8];
#pragma unroll
    for (int i = 0; i < 8; ++i) y[i] = {0.f, 0.f};
#pragma unroll 8
    for (int e = 0; e < 128; ++e) {
      const float c = coef[e];
      const f32x2 c2 = {c, c};
      const uint4 r = *(const uint4*)(EV + (size_t)idxs[e] * 1024 + lane * 16);
      y[0] += c2 * __builtin_amdgcn_cvt_pk_f32_fp8((int)r.x, false);
      y[1] += c2 * __builtin_amdgcn_cvt_pk_f32_fp8((int)r.x, true);
      y[2] += c2 * __builtin_amdgcn_cvt_pk_f32_fp8((int)r.y, false);
      y[3] += c2 * __builtin_amdgcn_cvt_pk_f32_fp8((int)r.y, true);
      y[4] += c2 * __builtin_amdgcn_cvt_pk_f32_fp8((int)r.z, false);
      y[5] += c2 * __builtin_amdgcn_cvt_pk_f32_fp8((int)r.z, true);
      y[6] += c2 * __builtin_amdgcn_cvt_pk_f32_fp8((int)r.w, false);
      y[7] += c2 * __builtin_amdgcn_cvt_pk_f32_fp8((int)r.w, true);
    }
    float* dp = dst + t * 1024 + lane * 16;
    float hv[16];
    unpack8(*(const uint4*)(HB + t * 1024 + lane * 16), hv);
    unpack8(*(const uint4*)(HB + t * 1024 + lane * 16 + 8), hv + 8);
    float ss = 0.f;
#pragma unroll
    for (int i = 0; i < 8; ++i) { hv[2 * i] += y[i][0]; hv[2 * i + 1] += y[i][1]; }
#pragma unroll
    for (int i = 0; i < 16; ++i) ss += hv[i] * hv[i];
    ss = wave_sum(ss);
    const float rn = rsqrtf(ss * (1.f / 1024.f) + EPS);
#pragma unroll
    for (int q = 0; q < 4; ++q) {
      const float4 n4 = *(const float4*)(p.norm_final + lane * 16 + 4 * q);
      *(float4*)(dp + 4 * q) = make_float4(hv[4 * q] * rn * n4.x, hv[4 * q + 1] * rn * n4.y, hv[4 * q + 2] * rn * n4.z, hv[4 * q + 3] * rn * n4.w);
    }
    __syncthreads();
  }
}

#define XB_TMO      128
#define XB_XCNT(j)  (256  + 64 * (j))
#define XB_XSUB(j)  (1280 + 64 * (j))
#define XB_XGEN(j)  (2304 + 64 * (j))
#define XB_TOP      3328
#define XB_TOPGEN   3392
#define XCD_BAR_WORDS 3456
#define XB_SPIN_CAP (1u << 22)
#define LAS __attribute__((address_space(3)))
DI unsigned xb_ld(unsigned* p)              { return __hip_atomic_load(p, __ATOMIC_RELAXED, __HIP_MEMORY_SCOPE_AGENT); }
DI unsigned xb_add(unsigned* p, unsigned v) { return __hip_atomic_fetch_add(p, v, __ATOMIC_RELAXED, __HIP_MEMORY_SCOPE_AGENT); }
DI unsigned xb_xcc_id() { return (unsigned)__builtin_amdgcn_s_getreg((3 << 11) | 20) & 0xFu; }
#define XB_SPIN(cond, bar) do { unsigned _sp = 0; while (cond) { __builtin_amdgcn_s_sleep(1); \
    if ((++_sp & 255u) == 0u) { if (xb_ld(&(bar)[XB_TMO])) break; if (_sp > XB_SPIN_CAP) { atomicAdd(&(bar)[XB_TMO], 1u); break; } } } } while (0)
struct XcdBarrier { unsigned* bar; unsigned x; volatile LAS unsigned* st; };
DI XcdBarrier xcd_barrier_post(unsigned* bar, volatile LAS unsigned* st) {
  XcdBarrier b; b.bar = bar; b.x = xb_xcc_id(); b.st = st;
  if (__builtin_amdgcn_workitem_id_x() == 0) (void)xb_add(&bar[XB_XCNT(b.x)], 1u);
  return b;
}
DI void xcd_barrier_complete(unsigned* bar, unsigned x, unsigned& nloc, unsigned& nx) {
  const unsigned G = gridDim.x * gridDim.y * gridDim.z;
  unsigned sum, cnt, mine, sp = 0u;
  for (;;) {
    sum = 0u; cnt = 0u; mine = 0u;
#pragma unroll
    for (unsigned j = 0; j < 16; ++j) { const unsigned c = xb_ld(&bar[XB_XCNT(j)]); sum += c; cnt += (c > 0u) ? 1u : 0u; mine = (j == x) ? c : mine; }
    if (sum == G) break;
    __builtin_amdgcn_s_sleep(1);
    if ((++sp & 255u) == 0u) { if (xb_ld(&bar[XB_TMO])) break; if (sp > XB_SPIN_CAP) { atomicAdd(&bar[XB_TMO], 1u); break; } }
  }
  nloc = mine > 0u ? mine : 1u; nx = cnt > 0u ? cnt : 1u;
}
DI void xcd_barrier(const XcdBarrier& b) {
  asm volatile("s_waitcnt vmcnt(0)" ::: "memory");
  __syncthreads();
  if (__builtin_amdgcn_workitem_id_x() == 0) {
    unsigned* bar = b.bar;
    __builtin_amdgcn_s_waitcnt(0);
    unsigned nloc = b.st[0], nx = b.st[1];
    if (nloc == 0u) { xcd_barrier_complete(bar, b.x, nloc, nx); b.st[0] = nloc; b.st[1] = nx; }
    const unsigned old = xb_add(&bar[XB_XSUB(b.x)], 1u);
    const unsigned gen = old / nloc;
    if (old + 1u == (gen + 1u) * nloc) {
      __builtin_amdgcn_fence(__ATOMIC_RELEASE, "agent");
      asm volatile("s_waitcnt vmcnt(0)" ::: "memory");
      const unsigned og = xb_add(&bar[XB_TOP], 1u);
      const unsigned tg = og / nx;
      if (og + 1u == (tg + 1u) * nx) xb_add(&bar[XB_TOPGEN], 1u);
      else XB_SPIN(xb_ld(&bar[XB_TOPGEN]) == tg, bar);
      __builtin_amdgcn_fence(__ATOMIC_ACQUIRE, "agent");
      xb_add(&bar[XB_XGEN(b.x)], 1u);
      asm volatile("s_waitcnt vmcnt(0)" ::: "memory");
    } else {
      XB_SPIN(xb_ld(&bar[XB_XGEN(b.x)]) == gen, bar);
      __builtin_amdgcn_fence(__ATOMIC_ACQUIRE, "agent");
      asm volatile("s_waitcnt vmcnt(0)" ::: "memory");
    }
  }
  __syncthreads();
}

__global__ void __launch_bounds__(256, 2) fwd_kernel(Params p_in, int ph_lo, int ph_hi) {
  extern __shared__ __attribute__((aligned(16))) char smem[];
  char* ws0 = p_in.ws;
#ifndef DOUBLE_MASK
#define DOUBLE_MASK 0
#endif
  const bool multi = (ph_hi - ph_lo) > 1;
  XcdBarrier xb;
  if (multi) {
    volatile LAS unsigned* st = (volatile LAS unsigned*)(smem + SMEM_BYTES - 16);
    if (__builtin_amdgcn_workitem_id_x() == 0) { st[0] = 0u; st[1] = 0u; }
    __syncthreads();
    xb = xcd_barrier_post((unsigned*)(ws0 + OFF_BAR), st);
  }
  if (ph_lo < -1000) cg::this_grid().sync();
#if defined(__HIP_DEVICE_COMPILE__)
#define LOAD_PARAMS(dst_) { const __attribute__((address_space(4))) char* kp_ = (const __attribute__((address_space(4))) char*)__builtin_amdgcn_kernarg_segment_ptr(); \
                            asm volatile("" : "+s"(kp_)); __builtin_memcpy(&(dst_), kp_, sizeof(Params)); }
#else
#define LOAD_PARAMS(dst_) { dst_ = p_in; }
#endif
#define RUN_PHASE(k, call) if (ph_lo <= (k) && (k) < ph_hi) { \
    _Pragma("unroll 1") for (int rep = ((DOUBLE_MASK >> (k)) & 1); rep >= 0; --rep) { \
      Params pl; LOAD_PARAMS(pl); const Params& p = pl; char* ws = p.ws; (void)ws; \
      call; if (rep > 0 || (k) + 1 < ph_hi) xcd_barrier(xb); } }
  RUN_PHASE(0, phase_prep(p, smem))
  RUN_PHASE(1, phase_proj(p, smem))
  RUN_PHASE(2, phase_chunks(p, smem))
  RUN_PHASE(3, phase_scan(p, smem))
  RUN_PHASE(4, phase_gate(p))
  RUN_PHASE(5, phase_resid((const u16*)(ws + OFF_YMIX), (const u16*)(ws + OFF_WOUT), nullptr, (u16*)(ws + OFF_XB), (float*)(ws + OFF_SSQ1), smem))
  RUN_PHASE(6, phase_scaled((const u16*)(ws + OFF_XB), (const u16*)(ws + OFF_WXQ), (const float*)(ws + OFF_SSQ1), (u16*)(ws + OFF_QX), smem))
  RUN_PHASE(7, phase_attn(p, smem))
  RUN_PHASE(8, phase_resid((const u16*)(ws + OFF_OX), (const u16*)(ws + OFF_WXO), nullptr, (u16*)(ws + OFF_XB), (float*)(ws + OFF_SSQ2), smem))
  RUN_PHASE(9, phase_pq_topk(p, smem))
  if (ph_lo <= 11 && 11 < ph_hi) {
    Params pl; LOAD_PARAMS(pl); const Params& p = pl;
#if (DOUBLE_MASK >> 11) & 1
    phase_peer(p, smem, (float*)(p.ws + OFF_PROJ)); xcd_barrier(xb);
#endif
    phase_peer(p, smem, p.out);
  }
}

extern "C" void kernel_launch(void* const* d_in, const int* in_sizes, int n_in, void* d_out, int out_size, void* d_ws, size_t ws_size,
                              hipStream_t stream) {
  static int grid = 0;
  if (grid == 0) {
    if (n_in != 21 || out_size != T_TOK * DM || ws_size < WS_END) {
      fprintf(stderr, "kernel_launch: unexpected shapes (n_in %d out %d ws %zu need %zu)\n", n_in, out_size, ws_size, (size_t)WS_END);
      grid = -1;
      return;
    }
    int dev = 0, cus = 0, per_cu = 0;
    hipGetDevice(&dev);
    hipDeviceGetAttribute(&cus, hipDeviceAttributeMultiprocessorCount, dev);
    hipFuncSetAttribute((const void*)fwd_kernel, hipFuncAttributeMaxDynamicSharedMemorySize, SMEM_BYTES);
    hipOccupancyMaxActiveBlocksPerMultiprocessor(&per_cu, (const void*)fwd_kernel, 256, SMEM_BYTES);
    if (per_cu < 1) per_cu = 1;
    if (per_cu > 2) per_cu = 2;
    grid = cus * per_cu;
    if (grid < 128) { fprintf(stderr, "kernel_launch: grid %d too small\n", grid); grid = -1; return; }
  }
  if (grid < 0) return;
  Params p{};
  const float** pp = (const float**)&p;
  for (int i = 0; i < 21; ++i) pp[i] = (const float*)d_in[i];
  p.out = (float*)d_out;
  p.ws = (char*)d_ws;
#if ONE_LAUNCH
  hipMemsetAsync((char*)d_ws + OFF_BAR, 0, BAR_BYTES, stream);
  int lo = 0, hi = NPH;
  void* args[] = {&p, &lo, &hi};
  hipError_t e = hipLaunchCooperativeKernel((const void*)fwd_kernel, dim3(grid), dim3(256), args, SMEM_BYTES, stream);
  if (e != hipSuccess) fprintf(stderr, "cooperative launch failed: %s (grid %d)\n", hipGetErrorString(e), grid);
#else
  for (int ph = 0; ph < NPH; ++ph) hipLaunchKernelGGL(fwd_kernel, dim3(grid), dim3(256), SMEM_BYTES, stream, p, ph, ph + 1);
#endif
}
```
